# Optimizing an MI355X kernel written in HIP

```python
import math
import jax
import jax.numpy as jnp
from jax import lax
import numpy as np

D_MODEL = 1024
BATCH = 2
SEQ = 16384
DEPTH = 2

GRID_W = 64
CTX_LEN = 256
QBLK = 128
EPS = 1e-6
NEG_INF = -1e30
ROPE_DIM = 64
ROPE_BASE = 10000.0
N_MOD = 9
FFN_DIM = 2816
FFN_RES = 0.5
N_BRANCH = 3

DIFF_D = 64
DIFF_HEADS = D_MODEL // (2 * DIFF_D)
DIFF_V = 2 * DIFF_D
WIN_HEAD_DIM = 64
WIN_Q_HEADS = D_MODEL // WIN_HEAD_DIM
WIN_KV_HEADS = WIN_Q_HEADS // 4
WIN_GROUP = WIN_Q_HEADS // WIN_KV_HEADS
WINDOW = 128
WIN_SCALE = WIN_HEAD_DIM ** -0.5
MLA_HEADS = D_MODEL // 128
MLA_Q_RANK = 384
MLA_KV_RANK = 256
MLA_NOPE = 128
MLA_ROPE = ROPE_DIM
MLA_V = 128
MLA_SCALE = (MLA_NOPE + MLA_ROPE) ** -0.5

MIX_SPLITS = (
    DIFF_HEADS * 2 * DIFF_D,
    DIFF_HEADS * 2 * DIFF_D,
    DIFF_HEADS * DIFF_V,
    WIN_Q_HEADS * WIN_HEAD_DIM,
    WIN_KV_HEADS * WIN_HEAD_DIM,
    WIN_KV_HEADS * WIN_HEAD_DIM,
    MLA_Q_RANK,
    MLA_KV_RANK,
    MLA_ROPE,
    N_BRANCH * D_MODEL,
)
MIX_IN = sum(MIX_SPLITS)
MIX_CUTS = tuple(int(v) for v in np.cumsum(MIX_SPLITS)[:-1])

kernel_name = 'hybrid_diffusion_parallel_branch_block'


def rms_norm(x, g):
    xf = x.astype(jnp.float32)
    y = xf * lax.rsqrt(jnp.mean(xf * xf, axis=-1, keepdims=True) + EPS)
    return (y * g.astype(jnp.float32)).astype(x.dtype)


def modulate(x, shift, scale):
    return x * (1 + scale) + shift


def swiglu(x, w_in, w_out):
    a, b = jnp.split(x @ w_in, 2, axis=-1)
    return (jax.nn.silu(a) * b) @ w_out


def ffn_sublayer(t, shift, scale, gate, g_pre, g_post, w_in, w_out):
    y = swiglu(modulate(rms_norm(t, g_pre), shift, scale), w_in, w_out)
    return t + FFN_RES * gate * rms_norm(y, g_post)


def axial_rope_tables(n):
    rows = n // GRID_W
    row = jnp.repeat(jnp.arange(rows), GRID_W).astype(jnp.float32)
    col = jnp.tile(jnp.arange(GRID_W), rows).astype(jnp.float32)
    quarter = ROPE_DIM // 4
    inv_freq = 1.0 / (ROPE_BASE ** (jnp.arange(quarter, dtype=jnp.float32) / quarter))
    ang_r = row[:, None] * inv_freq
    ang_c = col[:, None] * inv_freq
    return (jnp.cos(ang_r), jnp.sin(ang_r), jnp.cos(ang_c), jnp.sin(ang_c))


def apply_rope2d(x, tabs):
    cr, sr, cc, sc = (t.reshape((1, t.shape[0]) + (1,) * (x.ndim - 3) + (t.shape[1],)) for t in tabs)
    xf = x.astype(jnp.float32)
    r1, r2, c1, c2 = jnp.split(xf, 4, axis=-1)
    out = jnp.concatenate([r1 * cr - r2 * sr, r2 * cr + r1 * sr,
                           c1 * cc - c2 * sc, c2 * cc + c1 * sc], axis=-1)
    return out.astype(x.dtype)


def maybe_rope(t, tabs):
    return t if tabs is None else apply_rope2d(t, tabs)


def project(hm, w_in):
    return jnp.split(hm @ w_in, MIX_CUTS, axis=-1)


def mixer_kv(parts, kv_norm_g, w_ukv, tabs):
    B, N = parts[0].shape[:2]
    a_k = maybe_rope(parts[1].reshape(B, N, DIFF_HEADS, 2, DIFF_D), tabs)
    a_v = parts[2].reshape(B, N, DIFF_HEADS, DIFF_V)
    b_k = maybe_rope(parts[4].reshape(B, N, WIN_KV_HEADS, WIN_HEAD_DIM), tabs)
    b_v = parts[5].reshape(B, N, WIN_KV_HEADS, WIN_HEAD_DIM)
    kv = (rms_norm(parts[7], kv_norm_g) @ w_ukv).reshape(B, N, MLA_HEADS, MLA_NOPE + MLA_V)
    c_kr = maybe_rope(parts[8], tabs)
    return (a_k, a_v, b_k, b_v, kv[..., :MLA_NOPE], c_kr, kv[..., MLA_NOPE:])


def mixer_q(parts, q_norm_g, w_uq, tabs):
    B, N = parts[0].shape[:2]
    a_q = maybe_rope(parts[0].reshape(B, N, DIFF_HEADS, 2, DIFF_D), tabs)
    b_q = maybe_rope(parts[3].reshape(B, N, WIN_KV_HEADS, WIN_GROUP, WIN_HEAD_DIM), tabs)
    q = (rms_norm(parts[6], q_norm_g) @ w_uq).reshape(B, N, MLA_HEADS, MLA_NOPE + MLA_ROPE)
    return (a_q, b_q, q[..., :MLA_NOPE], maybe_rope(q[..., MLA_NOPE:], tabs))


def diff_attend(q, k, v, lam):
    s = jnp.einsum('bqhnd,bkhnd->bhnqk', q, k, preferred_element_type=jnp.float32) / math.sqrt(DIFF_D)
    p = jax.nn.softmax(s, axis=-1)
    a = p[:, :, 0] - lam * p[:, :, 1]
    return jnp.einsum('bhqk,bkhe->bqhe', a.astype(v.dtype), v)


def sink_attend(q, segments, sink):
    B, Q = q.shape[:2]
    scores = []
    for k, v, mask in segments:
        s = jnp.einsum('bqhgd,bkhd->bhgqk', q, k, preferred_element_type=jnp.float32) * WIN_SCALE
        scores.append(s if mask is None else jnp.where(mask, s, NEG_INF))
    sink_col = jnp.broadcast_to(sink.astype(jnp.float32).reshape(1, WIN_KV_HEADS, WIN_GROUP, 1, 1),
                                (B, WIN_KV_HEADS, WIN_GROUP, Q, 1))
    p = jax.nn.softmax(jnp.concatenate(scores + [sink_col], axis=-1), axis=-1)
    outs = []
    start = 0
    for k, v, _ in segments:
        n = k.shape[1]
        outs.append(jnp.einsum('bhgqk,bkhd->bqhgd', p[..., start:start + n].astype(v.dtype), v))
        start += n
    return sum(outs[1:], outs[0])


def mla_attend(q_nope, q_rope, k_nope, k_rope, v):
    s = (jnp.einsum('bqhd,bkhd->bhqk', q_nope, k_nope, preferred_element_type=jnp.float32)
         + jnp.einsum('bqhr,bkr->bhqk', q_rope, k_rope, preferred_element_type=jnp.float32)) * MLA_SCALE
    p = jax.nn.softmax(s, axis=-1)
    return jnp.einsum('bhqk,bkhd->bqhd', p.astype(v.dtype), v)


def sweep_query_blocks(attend, qs, extra=()):
    S = qs[0].shape[1]
    nblk = S // QBLK
    blocks = tuple(jnp.moveaxis(q.reshape((q.shape[0], nblk, QBLK) + q.shape[2:]), 1, 0) for q in qs)
    out = lax.map(lambda xs: attend(*xs), blocks + tuple(extra))
    out = jnp.moveaxis(out, 0, 1)
    return out.reshape((out.shape[0], S) + out.shape[3:])


def band_blocks(t):
    B, S = t.shape[:2]
    nblk = S // QBLK
    tp = jnp.pad(t, [(0, 0), (QBLK, QBLK)] + [(0, 0)] * (t.ndim - 2))
    tp = tp.reshape((B, nblk + 2, QBLK) + t.shape[2:])
    band = jnp.concatenate([tp[:, :-2], tp[:, 1:-1], tp[:, 2:]], axis=2)
    return jnp.moveaxis(band, 1, 0)


def mix_latent(q, kv_lat, kv_ctx, lam, sink, band_mask, key_valid):
    a_q, b_q, c_qn, c_qr = q
    a_k, a_v, b_k, b_v, c_kn, c_kr, c_v = kv_lat
    ca_k, ca_v, cb_k, cb_v, cc_kn, cc_kr, cc_v = kv_ctx
    cat = lambda u, w: jnp.concatenate([u, w], axis=1)
    ka, va = cat(a_k, ca_k), cat(a_v, ca_v)
    ya = sweep_query_blocks(lambda qb: diff_attend(qb, ka, va, lam), (a_q,))
    yb = sweep_query_blocks(
        lambda qb, kb, vb, kvd: sink_attend(qb, ((kb, vb, band_mask & kvd[None, :]), (cb_k, cb_v, None)), sink),
        (b_q,), (band_blocks(b_k), band_blocks(b_v), key_valid))
    kn, kr, vc = cat(c_kn, cc_kn), cat(c_kr, cc_kr), cat(c_v, cc_v)
    yc = sweep_query_blocks(lambda qn, qr: mla_attend(qn, qr, kn, kr, vc), (c_qn, c_qr))
    return ya, yb, yc


def mix_context(q, kv_ctx, lam, sink):
    a_q, b_q, c_qn, c_qr = q
    a_k, a_v, b_k, b_v, c_kn, c_kr, c_v = kv_ctx
    ya = diff_attend(a_q, a_k, a_v, lam)
    yb = sink_attend(b_q, ((b_k, b_v, None),), sink)
    yc = mla_attend(c_qn, c_qr, c_kn, c_kr, c_v)
    return ya, yb, yc


def merge_branches(ya, yb, yc, gates, subln_g, lambda_init, branch_w, w_out):
    B, N = ya.shape[:2]
    ya = (rms_norm(ya, subln_g) * (1.0 - lambda_init)).reshape(B, N, DIFF_HEADS * DIFF_V)
    yb = yb.reshape(B, N, WIN_Q_HEADS * WIN_HEAD_DIM)
    yc = yc.reshape(B, N, MLA_HEADS * MLA_V)
    ga, gb, gc = jnp.split(jax.nn.sigmoid(gates), N_BRANCH, axis=-1)
    merged = ga * (ya @ branch_w[0]) + gb * (yb @ branch_w[1]) + gc * (yc @ branch_w[2])
    return merged @ w_out


def setup_inputs(seed: int = 0) -> dict:
    key = jax.random.key(seed)
    ks = jax.random.split(key, 19)
    nrm = lambda k, shape, scale: scale * jax.random.normal(k, shape, jnp.float32)
    return {
        'x': nrm(ks[0], (BATCH, SEQ, D_MODEL), 1.0),
        'c': nrm(ks[1], (BATCH, D_MODEL), 1.0),
        'ctx': nrm(ks[2], (BATCH, CTX_LEN, D_MODEL), 1.0),
        'c_ctx': nrm(ks[3], (D_MODEL,), 1.0),
        'ada_w': nrm(ks[4], (DEPTH, D_MODEL, N_MOD * D_MODEL), 0.3 * D_MODEL ** -0.5),
        'ada_b': nrm(ks[5], (DEPTH, N_MOD * D_MODEL), 0.02),
        'norm_g': 1.0 + nrm(ks[6], (DEPTH, 6, D_MODEL), 0.02),
        'ffn_w_in': nrm(ks[7], (DEPTH, 2, D_MODEL, 2 * FFN_DIM), D_MODEL ** -0.5),
        'ffn_w_out': nrm(ks[8], (DEPTH, 2, FFN_DIM, D_MODEL), FFN_DIM ** -0.5),
        'mix_w_in': nrm(ks[9], (DEPTH, D_MODEL, MIX_IN), D_MODEL ** -0.5),
        'diff_lambda': nrm(ks[10], (DEPTH, 4, DIFF_D), 0.1),
        'diff_subln_g': 1.0 + nrm(ks[11], (DEPTH, DIFF_V), 0.02),
        'win_sink': nrm(ks[12], (DEPTH, WIN_Q_HEADS), 0.5),
        'mla_q_norm_g': 1.0 + nrm(ks[13], (DEPTH, MLA_Q_RANK), 0.02),
        'mla_kv_norm_g': 1.0 + nrm(ks[14], (DEPTH, MLA_KV_RANK), 0.02),
        'mla_w_uq': nrm(ks[15], (DEPTH, MLA_Q_RANK, MLA_HEADS * (MLA_NOPE + MLA_ROPE)), MLA_Q_RANK ** -0.5),
        'mla_w_ukv': nrm(ks[16], (DEPTH, MLA_KV_RANK, MLA_HEADS * (MLA_NOPE + MLA_V)), MLA_KV_RANK ** -0.5),
        'branch_w': nrm(ks[17], (DEPTH, N_BRANCH, D_MODEL, D_MODEL), D_MODEL ** -0.5),
        'mix_w_out': nrm(ks[18], (DEPTH, D_MODEL, D_MODEL), D_MODEL ** -0.5),
    }


def reference(x, c, ctx, c_ctx, ada_w, ada_b, norm_g, ffn_w_in, ffn_w_out, mix_w_in,
              diff_lambda, diff_subln_g, win_sink, mla_q_norm_g, mla_kv_norm_g,
              mla_w_uq, mla_w_ukv, branch_w, mix_w_out):
    B, S, _ = x.shape
    tabs = axial_rope_tables(S)
    nblk = S // QBLK
    qq = jnp.arange(QBLK)[:, None]
    kk = jnp.arange(3 * QBLK)[None, :]
    band_mask = jnp.abs(kk - QBLK - qq) <= WINDOW
    kpos = jnp.arange(nblk)[:, None] * QBLK - QBLK + kk
    key_valid = (kpos >= 0) & (kpos < S)
    silu_c = jax.nn.silu(c)[:, None, :]
    silu_cc = jax.nn.silu(c_ctx)
    h = ctx
    for l in range(DEPTH):
        last = l == DEPTH - 1
        lambda_init = 0.8 - 0.6 * math.exp(-0.3 * l)
        mx = jnp.split(silu_c @ ada_w[l] + ada_b[l], N_MOD, axis=-1)
        mc = jnp.split(silu_cc @ ada_w[l] + ada_b[l], N_MOD, axis=-1)
        g = norm_g[l]
        dl = diff_lambda[l].astype(jnp.float32)
        lam = jnp.exp(jnp.sum(dl[0] * dl[1])) - jnp.exp(jnp.sum(dl[2] * dl[3])) + lambda_init
        x = ffn_sublayer(x, mx[0], mx[1], mx[2], g[0], g[1], ffn_w_in[l, 0], ffn_w_out[l, 0])
        h = ffn_sublayer(h, mc[0], mc[1], mc[2], g[0], g[1], ffn_w_in[l, 0], ffn_w_out[l, 0])
        px = project(modulate(rms_norm(x, g[2]), mx[3], mx[4]), mix_w_in[l])
        pc = project(modulate(rms_norm(h, g[2]), mc[3], mc[4]), mix_w_in[l])
        kv_x = mixer_kv(px, mla_kv_norm_g[l], mla_w_ukv[l], tabs)
        kv_c = mixer_kv(pc, mla_kv_norm_g[l], mla_w_ukv[l], None)
        q_x = mixer_q(px, mla_q_norm_g[l], mla_w_uq[l], tabs)
        ya, yb, yc = mix_latent(q_x, kv_x, kv_c, lam, win_sink[l], band_mask, key_valid)
        y = merge_branches(ya, yb, yc, px[9], diff_subln_g[l], lambda_init, branch_w[l], mix_w_out[l])
        x = x + mx[5] * rms_norm(y, g[3])
        if not last:
            q_c = mixer_q(pc, mla_q_norm_g[l], mla_w_uq[l], None)
            ca, cb, cc = mix_context(q_c, kv_c, lam, win_sink[l])
            yh = merge_branches(ca, cb, cc, pc[9], diff_subln_g[l], lambda_init, branch_w[l], mix_w_out[l])
            h = h + mc[5] * rms_norm(yh, g[3])
            h = ffn_sublayer(h, mc[6], mc[7], mc[8], g[4], g[5], ffn_w_in[l, 1], ffn_w_out[l, 1])
        x = ffn_sublayer(x, mx[6], mx[7], mx[8], g[4], g[5], ffn_w_in[l, 1], ffn_w_out[l, 1])
    return x
```

```cpp
#include <hip/hip_runtime.h>
#include <hip/hip_cooperative_groups.h>
#include <cstdio>
#include <cstdint>
#include <cmath>
namespace cg = cooperative_groups;

typedef unsigned short u16;
using bf16x8 = __attribute__((ext_vector_type(8))) short;
using f32x16 = __attribute__((ext_vector_type(16))) float;
using u32x4 = __attribute__((ext_vector_type(4))) unsigned;
using u32x2 = __attribute__((ext_vector_type(2))) unsigned;
using f32x4 = __attribute__((ext_vector_type(4))) float;
#define GAS __attribute__((address_space(1)))
#define GP(T, p) (reinterpret_cast<GAS T*>(reinterpret_cast<uintptr_t>(p)))
#define GPC(T, p) (reinterpret_cast<const GAS T*>(reinterpret_cast<uintptr_t>(p)))
typedef __bf16 bf2_t __attribute__((ext_vector_type(2)));
typedef float f2_t __attribute__((ext_vector_type(2)));
#define DI __device__ __forceinline__
#define MFMA(a, b, c) __builtin_amdgcn_mfma_f32_32x32x16_bf16((a), (b), (c), 0, 0, 0)

constexpr int DM = 1024, NB = 2, SEQ = 16384, CTX = 256, DEPTH = 2;
constexpr int MB = SEQ + CTX;
constexpr int MT = NB * MB;
constexpr int FFN = 2816;
constexpr int MIXIN = 8384, NPROJ = 5312;
constexpr float EPS = 1e-6f;
constexpr float LOG2E = 1.4426950408889634f;

constexpr size_t SZ_WIN = (size_t)2 * FFN * DM * 2;
constexpr size_t SZ_WOUT = (size_t)DM * FFN * 2;
constexpr size_t O_WIN = 0;
constexpr size_t O_WOUT = O_WIN + 2 * SZ_WIN;
constexpr size_t O_WMIX = O_WOUT + 2 * SZ_WOUT;
constexpr size_t O_WUQ = O_WMIX + (size_t)MIXIN * DM * 2;
constexpr size_t O_WUKV = O_WUQ + (size_t)1536 * 384 * 2;
constexpr size_t O_WBR = O_WUKV + (size_t)2048 * 256 * 2;
constexpr size_t O_WMO = O_WBR + (size_t)3 * DM * DM * 2;
constexpr size_t O_MODS = O_WMO + (size_t)DM * DM * 2;
constexpr size_t O_ROPE = O_MODS + (size_t)DEPTH * 3 * 9216 * 4;
constexpr size_t O_LAM = O_ROPE + 2 * 256 * 16 * 4;
constexpr size_t O_BAR = O_LAM + 256;
constexpr size_t O_TCTX = O_BAR + 16384;
constexpr size_t O_U = O_TCTX + (size_t)NB * CTX * DM * 4;
constexpr size_t O_RX = O_U + (size_t)MT * DM * 2;
constexpr size_t O_ACT = O_RX;
constexpr size_t O_Y = O_ACT + (size_t)MT * FFN * 2;
constexpr size_t END_FFN = O_Y + (size_t)MT * DM * 4;
constexpr size_t SZ1 = (size_t)MB * DM * 2;
constexpr size_t SZQ = (size_t)MB * 256 * 2;
constexpr size_t O_QA = O_RX;
constexpr size_t O_KA = O_QA + SZ1;
constexpr size_t O_VAT = O_KA + SZ1;
constexpr size_t O_QB = O_VAT + SZ1;
constexpr size_t O_KB = O_QB + SZ1;
constexpr size_t O_VBT = O_KB + SZQ;
constexpr size_t O_CQ = O_VBT + SZQ;
constexpr size_t O_CKV = O_CQ + (size_t)MB * 384 * 2;
constexpr size_t O_KR = O_CKV + SZQ;
constexpr size_t O_QC = O_KR + (size_t)MB * 64 * 2;
constexpr size_t O_KCN = O_QC + (size_t)MB * 1536 * 2;
constexpr size_t O_VCT = O_KCN + SZ1;
constexpr size_t O_YA = O_VCT + SZ1;
constexpr size_t END_MIX = O_YA + 3 * SZ1;
constexpr size_t O_SG = O_QA;
constexpr size_t O_MERGED = O_QB;
constexpr size_t O_YO = O_KCN;
constexpr size_t WS_NEED = END_MIX > END_FFN ? END_MIX : END_FFN;

struct Params {
  const float* in[19];
  float* out;
  char* ws;
  float inv_freq[16];
  float linit[2];
  int pad[2];
};

DI int otid() { int t = threadIdx.x; asm volatile("" : "+v"(t)); return t; }
DI char* ows(const Params& P) {
  const unsigned long long w = reinterpret_cast<unsigned long long>(P.ws);
  unsigned lo = __builtin_amdgcn_readfirstlane((unsigned)w), hi = __builtin_amdgcn_readfirstlane((unsigned)(w >> 32));
  asm volatile("" : "+s"(lo), "+s"(hi));
  return reinterpret_cast<char*>(((unsigned long long)hi << 32) | lo);
}
DI const char* uptr(const void* p) {
  const unsigned long long w = reinterpret_cast<unsigned long long>(p);
  const unsigned lo = __builtin_amdgcn_readfirstlane((unsigned)w), hi = __builtin_amdgcn_readfirstlane((unsigned)(w >> 32));
  return reinterpret_cast<const char*>(((unsigned long long)hi << 32) | lo);
}
DI int crow(int i, int h) { return (i & 3) + 8 * (i >> 2) + 4 * h; }
DI unsigned pk2(float a, float b) { f2_t v = {a, b}; bf2_t r = __builtin_convertvector(v, bf2_t); return __builtin_bit_cast(unsigned, r); }
DI float bflo(unsigned x) { return __uint_as_float(x << 16); }
DI float bfhi(unsigned x) { return __uint_as_float(x & 0xffff0000u); }
DI float wave_sum(float v) {
#pragma unroll
  for (int o = 32; o > 0; o >>= 1) v += __shfl_xor(v, o);
  return v;
}
DI float xhalf_max(float v) {
  auto rr = __builtin_amdgcn_permlane32_swap(__float_as_uint(v), __float_as_uint(v), false, false);
  return fmaxf(__uint_as_float(rr[0]), __uint_as_float(rr[1]));
}
DI float xhalf_sum(float v) {
  auto rr = __builtin_amdgcn_permlane32_swap(__float_as_uint(v), __float_as_uint(v), false, false);
  return __uint_as_float(rr[0]) + __uint_as_float(rr[1]);
}
DI float vmax3(float a, float b, float c) { float r; asm("v_max3_f32 %0, %1, %2, %3" : "=v"(r) : "v"(a), "v"(b), "v"(c)); return r; }
DI float sigmoidf_(float x) { return __builtin_amdgcn_rcpf(1.f + __builtin_amdgcn_exp2f(-LOG2E * x)); }
DI void st_bf16_tile(const f32x16& c, u16* dst, int h) {
#pragma unroll
  for (int q = 0; q < 4; ++q) {
    u32x2 v; v.x = pk2(c[4 * q], c[4 * q + 1]); v.y = pk2(c[4 * q + 2], c[4 * q + 3]);
    *GP(u32x2, dst + 8 * q + 4 * h) = v;
  }
}
DI void st_bf16_tile_vt(const f32x16& c, u16* dst, int h) {
#pragma unroll
  for (int q = 0; q < 4; ++q) {
    u32x2 v; v.x = pk2(c[4 * q], c[4 * q + 1]); v.y = pk2(c[4 * q + 2], c[4 * q + 3]);
    *GP(u32x2, dst + 16 * (q >> 1) + 8 * h + 4 * (q & 1)) = v;
  }
}
DI void st_f32_tile(const f32x16& c, float* dst, int h) {
#pragma unroll
  for (int q = 0; q < 4; ++q) {
    f32x4 v = {c[4 * q], c[4 * q + 1], c[4 * q + 2], c[4 * q + 3]};
    *GP(f32x4, dst + 8 * q + 4 * h) = v;
  }
}
DI void rope_tile(f32x16& c, const float* __restrict__ rope, int idx, int h) {
  const float* cp = rope + idx * 16 + 4 * h;
  const float* sp = cp + 256 * 16;
  const f32x4 c0 = *GPC(f32x4, cp), c1 = *GPC(f32x4, cp + 8);
  const f32x4 s0 = *GPC(f32x4, sp), s1 = *GPC(f32x4, sp + 8);
#define ROPE1(i, CS, SN) { const float x1 = c[i], x2 = c[(i) + 8]; c[i] = x1 * (CS) - x2 * (SN); c[(i) + 8] = x2 * (CS) + x1 * (SN); }
  ROPE1(0, c0.x, s0.x) ROPE1(1, c0.y, s0.y) ROPE1(2, c0.z, s0.z) ROPE1(3, c0.w, s0.w)
  ROPE1(4, c1.x, s1.x) ROPE1(5, c1.y, s1.y) ROPE1(6, c1.z, s1.z) ROPE1(7, c1.w, s1.w)
#undef ROPE1
}

template <bool TRANS>
DI void gemm_kloop(const u16* __restrict__ A, int lda, const u16* __restrict__ W, int ldw, int K, f32x16 (&acc)[2][2], char* lds) {
  const int tid = otid(), lane = tid & 63, wid = tid >> 6, r = lane & 31, h = lane >> 5;
  const int wm = wid >> 1, wn = wid & 1;
  const int lrow = tid >> 3, lkc = tid & 7;
  const unsigned voa = (unsigned)(lrow * lda + lkc * 8) * 2u, vob = (unsigned)(lrow * ldw + lkc * 8) * 2u;
  const char* Ab = reinterpret_cast<const char*>(A);
  const char* Wb = reinterpret_cast<const char*>(W);
  const int soff0 = lrow * 128 + ((lkc ^ ((lrow >> 1) & 7)) << 4);
  u32x4 ra0, ra1, ra2, ra3, rb0, rb1, rb2, rb3, rc0, rc1, rc2, rc3, rd0, rd1, rd2, rd3;
#define GLOAD(A0, A1, A2, A3, B0, B1, B2, B3, k0)                                \
  {                                                                              \
    const char* pa_ = Ab + (long)(k0) * 2;                                       \
    const char* pw_ = Wb + (long)(k0) * 2;                                       \
    A0 = *GPC(u32x4, pa_ + voa);                                                 \
    A1 = *GPC(u32x4, pa_ + (long)64 * lda + voa);                                \
    A2 = *GPC(u32x4, pa_ + (long)128 * lda + voa);                               \
    A3 = *GPC(u32x4, pa_ + (long)192 * lda + voa);                               \
    B0 = *GPC(u32x4, pw_ + vob);                                                 \
    B1 = *GPC(u32x4, pw_ + (long)64 * ldw + vob);                                \
    B2 = *GPC(u32x4, pw_ + (long)128 * ldw + vob);                               \
    B3 = *GPC(u32x4, pw_ + (long)192 * ldw + vob);                               \
  }
#define SSTORE(A0, A1, A2, A3, B0, B1, B2, B3, bufi)                             \
  {                                                                              \
    char* sb = lds + (bufi) * 32768 + soff0;                                     \
    *reinterpret_cast<u32x4*>(sb) = A0;                                          \
    *reinterpret_cast<u32x4*>(sb + 4096) = A1;                                   \
    *reinterpret_cast<u32x4*>(sb + 8192) = A2;                                   \
    *reinterpret_cast<u32x4*>(sb + 12288) = A3;                                  \
    *reinterpret_cast<u32x4*>(sb + 16384) = B0;                                  \
    *reinterpret_cast<u32x4*>(sb + 16384 + 4096) = B1;                           \
    *reinterpret_cast<u32x4*>(sb + 16384 + 8192) = B2;                           \
    *reinterpret_cast<u32x4*>(sb + 16384 + 12288) = B3;                          \
  }
#define SET0 ra0, ra1, ra2, ra3, rb0, rb1, rb2, rb3
#define SET1 rc0, rc1, rc2, rc3, rd0, rd1, rd2, rd3
#define GL(...) GLOAD(__VA_ARGS__)
#define SS(...) SSTORE(__VA_ARGS__)
  const int KT = K >> 6;
  const int xr = (r >> 1) & 7;
  const int aoff = (wm * 64 + r) * 128, boff = 16384 + (wn * 64 + r) * 128;
#define COMPUTE(bufi)                                                                                                              \
  {                                                                                                                                \
    const char* buf = lds + (bufi) * 32768;                                                                                        \
    bf16x8 a0n, a1n, b0n, b1n;                                                                                                     \
    {                                                                                                                              \
      const int co = (h ^ xr) << 4;                                                                                                \
      a0n = *reinterpret_cast<const bf16x8*>(buf + aoff + co); a1n = *reinterpret_cast<const bf16x8*>(buf + aoff + 4096 + co);     \
      b0n = *reinterpret_cast<const bf16x8*>(buf + boff + co); b1n = *reinterpret_cast<const bf16x8*>(buf + boff + 4096 + co);     \
    }                                                                                                                              \
    _Pragma("unroll") for (int s = 0; s < 4; ++s) {                                                                                \
      const bf16x8 a0 = a0n, a1 = a1n, b0 = b0n, b1 = b1n;                                                                         \
      if (s < 3) {                                                                                                                 \
        const int co = ((2 * (s + 1) + h) ^ xr) << 4;                                                                              \
        a0n = *reinterpret_cast<const bf16x8*>(buf + aoff + co); a1n = *reinterpret_cast<const bf16x8*>(buf + aoff + 4096 + co);   \
        b0n = *reinterpret_cast<const bf16x8*>(buf + boff + co); b1n = *reinterpret_cast<const bf16x8*>(buf + boff + 4096 + co);   \
      }                                                                                                                            \
      if (TRANS) {                                                                                                                 \
        acc[0][0] = MFMA(a0, b0, acc[0][0]); acc[0][1] = MFMA(a0, b1, acc[0][1]);                                                  \
        acc[1][0] = MFMA(a1, b0, acc[1][0]); acc[1][1] = MFMA(a1, b1, acc[1][1]);                                                  \
      } else {                                                                                                                     \
        acc[0][0] = MFMA(b0, a0, acc[0][0]); acc[0][1] = MFMA(b1, a0, acc[0][1]);                                                  \
        acc[1][0] = MFMA(b0, a1, acc[1][0]); acc[1][1] = MFMA(b1, a1, acc[1][1]);                                                  \
      }                                                                                                                            \
      __builtin_amdgcn_sched_barrier(0);                                                                                           \
    }                                                                                                                              \
  }
  GL(SET0, 0);
  SS(SET0, 0);
  GL(SET1, 64);
  __syncthreads();
  for (int kt = 0; kt < KT; kt += 2) {
    const bool m2 = kt + 2 < KT;
    if (m2) { GL(SET0, (kt + 2) * 64); }
    COMPUTE(0);
    SS(SET1, 1);
    __syncthreads();
    if (m2) { GL(SET1, (kt + 3) * 64); }
    COMPUTE(1);
    if (m2) { SS(SET0, 0); }
    __syncthreads();
  }
#undef GLOAD
#undef SSTORE
#undef SET0
#undef SET1
#undef GL
#undef SS
#undef COMPUTE
}

enum { EPI_SWIGLU = 0, EPI_YF32 = 1, EPI_PROJ = 2, EPI_UQKV = 3, EPI_SG = 4, EPI_MERGE = 5 };
struct GemmDesc {
  int epi, mtiles, ntiles, K, lda, skipctx;
  const u16* A; const u16* W;
  void* dst;
};

template <bool MERGE>
DI void gemm_phase(const GemmDesc& d, const Params& P, char* lds) {
  const int tid = otid(), lane = tid & 63, wid = tid >> 6, r = lane & 31, h = lane >> 5;
  const int wm = wid >> 1, wn = wid & 1;
  char* ws = ows(P);
  const float* rope = reinterpret_cast<const float*>(ws + O_ROPE);
  const int ntl = d.mtiles * d.ntiles;
  for (int t = blockIdx.x; t < ntl; t += gridDim.x) {
    int mt = t / d.ntiles;
    int nt = t - mt * d.ntiles;
    if (d.ntiles == 8) {
      const int m4 = d.mtiles & ~3;
      if (t < 8 * m4) {
        const int x = t & 7, k = t >> 3;
        nt = 4 * (x & 1) + (k & 3);
        mt = 4 * (k >> 2) + (x >> 1);
      }
    }
    if (d.skipctx && mt >= 128) mt += 2;
    const u16* A = d.A; const u16* W = d.W; int lda = d.lda, K = d.K;
    bool trans = false;
    int uq = 0;
    if (d.epi == EPI_PROJ) {
      const int n0 = nt * 128;
      trans = (n0 >= 2048 && n0 < 3072) || (n0 >= 4352 && n0 < 4608);
    } else if (d.epi == EPI_UQKV) {
      if (nt < 12) { uq = 1; A = reinterpret_cast<const u16*>(ws + O_CQ); lda = 384; K = 384; W = reinterpret_cast<const u16*>(ws + O_WUQ); }
      else { nt -= 12; A = reinterpret_cast<const u16*>(ws + O_CKV); lda = 256; K = 256; W = reinterpret_cast<const u16*>(ws + O_WUKV); trans = (nt & 1); }
    }
    const int n0 = nt * 128;
    constexpr int nrep = MERGE ? 3 : 1;
    f32x16 acc[2][2];
#pragma unroll 1
    for (int rep = 0; rep < nrep; ++rep) {
#pragma unroll
      for (int a = 0; a < 2; ++a)
#pragma unroll
        for (int b = 0; b < 2; ++b)
#pragma unroll
          for (int i = 0; i < 16; ++i) acc[a][b][i] = 0.f;
      const u16* Ar = A + (long)rep * ((long)MB * DM) + (long)(mt * 128) * lda;
      const u16* Wr = W + (long)rep * ((long)DM * DM) + (long)n0 * K;
      if (trans) gemm_kloop<true>(Ar, lda, Wr, K, K, acc, lds);
      else gemm_kloop<false>(Ar, lda, Wr, K, K, acc, lds);
      if constexpr (MERGE) {
        const u16* sg = reinterpret_cast<const u16*>(ws + O_SG);
        float* macc = reinterpret_cast<float*>(ws + O_YO);
        u16* mo = reinterpret_cast<u16*>(d.dst);
#pragma unroll
        for (int mi = 0; mi < 2; ++mi)
#pragma unroll
          for (int ni = 0; ni < 2; ++ni) {
            const long row = mt * 128 + wm * 64 + mi * 32 + r;
            const int col = n0 + wn * 64 + ni * 32 + 4 * h;
            const u16* gp = sg + row * 3072 + rep * 1024 + col;
            float* mp = macc + row * DM + col;
#pragma unroll
            for (int q = 0; q < 4; ++q) {
              const u32x2 g = *GPC(u32x2, gp + 8 * q);
              f32x4 v = {0.f, 0.f, 0.f, 0.f};
              if (rep > 0) v = *GPC(f32x4, mp + 8 * q);
              v.x += bflo(g.x) * acc[mi][ni][4 * q + 0]; v.y += bfhi(g.x) * acc[mi][ni][4 * q + 1];
              v.z += bflo(g.y) * acc[mi][ni][4 * q + 2]; v.w += bfhi(g.y) * acc[mi][ni][4 * q + 3];
              if (rep < 2) *GP(f32x4, mp + 8 * q) = v;
              else { u32x2 o = {pk2(v.x, v.y), pk2(v.z, v.w)}; *GP(u32x2, mo + row * DM + col + 8 * q) = o; }
            }
          }
      }
    }
    const int cb = n0 + wn * 64;
    const int rowb = mt * 128 + wm * 64;
    if constexpr (MERGE) {
    } else if (d.epi == EPI_SWIGLU) {
      u16* act = reinterpret_cast<u16*>(d.dst);
      const int acol = (n0 >> 1) + wn * 32;
#pragma unroll
      for (int mi = 0; mi < 2; ++mi) {
        f32x16 o;
#pragma unroll
        for (int i = 0; i < 16; ++i) { float a = acc[mi][0][i], b = acc[mi][1][i]; o[i] = a * sigmoidf_(a) * b; }
        st_bf16_tile(o, act + (long)(rowb + mi * 32 + r) * FFN + acol, h);
      }
    } else if (d.epi == EPI_YF32) {
      float* y = reinterpret_cast<float*>(d.dst);
#pragma unroll
      for (int mi = 0; mi < 2; ++mi)
#pragma unroll
        for (int ni = 0; ni < 2; ++ni) st_f32_tile(acc[mi][ni], y + (long)(rowb + mi * 32 + r) * DM + cb + ni * 32, h);
    } else if (d.epi == EPI_SG) {
      u16* sg = reinterpret_cast<u16*>(d.dst);
#pragma unroll
      for (int mi = 0; mi < 2; ++mi)
#pragma unroll
        for (int ni = 0; ni < 2; ++ni) {
          f32x16 o;
#pragma unroll
          for (int i = 0; i < 16; ++i) o[i] = sigmoidf_(acc[mi][ni][i]);
          st_bf16_tile(o, sg + (long)(rowb + mi * 32 + r) * 3072 + cb + ni * 32, h);
        }
    } else if (trans) {
      u16* vt; int f0;
      if (d.epi == EPI_PROJ) {
        if (cb < 3072) { vt = reinterpret_cast<u16*>(ws + O_VAT); f0 = cb - 2048; }
        else { vt = reinterpret_cast<u16*>(ws + O_VBT); f0 = cb - 4352; }
      } else { vt = reinterpret_cast<u16*>(ws + O_VCT); f0 = (nt >> 1) * 128 + wn * 64; }
#pragma unroll
      for (int mi = 0; mi < 2; ++mi)
#pragma unroll
        for (int ni = 0; ni < 2; ++ni) st_bf16_tile_vt(acc[mi][ni], vt + (long)(f0 + ni * 32 + r) * MB + rowb + mi * 32, h);
    } else {
      u16* dst = nullptr; int ld = 0, cofs = 0; bool rp = false;
      if (d.epi == EPI_PROJ) {
        if (cb < 1024) { dst = reinterpret_cast<u16*>(ws + O_QA); ld = 1024; cofs = cb; rp = true; }
        else if (cb < 2048) { dst = reinterpret_cast<u16*>(ws + O_KA); ld = 1024; cofs = cb - 1024; rp = true; }
        else if (cb < 4096) { dst = reinterpret_cast<u16*>(ws + O_QB); ld = 1024; cofs = cb - 3072; rp = true; }
        else if (cb < 4352) { dst = reinterpret_cast<u16*>(ws + O_KB); ld = 256; cofs = cb - 4096; rp = true; }
        else if (cb < 4992) { dst = reinterpret_cast<u16*>(ws + O_CQ); ld = 384; cofs = cb - 4608; }
        else if (cb < 5248) { dst = reinterpret_cast<u16*>(ws + O_CKV); ld = 256; cofs = cb - 4992; }
        else if (cb < 5312) { dst = reinterpret_cast<u16*>(ws + O_KR); ld = 64; cofs = 0; rp = true; }
      } else {
        if (uq) { dst = reinterpret_cast<u16*>(ws + O_QC); ld = 1536; cofs = cb; rp = (cb % 192) == 128; }
        else { dst = reinterpret_cast<u16*>(ws + O_KCN); ld = 1024; cofs = (nt >> 1) * 128 + wn * 64; }
      }
      if (dst != nullptr) {
        const bool latent = mt < 128;
#pragma unroll
        for (int mi = 0; mi < 2; ++mi) {
          const int lr = rowb + mi * 32 + r;
#pragma unroll
          for (int ni = 0; ni < 2; ++ni) {
            f32x16 o = acc[mi][ni];
            if (rp && latent) rope_tile(o, rope, ni == 0 ? (lr >> 6) : (lr & 63), h);
            st_bf16_tile(o, dst + (long)lr * ld + cofs + ni * 32, h);
          }
        }
      }
    }
  }
}

struct RowDesc {
  int g0, g1, skipctx;
  const float* told_lat; const float* told_ctx;
  const float* ybuf; int yrow0;
  float gscale; int gate_idx, gpost_idx, layer;
  int has_u, ulayer, gpre_idx, shift_idx, scale_idx;
};

DI void rowop_phase(const RowDesc& d, const Params& P) {
  const int tid_ = otid(); const int lane = tid_ & 63, wid = tid_ >> 6;
  char* ws = ows(P);
  const float* mods = reinterpret_cast<const float*>(ws + O_MODS);
  const float* normg = P.in[6];
  float* tctx = reinterpret_cast<float*>(ws + O_TCTX);
  u16* U = reinterpret_cast<u16*>(ws + O_U);
  const int stride = gridDim.x * 4;
  const bool has_y = d.ybuf != nullptr;
  f32x4 tn[4], yn[4];
  bool vn = false;
#define LOADROW(g_)                                                                                              \
  {                                                                                                              \
    const int b_ = (g_) / MB, i_ = (g_) - b_ * MB;                                                               \
    const bool lat_ = i_ < SEQ;                                                                                  \
    vn = !(d.skipctx && !lat_);                                                                                  \
    if (vn) {                                                                                                    \
      const long toff_ = lat_ ? ((long)(b_ * SEQ + i_)) * DM : ((long)(b_ * CTX + i_ - SEQ)) * DM;               \
      const float* told_ = (lat_ ? d.told_lat : d.told_ctx) + toff_;                                             \
      _Pragma("unroll") for (int j = 0; j < 4; ++j) tn[j] = *GPC(f32x4, told_ + lane * 4 + 256 * j);             \
      if (has_y) {                                                                                               \
        const float* y_ = d.ybuf + (long)((g_) - d.yrow0) * DM;                                                  \
        _Pragma("unroll") for (int j = 0; j < 4; ++j) yn[j] = *GPC(f32x4, y_ + lane * 4 + 256 * j);              \
      }                                                                                                          \
    }                                                                                                            \
  }
  int gnext = d.g0 + blockIdx.x * 4 + wid;
  if (gnext < d.g1) { LOADROW(gnext) }
  while (gnext < d.g1) {
    const int g = gnext;
    const bool v = vn;
    f32x4 t[4], yv[4];
#pragma unroll
    for (int j = 0; j < 4; ++j) { t[j] = tn[j]; yv[j] = yn[j]; }
    gnext += stride;
    if (gnext < d.g1) { LOADROW(gnext) }
    if (!v) continue;
    const int b = g / MB, i = g - b * MB;
    const bool lat = i < SEQ;
    const int midx = lat ? b : 2;
    const long toff = lat ? ((long)(b * SEQ + i)) * DM : ((long)(b * CTX + i - SEQ)) * DM;
    if (has_y) {
      float ss = 0.f;
#pragma unroll
      for (int j = 0; j < 4; ++j) ss += yv[j].x * yv[j].x + yv[j].y * yv[j].y + yv[j].z * yv[j].z + yv[j].w * yv[j].w;
      ss = wave_sum(ss);
      const float rr = rsqrtf(ss * (1.f / DM) + EPS) * d.gscale;
      const float* gate = mods + (d.layer * 3 + midx) * 9216 + d.gate_idx * DM;
      const float* gp = normg + (d.layer * 6 + d.gpost_idx) * DM;
      float* tnew = (lat ? P.out : tctx) + toff;
#pragma unroll
      for (int j = 0; j < 4; ++j) {
        f32x4 ga = *GPC(f32x4, gate + lane * 4 + 256 * j);
        f32x4 gg = *GPC(f32x4, gp + lane * 4 + 256 * j);
        t[j].x += ga.x * (yv[j].x * rr * gg.x); t[j].y += ga.y * (yv[j].y * rr * gg.y);
        t[j].z += ga.z * (yv[j].z * rr * gg.z); t[j].w += ga.w * (yv[j].w * rr * gg.w);
        *GP(f32x4, tnew + lane * 4 + 256 * j) = t[j];
      }
    }
    if (d.has_u) {
      float ss = 0.f;
#pragma unroll
      for (int j = 0; j < 4; ++j) ss += t[j].x * t[j].x + t[j].y * t[j].y + t[j].z * t[j].z + t[j].w * t[j].w;
      ss = wave_sum(ss);
      const float rr = rsqrtf(ss * (1.f / DM) + EPS);
      const float* mu = mods + (d.ulayer * 3 + midx) * 9216;
      const float* sh = mu + d.shift_idx * DM; const float* sc = mu + d.scale_idx * DM;
      const float* gp = normg + (d.ulayer * 6 + d.gpre_idx) * DM;
      u16* u = U + (long)g * DM;
#pragma unroll
      for (int j = 0; j < 4; ++j) {
        f32x4 gg = *GPC(f32x4, gp + lane * 4 + 256 * j);
        f32x4 s1 = *GPC(f32x4, sc + lane * 4 + 256 * j);
        f32x4 s0 = *GPC(f32x4, sh + lane * 4 + 256 * j);
        float a = (t[j].x * rr * gg.x) * (1.f + s1.x) + s0.x, bb = (t[j].y * rr * gg.y) * (1.f + s1.y) + s0.y;
        float c = (t[j].z * rr * gg.z) * (1.f + s1.z) + s0.z, dd = (t[j].w * rr * gg.w) * (1.f + s1.w) + s0.w;
        u32x2 v2; v2.x = pk2(a, bb); v2.y = pk2(c, dd);
        *GP(u32x2, u + lane * 4 + 256 * j) = v2;
      }
    }
  }
#undef LOADROW
}

DI void r3_phase(int layer, const Params& P) {
  const int tid_ = otid(); const int lane = tid_ & 63, wid = tid_ >> 6;
  char* ws = ows(P);
  u16* cq = reinterpret_cast<u16*>(ws + O_CQ);
  u16* ckv = reinterpret_cast<u16*>(ws + O_CKV);
  const float* gq = P.in[13] + layer * 384;
  const float* gkv = P.in[14] + layer * 256;
  for (int row = blockIdx.x * 4 + wid; row < MB; row += gridDim.x * 4) {
    {
      u16* p = cq + (long)row * 384;
      float v[6]; float ss = 0.f;
#pragma unroll
      for (int j = 0; j < 3; ++j) {
        unsigned x = *GPC(unsigned, p + lane * 2 + 128 * j);
        v[2 * j] = bflo(x); v[2 * j + 1] = bfhi(x); ss += v[2 * j] * v[2 * j] + v[2 * j + 1] * v[2 * j + 1];
      }
      ss = wave_sum(ss);
      const float rr = rsqrtf(ss * (1.f / 384.f) + EPS);
#pragma unroll
      for (int j = 0; j < 3; ++j) {
        const int c = lane * 2 + 128 * j;
        *GP(unsigned, p + c) = pk2(v[2 * j] * rr * gq[c], v[2 * j + 1] * rr * gq[c + 1]);
      }
    }
    {
      u16* p = ckv + (long)row * 256;
      u32x2 x = *GPC(u32x2, p + lane * 4);
      float v0 = bflo(x.x), v1 = bfhi(x.x), v2 = bflo(x.y), v3 = bfhi(x.y);
      float ss = wave_sum(v0 * v0 + v1 * v1 + v2 * v2 + v3 * v3);
      const float rr = rsqrtf(ss * (1.f / 256.f) + EPS);
      const int c = lane * 4;
      u32x2 o; o.x = pk2(v0 * rr * gkv[c], v1 * rr * gkv[c + 1]); o.y = pk2(v2 * rr * gkv[c + 2], v3 * rr * gkv[c + 3]);
      *GP(u32x2, p + c) = o;
    }
  }
}

template <int DQK, int DV, int TYPE>
DI void attn_item(int layer, int qt, int head, char* lds, const Params& P) {
  const int tid = otid(), lane = tid & 63, wid = tid >> 6, r = lane & 31, h = lane >> 5;
  char* ws = ows(P);
  constexpr int NS = DQK / 16, NDV = DV / 32;
  constexpr bool DB = DQK == 64;
  constexpr int KBYTES = 64 * DQK * 2;
  constexpr int STAGE = DB ? 24576 : 0;
  constexpr int VOFF = DB ? 8192 : 24576;
  constexpr float SCALE = TYPE == 1 ? 0.07216878364870322f : 0.125f;
  constexpr float C = SCALE * LOG2E;
  const bool latent = qt < 128;
  int ta0, na, NT;
  if (!latent) { ta0 = 256; na = 4; NT = 4; }
  else if (TYPE == 2) { int lo = qt * 2 - 2; if (lo < 0) lo = 0; int hi = qt * 2 + 4; if (hi > 256) hi = 256; ta0 = lo; na = hi - lo; NT = na + 4; }
  else { ta0 = 0; na = 260; NT = 260; }
  const int qrow = qt * 128 + wid * 32 + r;
  const u16* Kp; int ldk; const u16* Vp;
  if (TYPE == 0) { Kp = reinterpret_cast<const u16*>(ws + O_KA) + head * 128; ldk = 1024; Vp = reinterpret_cast<const u16*>(ws + O_VAT) + (long)(head * 128) * MB; }
  else if (TYPE == 1) { Kp = reinterpret_cast<const u16*>(ws + O_KCN) + head * 128; ldk = 1024; Vp = reinterpret_cast<const u16*>(ws + O_VCT) + (long)(head * 128) * MB; }
  else { Kp = reinterpret_cast<const u16*>(ws + O_KB) + (head >> 2) * 64; ldk = 256; Vp = reinterpret_cast<const u16*>(ws + O_VBT) + (long)((head >> 2) * 64) * MB; }
  const u16* K2 = reinterpret_cast<const u16*>(ws + O_KR);
  const int kr_a = (DQK == 64) ? (tid >> 3) : (tid >> 4), kc_a = (DQK == 64) ? (tid & 7) : (tid & 15);
  const int kgo_a = kr_a * ldk + kc_a * 8;
  const int kso_a = kr_a * (DQK * 2) + ((kc_a ^ ((kr_a >> 1) & 7)) << 4);
  const int kr_b = tid >> 3, kc_b = 16 + (tid & 7);
  const int kgo_b = kr_b * 64 + (tid & 7) * 8;
  const int kso_b = kr_b * (DQK * 2) + ((kc_b ^ ((kr_b >> 1) & 7)) << 4);
  const int vdv = tid >> 3, vkc = tid & 7, vxs = (vdv >> 1) & 7;
  const unsigned vvo = (unsigned)(vdv * MB + vkc * 8) * 2u;
  const unsigned kvo_a = (unsigned)kgo_a * 2u, kvo_b = (unsigned)kgo_b * 2u;
  const int vso = VOFF + vdv * 128 + ((vkc ^ vxs) << 4);
  u32x4 kreg0, kreg1, kreg2, kreg3, kreg4, kreg5, vreg0, vreg1, vreg2, vreg3;
  const int xr = (r >> 1) & 7;
  constexpr int NMAPS = TYPE == 0 ? 2 : 1;
  u16* ya_dst = reinterpret_cast<u16*>(ws + O_YA) + (long)qrow * 1024 + head * 128;
  for (int map = 0; map < NMAPS; ++map) {
    const u16* Kb = Kp + map * 64;
    const u16* Qp;
    if (TYPE == 0) Qp = reinterpret_cast<const u16*>(ws + O_QA) + (long)qrow * 1024 + head * 128 + map * 64;
    else if (TYPE == 1) Qp = reinterpret_cast<const u16*>(ws + O_QC) + (long)qrow * 1536 + head * 192;
    else Qp = reinterpret_cast<const u16*>(ws + O_QB) + (long)qrow * 1024 + head * 64;
    constexpr int NQR = NS > 6 ? 6 : NS;
    bf16x8 qf[NQR];
#pragma unroll
    for (int s = 0; s < NQR; ++s) qf[s] = *GPC(bf16x8, Qp + 16 * s + 8 * h);
    char* qpark = lds + 40960 + tid * 16;
#pragma unroll
    for (int s = NQR; s < NS; ++s) *reinterpret_cast<bf16x8*>(qpark + (s - NQR) * 4096) = *GPC(bf16x8, Qp + 16 * s + 8 * h);
    float m_run, l_run;
    if (TYPE == 2) { m_run = P.in[12][layer * 16 + head] * (1.f / SCALE); l_run = h == 0 ? 1.f : 0.f; }
    else { m_run = -1e30f; l_run = 0.f; }
    f32x16 oacc[NDV];
#pragma unroll
    for (int d = 0; d < NDV; ++d)
#pragma unroll
      for (int i = 0; i < 16; ++i) oacc[d][i] = 0.f;
#define TILE_OF(j) ((j) < na ? ta0 + (j) : 256 + ((j) - na))
#define LDG(p) (*GPC(u32x4, p))
#define ATT_GLOAD(tile)                                                                                          \
  {                                                                                                              \
    const long key0 = (long)(tile) * 64;                                                                         \
    const char* kp_ = uptr(Kb + key0 * ldk);                                                    \
    if constexpr (DQK == 64) {                                                                                   \
      kreg0 = LDG(kp_ + kvo_a); kreg1 = LDG(kp_ + (long)64 * ldk + kvo_a);                                       \
    } else {                                                                                                     \
      kreg0 = LDG(kp_ + kvo_a); kreg1 = LDG(kp_ + (long)32 * ldk + kvo_a);                                       \
      kreg2 = LDG(kp_ + (long)64 * ldk + kvo_a); kreg3 = LDG(kp_ + (long)96 * ldk + kvo_a);                      \
      const char* k2_ = uptr(K2 + key0 * 64);                                           \
      kreg4 = LDG(k2_ + kvo_b); kreg5 = LDG(k2_ + 32 * 64 * 2 + kvo_b);                                          \
    }                                                                                                            \
    const char* vp_ = uptr(Vp + key0);                                                  \
    vreg0 = LDG(vp_ + vvo); vreg1 = LDG(vp_ + (long)64 * MB + vvo);                                              \
    if constexpr (DV == 128) { vreg2 = LDG(vp_ + (long)128 * MB + vvo); vreg3 = LDG(vp_ + (long)192 * MB + vvo); } \
  }
#define STV(sb, j, v) { *reinterpret_cast<u32x4*>((sb) + vso + (j) * 4096) = v; }
#define ATT_SSTORE(sb)                                                                                           \
  {                                                                                                              \
    if constexpr (DQK == 64) {                                                                                   \
      *reinterpret_cast<u32x4*>((sb) + kso_a) = kreg0; *reinterpret_cast<u32x4*>((sb) + kso_a + 4096) = kreg1;   \
    } else {                                                                                                     \
      *reinterpret_cast<u32x4*>((sb) + kso_a) = kreg0; *reinterpret_cast<u32x4*>((sb) + kso_a + 16 * 384) = kreg1; \
      *reinterpret_cast<u32x4*>((sb) + kso_a + 32 * 384) = kreg2; *reinterpret_cast<u32x4*>((sb) + kso_a + 48 * 384) = kreg3; \
      *reinterpret_cast<u32x4*>((sb) + kso_b) = kreg4; *reinterpret_cast<u32x4*>((sb) + kso_b + 32 * 384) = kreg5; \
    }                                                                                                            \
    STV(sb, 0, vreg0) STV(sb, 1, vreg1)                                                                          \
    if constexpr (DV == 128) { STV(sb, 2, vreg2) STV(sb, 3, vreg3) }                                             \
  }
    ATT_GLOAD(TILE_OF(0));
    ATT_SSTORE(lds);
    if constexpr (DB) { if (1 < NT) { ATT_GLOAD(TILE_OF(1)); } }
    __syncthreads();
    for (int j = 0; j < NT; ++j) {
      const int tile = TILE_OF(j);
      const char* sb = lds + (DB ? (j & 1) * STAGE : 0);
      if constexpr (DB) {
        char* sn = lds + ((j + 1) & 1) * STAGE;
        if (j + 1 < NT) { ATT_SSTORE(sn); }
        if (j + 2 < NT) { ATT_GLOAD(TILE_OF(j + 2)); }
      } else {
        if (j + 1 < NT) { ATT_GLOAD(TILE_OF(j + 1)); }
      }
      f32x16 s0, s1;
#pragma unroll
      for (int i = 0; i < 16; ++i) { s0[i] = 0.f; s1[i] = 0.f; }
      {
        bf16x8 kr0[3], kr1[3];
#define KFR(s_, slot_)                                                                          \
  {                                                                                             \
    const int co = ((2 * (s_) + h) ^ xr) << 4;                                                  \
    kr0[slot_] = *reinterpret_cast<const bf16x8*>(sb + r * (DQK * 2) + co);                     \
    kr1[slot_] = *reinterpret_cast<const bf16x8*>(sb + (32 + r) * (DQK * 2) + co);              \
  }
        KFR(0, 0) KFR(1, 1)
#pragma unroll
        for (int s = 0; s < NS; ++s) {
          if (s + 2 < NS) KFR(s + 2, (s + 2) % 3)
          bf16x8 qs;
          if constexpr (NS > NQR) { if (s < NQR) qs = qf[s < NQR ? s : 0]; else qs = *reinterpret_cast<const bf16x8*>(qpark + (s - NQR) * 4096); }
          else qs = qf[s];
          s0 = MFMA(kr0[s % 3], qs, s0);
          s1 = MFMA(kr1[s % 3], qs, s1);
          __builtin_amdgcn_sched_barrier(0);
        }
#undef KFR
      }
      if (TYPE == 2 && latent && j < na) {
        const int kb0 = tile * 64 - qrow;
#pragma unroll
        for (int i = 0; i < 16; ++i) {
          const int d0 = kb0 + crow(i, h), d1 = d0 + 32;
          if (d0 > 128 || d0 < -128) s0[i] = -1e30f;
          if (d1 > 128 || d1 < -128) s1[i] = -1e30f;
        }
      }
      asm volatile("s_nop 15" ::: "memory");
      __builtin_amdgcn_sched_barrier(0);
      const float tm0 = vmax3(s0[0], s0[1], s0[2]), tm1 = vmax3(s0[3], s0[4], s0[5]), tm2 = vmax3(s0[6], s0[7], s0[8]), tm3 = vmax3(s0[9], s0[10], s0[11]);
      const float tm4 = vmax3(s0[12], s0[13], s0[14]), tm5 = vmax3(s1[0], s1[1], s1[2]), tm6 = vmax3(s1[3], s1[4], s1[5]), tm7 = vmax3(s1[6], s1[7], s1[8]);
      const float tm8 = vmax3(s1[9], s1[10], s1[11]), tm9 = vmax3(s1[12], s1[13], s1[14]), tma = vmax3(s0[15], s1[15], tm0), tmb = vmax3(tm1, tm2, tm3);
      const float tmc = vmax3(tm4, tm5, tm6), tmd = vmax3(tm7, tm8, tm9);
      float tmax = xhalf_max(vmax3(vmax3(tma, tmb, tmc), tmd, tmd));
      const float mnew = fmaxf(m_run, tmax);
      const float alpha = __builtin_amdgcn_exp2f((m_run - mnew) * C);
      m_run = mnew;
      const float mc = -mnew * C;
      float pa = 0.f, pb = 0.f, pc = 0.f, pd = 0.f;
#pragma unroll
      for (int i = 0; i < 16; i += 2) {
        s0[i] = __builtin_amdgcn_exp2f(fmaf(s0[i], C, mc)); pa += s0[i];
        s0[i + 1] = __builtin_amdgcn_exp2f(fmaf(s0[i + 1], C, mc)); pb += s0[i + 1];
      }
#pragma unroll
      for (int i = 0; i < 16; i += 2) {
        s1[i] = __builtin_amdgcn_exp2f(fmaf(s1[i], C, mc)); pc += s1[i];
        s1[i + 1] = __builtin_amdgcn_exp2f(fmaf(s1[i + 1], C, mc)); pd += s1[i + 1];
      }
      l_run = l_run * alpha + ((pa + pb) + (pc + pd));
      if (__any(alpha != 1.f)) {
#pragma unroll
        for (int d = 0; d < NDV; ++d)
#pragma unroll
          for (int i = 0; i < 16; ++i) oacc[d][i] *= alpha;
      }
      bf16x8 pf[4];
#pragma unroll
      for (int sp = 0; sp < 2; ++sp) {
        u32x4 w0, w1;
        w0.x = pk2(s0[8 * sp + 0], s0[8 * sp + 1]); w0.y = pk2(s0[8 * sp + 2], s0[8 * sp + 3]);
        w0.z = pk2(s0[8 * sp + 4], s0[8 * sp + 5]); w0.w = pk2(s0[8 * sp + 6], s0[8 * sp + 7]);
        w1.x = pk2(s1[8 * sp + 0], s1[8 * sp + 1]); w1.y = pk2(s1[8 * sp + 2], s1[8 * sp + 3]);
        w1.z = pk2(s1[8 * sp + 4], s1[8 * sp + 5]); w1.w = pk2(s1[8 * sp + 6], s1[8 * sp + 7]);
        pf[sp] = __builtin_bit_cast(bf16x8, w0);
        pf[2 + sp] = __builtin_bit_cast(bf16x8, w1);
      }
      {
        const char* vb0 = sb + VOFF + r * 128;
#define VFRAG(d, B) (*reinterpret_cast<const bf16x8*>(vb0 + (d) * 4096 + (((2 * (B) + h) ^ xr) << 4)))
        bf16x8 vr[4];
        vr[0] = VFRAG(0, 0); vr[1] = VFRAG(0, 1); vr[2] = VFRAG(0, 2);
#pragma unroll
        for (int f = 0; f < NDV * 4; ++f) {
          if (f + 3 < NDV * 4) vr[(f + 3) & 3] = VFRAG((f + 3) >> 2, (f + 3) & 3);
          oacc[f >> 2] = MFMA(vr[f & 3], pf[f & 3], oacc[f >> 2]);
          __builtin_amdgcn_sched_barrier(0);
        }
#undef VFRAG
      }
      __syncthreads();
      if constexpr (!DB) {
        if (j + 1 < NT) { ATT_SSTORE(lds); }
        __syncthreads();
      }
    }
#undef ATT_GLOAD
#undef ATT_SSTORE
#undef STV
#undef LDG
#undef TILE_OF
    const float il = __builtin_amdgcn_rcpf(xhalf_sum(l_run));
    if (TYPE == 0 && map == 0) {
#pragma unroll
      for (int d = 0; d < NDV; ++d) {
        f32x16 o;
#pragma unroll
        for (int i = 0; i < 16; ++i) o[i] = oacc[d][i] * il;
        st_bf16_tile(o, ya_dst + d * 32, h);
      }
    } else if (TYPE == 0) {
      const float lam = reinterpret_cast<const float*>(ws + O_LAM)[layer];
      float ss = 0.f;
#pragma unroll
      for (int d = 0; d < NDV; ++d) {
#pragma unroll
        for (int q = 0; q < 4; ++q) {
          const u32x2 w = *GPC(u32x2, ya_dst + d * 32 + 8 * q + 4 * h);
          const float v0 = bflo(w.x) - lam * (oacc[d][4 * q + 0] * il), v1 = bfhi(w.x) - lam * (oacc[d][4 * q + 1] * il);
          const float v2 = bflo(w.y) - lam * (oacc[d][4 * q + 2] * il), v3 = bfhi(w.y) - lam * (oacc[d][4 * q + 3] * il);
          oacc[d][4 * q + 0] = v0; oacc[d][4 * q + 1] = v1; oacc[d][4 * q + 2] = v2; oacc[d][4 * q + 3] = v3;
          ss += v0 * v0 + v1 * v1 + v2 * v2 + v3 * v3;
        }
      }
      ss = xhalf_sum(ss);
      const float rr = rsqrtf(ss * (1.f / 128.f) + EPS) * (1.f - P.linit[layer]);
      const float* sg = P.in[11] + layer * 128;
#pragma unroll
      for (int d = 0; d < NDV; ++d) {
        f32x16 o;
#pragma unroll
        for (int q = 0; q < 4; ++q) {
          const f32x4 g4 = *GPC(f32x4, sg + d * 32 + 8 * q + 4 * h);
          o[4 * q] = oacc[d][4 * q] * rr * g4.x; o[4 * q + 1] = oacc[d][4 * q + 1] * rr * g4.y;
          o[4 * q + 2] = oacc[d][4 * q + 2] * rr * g4.z; o[4 * q + 3] = oacc[d][4 * q + 3] * rr * g4.w;
        }
        st_bf16_tile(o, ya_dst + d * 32, h);
      }
    } else {
      u16* dst = TYPE == 1 ? reinterpret_cast<u16*>(ws + O_YA + 2 * SZ1) + (long)qrow * 1024 + head * 128
                           : reinterpret_cast<u16*>(ws + O_YA + SZ1) + (long)qrow * 1024 + head * 64;
#pragma unroll
      for (int d = 0; d < NDV; ++d) {
        f32x16 o;
#pragma unroll
        for (int i = 0; i < 16; ++i) o[i] = oacc[d][i] * il;
        st_bf16_tile(o, dst + d * 32, h);
      }
    }
  }
  __syncthreads();
}

DI void attn_phase(int layer, const Params& P, char* lds) {
  const int NITEMS = layer + 1 < DEPTH ? 4096 + 64 : 4096;
  for (int w = blockIdx.x; w < NITEMS; w += gridDim.x) {
    if (w < 1024) attn_item<64, 128, 0>(layer, w >> 3, w & 7, lds, P);
    else if (w < 2048) attn_item<192, 128, 1>(layer, (w - 1024) >> 3, w & 7, lds, P);
    else if (w < 4096) attn_item<64, 64, 2>(layer, (w - 2048) >> 4, w & 15, lds, P);
    else if (w < 4112) attn_item<64, 128, 0>(layer, 128 + ((w - 4096) >> 3), w & 7, lds, P);
    else if (w < 4128) attn_item<192, 128, 1>(layer, 128 + ((w - 4112) >> 3), w & 7, lds, P);
    else attn_item<64, 64, 2>(layer, 128 + ((w - 4128) >> 4), w & 15, lds, P);
  }
}

DI void conv_tile(const float* __restrict__ src, int K, int N, u16* __restrict__ dst, int tile, int perm, char* lds) {
  float* sm = reinterpret_cast<float*>(lds);
  const int tid = otid();
  const int nts = N >> 6;
  const int kt = tile / nts, ntile = tile - kt * nts;
  const int k0 = kt * 64, n0 = ntile * 64;
#pragma unroll
  for (int j = 0; j < 16; ++j) {
    const int k = j * 4 + (tid >> 6), n = tid & 63;
    sm[k * 65 + n] = src[(long)(k0 + k) * N + n0 + n];
  }
  __syncthreads();
#pragma unroll
  for (int j = 0; j < 2; ++j) {
    const int n = (tid >> 3) + 32 * j, kc = tid & 7;
    float v[8];
#pragma unroll
    for (int e = 0; e < 8; ++e) v[e] = sm[(kc * 8 + e) * 65 + n];
    int nn = n0 + n;
    if (perm) { const int s = nn >= FFN ? 1 : 0; const int jj = nn - s * FFN; nn = 64 * (jj >> 5) + 32 * s + (jj & 31); }
    u32x4 o; o.x = pk2(v[0], v[1]); o.y = pk2(v[2], v[3]); o.z = pk2(v[4], v[5]); o.w = pk2(v[6], v[7]);
    *GP(u32x4, dst + (long)nn * K + k0 + kc * 8) = o;
  }
  __syncthreads();
}

constexpr int CONV_TILES = 7616;
DI void conv_phase(int layer, const Params& P, char* lds, int extra_first) {
  char* ws = ows(P);
  for (int t = blockIdx.x + extra_first; t < CONV_TILES + extra_first; t += gridDim.x) {
    int x = t - extra_first;
    const float* src; int K, N, perm = 0; u16* dst;
    if (x < 2816) { const int s = x / 1408; x -= s * 1408; src = P.in[7] + ((long)(layer * 2 + s)) * DM * 2 * FFN; K = DM; N = 2 * FFN; perm = 1; dst = reinterpret_cast<u16*>(ws + O_WIN + s * SZ_WIN); }
    else if (x < 4224) { x -= 2816; const int s = x / 704; x -= s * 704; src = P.in[8] + ((long)(layer * 2 + s)) * FFN * DM; K = FFN; N = DM; dst = reinterpret_cast<u16*>(ws + O_WOUT + s * SZ_WOUT); }
    else if (x < 6320) { x -= 4224; src = P.in[9] + (long)layer * DM * MIXIN; K = DM; N = MIXIN; dst = reinterpret_cast<u16*>(ws + O_WMIX); }
    else if (x < 6464) { x -= 6320; src = P.in[15] + (long)layer * 384 * 1536; K = 384; N = 1536; dst = reinterpret_cast<u16*>(ws + O_WUQ); }
    else if (x < 6592) { x -= 6464; src = P.in[16] + (long)layer * 256 * 2048; K = 256; N = 2048; dst = reinterpret_cast<u16*>(ws + O_WUKV); }
    else if (x < 7360) { x -= 6592; const int br = x / 256; x -= br * 256; src = P.in[17] + ((long)(layer * 3 + br)) * DM * DM; K = DM; N = DM; dst = reinterpret_cast<u16*>(ws + O_WBR) + (long)br * DM * DM; }
    else { x -= 7360; src = P.in[18] + (long)layer * DM * DM; K = DM; N = DM; dst = reinterpret_cast<u16*>(ws + O_WMO); }
    conv_tile(src, K, N, dst, x, perm, lds);
  }
}

DI void mods_item(int item, const Params& P, char* lds) {
  float* sv = reinterpret_cast<float*>(lds);
  float* red = sv + 3 * 1024;
  const int tid = otid();
  const int l = item / 144, nb = item - l * 144;
  for (int e = tid; e < 3 * 1024; e += 256) {
    const int v = e >> 10, k = e & 1023;
    const float x = v < 2 ? P.in[1][v * DM + k] : P.in[3][k];
    sv[e] = x / (1.f + __expf(-x));
  }
  __syncthreads();
  const int c = tid & 63, kg = tid >> 6;
  const float* w = P.in[4] + (long)l * DM * 9216 + nb * 64 + c;
  float a0 = 0.f, a1 = 0.f, a2 = 0.f;
  for (int k = kg * 256; k < kg * 256 + 256; ++k) {
    const float wv = w[(long)k * 9216];
    a0 += sv[k] * wv; a1 += sv[1024 + k] * wv; a2 += sv[2048 + k] * wv;
  }
  red[(kg * 3 + 0) * 64 + c] = a0; red[(kg * 3 + 1) * 64 + c] = a1; red[(kg * 3 + 2) * 64 + c] = a2;
  __syncthreads();
  if (tid < 192) {
    const int v = tid >> 6, cc = tid & 63;
    float s = red[(0 * 3 + v) * 64 + cc] + red[(1 * 3 + v) * 64 + cc] + red[(2 * 3 + v) * 64 + cc] + red[(3 * 3 + v) * 64 + cc];
    const int n = nb * 64 + cc;
    reinterpret_cast<float*>(ows(P) + O_MODS)[(l * 3 + v) * 9216 + n] = s + P.in[5][l * 9216 + n];
  }
  __syncthreads();
}

DI void misc_item(const Params& P) {
  const int tid = otid();
  float* rope = reinterpret_cast<float*>(ows(P) + O_ROPE);
  for (int e = tid; e < 256 * 16; e += 256) {
    const int p = e >> 4, j = e & 15;
    const float ang = (float)p * P.inv_freq[j];
    double a = (double)ang;
    const double TWO_PI = 6.283185307179586476925;
    a -= TWO_PI * rint(a / TWO_PI);
    const double q = a * 0.25, q2 = q * q;
    double sn = q * (1.0 + q2 * (-1.0 / 6 + q2 * (1.0 / 120 + q2 * (-1.0 / 5040 + q2 * (1.0 / 362880 + q2 * (-1.0 / 39916800 + q2 * (1.0 / 6227020800.0)))))));
    double cs = 1.0 + q2 * (-0.5 + q2 * (1.0 / 24 + q2 * (-1.0 / 720 + q2 * (1.0 / 40320 + q2 * (-1.0 / 3628800 + q2 * (1.0 / 479001600.0 + q2 * (-1.0 / 87178291200.0)))))));
    double s2 = 2 * sn * cs, c2 = cs * cs - sn * sn;
    double s4 = 2 * s2 * c2, c4 = c2 * c2 - s2 * s2;
    rope[e] = (float)c4;
    rope[256 * 16 + e] = (float)s4;
  }
  if (tid < DEPTH) {
    const float* dl = P.in[10] + tid * 4 * 64;
    float d01 = 0.f, d23 = 0.f;
    for (int i = 0; i < 64; ++i) { d01 += dl[i] * dl[64 + i]; d23 += dl[128 + i] * dl[192 + i]; }
    reinterpret_cast<float*>(ows(P) + O_LAM)[tid] = expf(d01) - expf(d23) + P.linit[tid];
  }
}

#define XB_TMO      128
#define XB_XCNT(j)  (256  + 64 * (j))
#define XB_XSUB(j)  (1280 + 64 * (j))
#define XB_XGEN(j)  (2304 + 64 * (j))
#define XB_TOP      3328
#define XB_TOPGEN   3392
#define XCD_BAR_WORDS 3456
#define XB_SPIN_CAP (1u << 18)
#define LAS __attribute__((address_space(3)))
DI unsigned xb_ld(unsigned* p) { return __hip_atomic_load(p, __ATOMIC_RELAXED, __HIP_MEMORY_SCOPE_AGENT); }
DI unsigned xb_add(unsigned* p, unsigned v) { return __hip_atomic_fetch_add(p, v, __ATOMIC_RELAXED, __HIP_MEMORY_SCOPE_AGENT); }
DI unsigned xb_xcc_id() { return (unsigned)__builtin_amdgcn_s_getreg((3 << 11) | 20) & 0xFu; }
#define XB_SPIN(cond, bar) do { unsigned _sp = 0; while (cond) { __builtin_amdgcn_s_sleep(1); \
    if ((++_sp & 255u) == 0u) { if (xb_ld(&(bar)[XB_TMO])) break; if (_sp > XB_SPIN_CAP) { atomicAdd(&(bar)[XB_TMO], 1u); break; } } } } while (0)
struct XcdBarrier { unsigned* bar; unsigned x; volatile LAS unsigned* st; };
DI XcdBarrier xcd_barrier_post(unsigned* bar, volatile LAS unsigned* st) {
  XcdBarrier b; b.bar = bar; b.x = xb_xcc_id(); b.st = st;
  if (threadIdx.x == 0) (void)xb_add(&bar[XB_XCNT(b.x)], 1u);
  return b;
}
DI void xcd_barrier_complete(unsigned* bar, unsigned x, unsigned& nloc, unsigned& nx) {
  const unsigned G = gridDim.x * gridDim.y * gridDim.z;
  unsigned sum, cnt, mine, sp = 0u;
  for (;;) {
    sum = 0u; cnt = 0u; mine = 0u;
#pragma unroll
    for (unsigned j = 0; j < 16; ++j) { const unsigned c = xb_ld(&bar[XB_XCNT(j)]); sum += c; cnt += (c > 0u) ? 1u : 0u; mine = (j == x) ? c : mine; }
    if (sum == G) break;
    __builtin_amdgcn_s_sleep(1);
    if ((++sp & 255u) == 0u) { if (xb_ld(&bar[XB_TMO])) break; if (sp > XB_SPIN_CAP) { atomicAdd(&bar[XB_TMO], 1u); break; } }
  }
  nloc = mine > 0u ? mine : 1u; nx = cnt > 0u ? cnt : 1u;
}
DI void xcd_barrier(const XcdBarrier& b) {
  asm volatile("s_waitcnt vmcnt(0)" ::: "memory");
  __syncthreads();
  if (threadIdx.x == 0) {
    unsigned* bar = b.bar;
    __builtin_amdgcn_s_waitcnt(0);
    unsigned nloc = b.st[0], nx = b.st[1];
    if (nloc == 0u) { xcd_barrier_complete(bar, b.x, nloc, nx); b.st[0] = nloc; b.st[1] = nx; }
    const unsigned old = xb_add(&bar[XB_XSUB(b.x)], 1u);
    const unsigned gen = old / nloc;
    if (old + 1u == (gen + 1u) * nloc) {
      __builtin_amdgcn_fence(__ATOMIC_RELEASE, "agent");
      asm volatile("s_waitcnt vmcnt(0)" ::: "memory");
      const unsigned og = xb_add(&bar[XB_TOP], 1u);
      const unsigned tg = og / nx;
      if (og + 1u == (tg + 1u) * nx) xb_add(&bar[XB_TOPGEN], 1u);
      else XB_SPIN(xb_ld(&bar[XB_TOPGEN]) == tg, bar);
      __builtin_amdgcn_fence(__ATOMIC_ACQUIRE, "agent");
      xb_add(&bar[XB_XGEN(b.x)], 1u);
      asm volatile("s_waitcnt vmcnt(0)" ::: "memory");
    } else {
      XB_SPIN(xb_ld(&bar[XB_XGEN(b.x)]) == gen, bar);
      __builtin_amdgcn_fence(__ATOMIC_ACQUIRE, "agent");
      asm volatile("s_waitcnt vmcnt(0)" ::: "memory");
    }
  }
  __syncthreads();
}

constexpr size_t LDS_BYTES = 65536 + 64;
constexpr int NPL = 23;
constexpr int NPH = 1 + DEPTH * NPL;

__global__ void __launch_bounds__(256, 2) fwd_megakernel(Params P) {
  extern __shared__ __attribute__((aligned(16))) char lds[];
  cg::grid_group grid = cg::this_grid();
  volatile LAS unsigned* xst = (volatile LAS unsigned*)(lds + 65536);
  if (threadIdx.x == 0) { xst[0] = 0u; xst[1] = 0u; }
  __syncthreads();
  const XcdBarrier xb = xcd_barrier_post(reinterpret_cast<unsigned*>(P.ws + O_BAR), xst);
  char* ws = P.ws;
  u16* U = reinterpret_cast<u16*>(ws + O_U);
  float* tctx = reinterpret_cast<float*>(ws + O_TCTX);
  for (int ph = 0; ph < NPH; ++ph) {
    int kind = 0;
    GemmDesc gd; RowDesc rd;
    gd.skipctx = 0; gd.epi = 0; gd.mtiles = 0; gd.ntiles = 0; gd.K = 0; gd.lda = 0; gd.A = nullptr; gd.W = nullptr; gd.dst = nullptr;
    rd.skipctx = 0; rd.g0 = 0; rd.g1 = 0; rd.told_lat = P.out; rd.told_ctx = tctx; rd.ybuf = nullptr; rd.yrow0 = 0; rd.gscale = 1.f;
    rd.gate_idx = 0; rd.gpost_idx = 0; rd.layer = 0; rd.has_u = 0; rd.ulayer = 0; rd.gpre_idx = 0; rd.shift_idx = 0; rd.scale_idx = 0;
    int layer = 0, conv_layer = -1;
    if (ph == 0) {
      for (int t = blockIdx.x; t < 289; t += gridDim.x) { if (t < 288) mods_item(t, P, lds); else misc_item(P); }
      conv_phase(0, P, lds, 0);
    } else {
      layer = (ph - 1) / NPL;
      const int q = (ph - 1) - layer * NPL;
      const bool first = layer == 0;
      if (q == 0) {
        if (first) { kind = 2; rd.g0 = 0; rd.g1 = MT; rd.told_lat = P.in[0]; rd.told_ctx = P.in[2]; rd.has_u = 1; rd.ulayer = 0; rd.gpre_idx = 0; rd.shift_idx = 0; rd.scale_idx = 1; }
        else kind = -1;
      } else if (q == 1 || q == 20) {
        const int s = q == 1 ? 0 : 1;
        kind = 1; gd.epi = EPI_SWIGLU; gd.mtiles = MT / 128;
        if (s == 1 && layer + 1 == DEPTH) { gd.mtiles = 256; gd.skipctx = 1; } gd.ntiles = 44; gd.K = DM; gd.lda = DM; gd.A = U;
        gd.W = reinterpret_cast<const u16*>(ws + O_WIN + s * SZ_WIN); gd.dst = ws + O_ACT;
      } else if (q == 2 || q == 21) {
        const int s = q == 2 ? 0 : 1;
        kind = 1; gd.epi = EPI_YF32; gd.mtiles = MT / 128;
        if (s == 1 && layer + 1 == DEPTH) { gd.mtiles = 256; gd.skipctx = 1; } gd.ntiles = 8; gd.K = FFN; gd.lda = FFN; gd.A = reinterpret_cast<const u16*>(ws + O_ACT);
        gd.W = reinterpret_cast<const u16*>(ws + O_WOUT + s * SZ_WOUT); gd.dst = ws + O_Y;
      } else if (q == 3) {
        kind = 2; rd.g0 = 0; rd.g1 = MT;
        if (first) { rd.told_lat = P.in[0]; rd.told_ctx = P.in[2]; }
        rd.ybuf = reinterpret_cast<const float*>(ws + O_Y); rd.yrow0 = 0; rd.gscale = 0.5f; rd.gate_idx = 2; rd.gpost_idx = 1; rd.layer = layer;
        rd.has_u = 1; rd.ulayer = layer; rd.gpre_idx = 2; rd.shift_idx = 3; rd.scale_idx = 4;
      } else if (q < 20) {
        const int b = (q - 4) >> 3, qq = (q - 4) & 7;
        const u16* Ub = U + (long)b * MB * DM;
        const int mtq = layer + 1 == DEPTH ? 128 : 130;
        if (qq == 0) { kind = 1; gd.epi = EPI_PROJ; gd.mtiles = 130; gd.ntiles = 42; gd.K = DM; gd.lda = DM; gd.A = Ub; gd.W = reinterpret_cast<const u16*>(ws + O_WMIX); }
        else if (qq == 1) { kind = 3; }
        else if (qq == 2) { kind = 1; gd.epi = EPI_UQKV; gd.mtiles = 130; gd.ntiles = 28; }
        else if (qq == 3) { kind = 4; }
        else if (qq == 4) { kind = 1; gd.epi = EPI_SG; gd.mtiles = mtq; gd.ntiles = 24; gd.K = DM; gd.lda = DM; gd.A = Ub; gd.W = reinterpret_cast<const u16*>(ws + O_WMIX) + (long)NPROJ * DM; gd.dst = ws + O_SG; }
        else if (qq == 5) { kind = 5; gd.epi = EPI_MERGE; gd.mtiles = mtq; gd.ntiles = 8; gd.K = DM; gd.lda = DM; gd.A = reinterpret_cast<const u16*>(ws + O_YA); gd.W = reinterpret_cast<const u16*>(ws + O_WBR); gd.dst = ws + O_MERGED; }
        else if (qq == 6) { kind = 1; gd.epi = EPI_YF32; gd.mtiles = mtq; gd.ntiles = 8; gd.K = DM; gd.lda = DM; gd.A = reinterpret_cast<const u16*>(ws + O_MERGED); gd.W = reinterpret_cast<const u16*>(ws + O_WMO); gd.dst = ws + O_YO; }
        else {
          kind = 2; rd.g0 = b * MB; rd.g1 = (b + 1) * MB; rd.skipctx = layer + 1 == DEPTH; rd.ybuf = reinterpret_cast<const float*>(ws + O_YO); rd.yrow0 = b * MB; rd.gscale = 1.f;
          rd.gate_idx = 5; rd.gpost_idx = 3; rd.layer = layer; rd.has_u = 1; rd.ulayer = layer; rd.gpre_idx = 4; rd.shift_idx = 6; rd.scale_idx = 7;
        }
      } else {
        kind = 2; rd.g0 = 0; rd.g1 = MT; rd.skipctx = layer + 1 == DEPTH; rd.ybuf = reinterpret_cast<const float*>(ws + O_Y); rd.yrow0 = 0; rd.gscale = 0.5f; rd.gate_idx = 8; rd.gpost_idx = 5; rd.layer = layer;
        if (layer + 1 < DEPTH) { rd.has_u = 1; rd.ulayer = layer + 1; rd.gpre_idx = 0; rd.shift_idx = 0; rd.scale_idx = 1; conv_layer = layer + 1; }
      }
    }
    if (kind == 1) gemm_phase<false>(gd, P, lds);
    else if (kind == 5) gemm_phase<true>(gd, P, lds);
    else if (kind == 2) rowop_phase(rd, P);
    else if (kind == 3) r3_phase(layer, P);
    else if (kind == 4) attn_phase(layer, P, lds);
    if (conv_layer >= 0) conv_phase(conv_layer, P, lds, 0);
    if (kind != -1 && ph + 1 < NPH) {
      if (P.pad[0] == 0x7fffffff) grid.sync();
      xcd_barrier(xb);
    }
  }
}

extern "C" void kernel_launch(void* const* d_in, const int* in_sizes, int n_in, void* d_out, int out_size, void* d_ws, size_t ws_size,
                              hipStream_t stream) {
  static int grid_blocks = 0;
  if (!grid_blocks) {
    int dev = 0, cus = 0, per_cu = 0;
    (void)hipGetDevice(&dev);
    (void)hipDeviceGetAttribute(&cus, hipDeviceAttributeMultiprocessorCount, dev);
    (void)hipFuncSetAttribute((const void*)fwd_megakernel, hipFuncAttributeMaxDynamicSharedMemorySize, (int)LDS_BYTES);
    (void)hipOccupancyMaxActiveBlocksPerMultiprocessor(&per_cu, fwd_megakernel, 256, LDS_BYTES);
    if (per_cu > 2) per_cu = 2;
    if (per_cu < 1) per_cu = 1;
    grid_blocks = cus * per_cu;
    fprintf(stderr, "megakernel: cus %d per_cu %d grid %d ws_need %zu ws_size %zu\n", cus, per_cu, grid_blocks, (size_t)WS_NEED, ws_size);
  }
  if (n_in != 19 || ws_size < WS_NEED) {
    fprintf(stderr, "kernel_launch: bad setup n_in %d ws_size %zu need %zu\n", n_in, ws_size, (size_t)WS_NEED);
    return;
  }
  Params p{};
  for (int i = 0; i < 19; ++i) p.in[i] = reinterpret_cast<const float*>(d_in[i]);
  p.out = reinterpret_cast<float*>(d_out);
  p.ws = reinterpret_cast<char*>(d_ws);
  for (int j = 0; j < 16; ++j) p.inv_freq[j] = 1.0f / powf(10000.0f, (float)j / 16.0f);
  for (int l = 0; l < DEPTH; ++l) p.linit[l] = (float)(0.8 - 0.6 * exp(-0.3 * (double)l));
  (void)hipMemsetAsync(reinterpret_cast<char*>(d_ws) + O_BAR, 0, XCD_BAR_WORDS * 4, stream);
  void* args[] = {&p};
  hipError_t e = hipLaunchCooperativeKernel((void*)fwd_megakernel, dim3(grid_blocks), dim3(256), args, LDS_BYTES, stream);
  if (e != hipSuccess) fprintf(stderr, "cooperative launch failed: %s (grid %d)\n", hipGetErrorString(e), grid_blocks);
}
```

```cpp
#include <hip/hip_runtime.h>
#include <hip/hip_cooperative_groups.h>
#include <cstdio>
#include <cstdint>
#include <cmath>
namespace cg = cooperative_groups;

typedef unsigned short u16;
using bf16x8 = __attribute__((ext_vector_type(8))) short;
using f32x16 = __attribute__((ext_vector_type(16))) float;
using u32x4 = __attribute__((ext_vector_type(4))) unsigned;
using u32x2 = __attribute__((ext_vector_type(2))) unsigned;
using f32x4 = __attribute__((ext_vector_type(4))) float;
#define GAS __attribute__((address_space(1)))
#define GP(T, p) (reinterpret_cast<GAS T*>(reinterpret_cast<uintptr_t>(p)))
#define GPC(T, p) (reinterpret_cast<const GAS T*>(reinterpret_cast<uintptr_t>(p)))
typedef __bf16 bf2_t __attribute__((ext_vector_type(2)));
typedef float f2_t __attribute__((ext_vector_type(2)));
#define DI __device__ __forceinline__
#define MFMA(a, b, c) __builtin_amdgcn_mfma_f32_32x32x16_bf16((a), (b), (c), 0, 0, 0)

constexpr int DM = 1024, NB = 2, SEQ = 16384, CTX = 256, DEPTH = 2;
constexpr int MB = SEQ + CTX;
constexpr int MT = NB * MB;
constexpr int FFN = 2816;
constexpr int MIXIN = 8384, NPROJ = 5312;
constexpr float EPS = 1e-6f;
constexpr float LOG2E = 1.4426950408889634f;

constexpr size_t SZ_WIN = (size_t)2 * FFN * DM * 2;
constexpr size_t SZ_WOUT = (size_t)DM * FFN * 2;
constexpr size_t O_WIN = 0;
constexpr size_t O_WOUT = O_WIN + 2 * SZ_WIN;
constexpr size_t O_WMIX = O_WOUT + 2 * SZ_WOUT;
constexpr size_t O_WUQ = O_WMIX + (size_t)MIXIN * DM * 2;
constexpr size_t O_WUKV = O_WUQ + (size_t)1536 * 384 * 2;
constexpr size_t O_WBR = O_WUKV + (size_t)2048 * 256 * 2;
constexpr size_t O_WMO = O_WBR + (size_t)3 * DM * DM * 2;
constexpr size_t O_MODS = O_WMO + (size_t)DM * DM * 2;
constexpr size_t O_ROPE = O_MODS + (size_t)DEPTH * 3 * 9216 * 4;
constexpr size_t O_LAM = O_ROPE + 2 * 256 * 16 * 4;
constexpr size_t O_BAR = O_LAM + 256;
constexpr size_t O_TCTX = O_BAR + 16384;
constexpr size_t O_U = O_TCTX + (size_t)NB * CTX * DM * 4;
constexpr size_t O_RX = O_U + (size_t)MT * DM * 2;
constexpr size_t O_ACT = O_RX;
constexpr size_t O_Y = O_ACT + (size_t)MT * FFN * 2;
constexpr size_t END_FFN = O_Y + (size_t)MT * DM * 4;
constexpr size_t SZ1 = (size_t)MB * DM * 2;
constexpr size_t SZQ = (size_t)MB * 256 * 2;
constexpr size_t O_QA = O_RX;
constexpr size_t O_KA = O_QA + SZ1;
constexpr size_t O_VAT = O_KA + SZ1;
constexpr size_t O_QB = O_VAT + SZ1;
constexpr size_t O_KB = O_QB + SZ1;
constexpr size_t O_VBT = O_KB + SZQ;
constexpr size_t O_CQ = O_VBT + SZQ;
constexpr size_t O_CKV = O_CQ + (size_t)MB * 384 * 2;
constexpr size_t O_KR = O_CKV + SZQ;
constexpr size_t O_QC = O_KR + (size_t)MB * 64 * 2;
constexpr size_t O_KCN = O_QC + (size_t)MB * 1536 * 2;
constexpr size_t O_VCT = O_KCN + SZ1;
constexpr size_t O_YA = O_VCT + SZ1;
constexpr size_t END_MIX = O_YA + 3 * SZ1;
constexpr size_t O_SG = O_QA;
constexpr size_t O_MERGED = O_QB;
constexpr size_t O_YO = O_KCN;
constexpr size_t WS_NEED = END_MIX > END_FFN ? END_MIX : END_FFN;

struct Params {
  const float* in[19];
  float* out;
  char* ws;
  float inv_freq[16];
  float linit[2];
  int pad[2];
};

DI int otid() { int t = threadIdx.x; asm volatile("" : "+v"(t)); return t; }
DI char* ows(const Params& P) {
  const unsigned long long w = reinterpret_cast<unsigned long long>(P.ws);
  unsigned lo = __builtin_amdgcn_readfirstlane((unsigned)w), hi = __builtin_amdgcn_readfirstlane((unsigned)(w >> 32));
  asm volatile("" : "+s"(lo), "+s"(hi));
  return reinterpret_cast<char*>(((unsigned long long)hi << 32) | lo);
}
DI const char* uptr(const void* p) {
  const unsigned long long w = reinterpret_cast<unsigned long long>(p);
  const unsigned lo = __builtin_amdgcn_readfirstlane((unsigned)w), hi = __builtin_amdgcn_readfirstlane((unsigned)(w >> 32));
  return reinterpret_cast<const char*>(((unsigned long long)hi << 32) | lo);
}
DI int crow(int i, int h) { return (i & 3) + 8 * (i >> 2) + 4 * h; }
DI unsigned pk2(float a, float b) { f2_t v = {a, b}; bf2_t r = __builtin_convertvector(v, bf2_t); return __builtin_bit_cast(unsigned, r); }
DI float bflo(unsigned x) { return __uint_as_float(x << 16); }
DI float bfhi(unsigned x) { return __uint_as_float(x & 0xffff0000u); }
DI float wave_sum(float v) {
#pragma unroll
  for (int o = 32; o > 0; o >>= 1) v += __shfl_xor(v, o);
  return v;
}
DI float xhalf_max(float v) {
  auto rr = __builtin_amdgcn_permlane32_swap(__float_as_uint(v), __float_as_uint(v), false, false);
  return fmaxf(__uint_as_float(rr[0]), __uint_as_float(rr[1]));
}
DI float xhalf_sum(float v) {
  auto rr = __builtin_amdgcn_permlane32_swap(__float_as_uint(v), __float_as_uint(v), false, false);
  return __uint_as_float(rr[0]) + __uint_as_float(rr[1]);
}
DI float vmax3(float a, float b, float c) { float r; asm("v_max3_f32 %0, %1, %2, %3" : "=v"(r) : "v"(a), "v"(b), "v"(c)); return r; }
DI float sigmoidf_(float x) { return __builtin_amdgcn_rcpf(1.f + __builtin_amdgcn_exp2f(-LOG2E * x)); }
DI void st_bf16_tile(const f32x16& c, u16* dst, int h) {
#pragma unroll
  for (int q = 0; q < 4; ++q) {
    u32x2 v; v.x = pk2(c[4 * q], c[4 * q + 1]); v.y = pk2(c[4 * q + 2], c[4 * q + 3]);
    *GP(u32x2, dst + 8 * q + 4 * h) = v;
  }
}
DI void st_bf16_tile_vt(const f32x16& c, u16* dst, int h) {
#pragma unroll
  for (int q = 0; q < 4; ++q) {
    u32x2 v; v.x = pk2(c[4 * q], c[4 * q + 1]); v.y = pk2(c[4 * q + 2], c[4 * q + 3]);
    *GP(u32x2, dst + 16 * (q >> 1) + 8 * h + 4 * (q & 1)) = v;
  }
}
DI void st_f32_tile(const f32x16& c, float* dst, int h) {
#pragma unroll
  for (int q = 0; q < 4; ++q) {
    f32x4 v = {c[4 * q], c[4 * q + 1], c[4 * q + 2], c[4 * q + 3]};
    *GP(f32x4, dst + 8 * q + 4 * h) = v;
  }
}
DI void rope_tile(f32x16& c, const float* __restrict__ rope, int idx, int h) {
  const float* cp = rope + idx * 16 + 4 * h;
  const float* sp = cp + 256 * 16;
  const f32x4 c0 = *GPC(f32x4, cp), c1 = *GPC(f32x4, cp + 8);
  const f32x4 s0 = *GPC(f32x4, sp), s1 = *GPC(f32x4, sp + 8);
#define ROPE1(i, CS, SN) { const float x1 = c[i], x2 = c[(i) + 8]; c[i] = x1 * (CS) - x2 * (SN); c[(i) + 8] = x2 * (CS) + x1 * (SN); }
  ROPE1(0, c0.x, s0.x) ROPE1(1, c0.y, s0.y) ROPE1(2, c0.z, s0.z) ROPE1(3, c0.w, s0.w)
  ROPE1(4, c1.x, s1.x) ROPE1(5, c1.y, s1.y) ROPE1(6, c1.z, s1.z) ROPE1(7, c1.w, s1.w)
#undef ROPE1
}

template <bool TRANS>
DI void gemm_kloop(const u16* __restrict__ A, int lda, const u16* __restrict__ W, int ldw, int K, f32x16 (&acc)[2][2], char* lds) {
  const int tid = otid(), lane = tid & 63, wid = tid >> 6, r = lane & 31, h = lane >> 5;
  const int wm = wid >> 1, wn = wid & 1;
  const int lrow = tid >> 3, lkc = tid & 7;
  const unsigned voa = (unsigned)(lrow * lda + lkc * 8) * 2u, vob = (unsigned)(lrow * ldw + lkc * 8) * 2u;
  const char* Ab = reinterpret_cast<const char*>(A);
  const char* Wb = reinterpret_cast<const char*>(W);
  const int soff0 = lrow * 128 + ((lkc ^ ((lrow >> 1) & 7)) << 4);
  u32x4 ra0, ra1, ra2, ra3, rb0, rb1, rb2, rb3, rc0, rc1, rc2, rc3, rd0, rd1, rd2, rd3;
#define GLOAD(A0, A1, A2, A3, B0, B1, B2, B3, k0)                                \
  {                                                                              \
    const char* pa_ = Ab + (long)(k0) * 2;                                       \
    const char* pw_ = Wb + (long)(k0) * 2;                                       \
    A0 = *GPC(u32x4, uptr(pa_) + voa);                                           \
    A1 = *GPC(u32x4, uptr(pa_ + (long)64 * lda) + voa);                          \
    A2 = *GPC(u32x4, uptr(pa_ + (long)128 * lda) + voa);                         \
    A3 = *GPC(u32x4, uptr(pa_ + (long)192 * lda) + voa);                         \
    B0 = *GPC(u32x4, uptr(pw_) + vob);                                           \
    B1 = *GPC(u32x4, uptr(pw_ + (long)64 * ldw) + vob);                          \
    B2 = *GPC(u32x4, uptr(pw_ + (long)128 * ldw) + vob);                         \
    B3 = *GPC(u32x4, uptr(pw_ + (long)192 * ldw) + vob);                         \
  }
#define SSTORE(A0, A1, A2, A3, B0, B1, B2, B3, bufi)                             \
  {                                                                              \
    char* sb = lds + (bufi) * 32768 + soff0;                                     \
    *reinterpret_cast<u32x4*>(sb) = A0;                                          \
    *reinterpret_cast<u32x4*>(sb + 4096) = A1;                                   \
    *reinterpret_cast<u32x4*>(sb + 8192) = A2;                                   \
    *reinterpret_cast<u32x4*>(sb + 12288) = A3;                                  \
    *reinterpret_cast<u32x4*>(sb + 16384) = B0;                                  \
    *reinterpret_cast<u32x4*>(sb + 16384 + 4096) = B1;                           \
    *reinterpret_cast<u32x4*>(sb + 16384 + 8192) = B2;                           \
    *reinterpret_cast<u32x4*>(sb + 16384 + 12288) = B3;                          \
  }
#define SET0 ra0, ra1, ra2, ra3, rb0, rb1, rb2, rb3
#define SET1 rc0, rc1, rc2, rc3, rd0, rd1, rd2, rd3
#define GL(...) GLOAD(__VA_ARGS__)
#define SS(...) SSTORE(__VA_ARGS__)
  const int KT = K >> 6;
  const int xr = (r >> 1) & 7;
  const int aoff = (wm * 64 + r) * 128, boff = 16384 + (wn * 64 + r) * 128;
#define COMPUTE(bufi)                                                                                                              \
  {                                                                                                                                \
    const char* buf = lds + (bufi) * 32768;                                                                                        \
    bf16x8 a0n, a1n, b0n, b1n;                                                                                                     \
    {                                                                                                                              \
      const int co = (h ^ xr) << 4;                                                                                                \
      a0n = *reinterpret_cast<const bf16x8*>(buf + aoff + co); a1n = *reinterpret_cast<const bf16x8*>(buf + aoff + 4096 + co);     \
      b0n = *reinterpret_cast<const bf16x8*>(buf + boff + co); b1n = *reinterpret_cast<const bf16x8*>(buf + boff + 4096 + co);     \
    }                                                                                                                              \
    _Pragma("unroll") for (int s = 0; s < 4; ++s) {                                                                                \
      const bf16x8 a0 = a0n, a1 = a1n, b0 = b0n, b1 = b1n;                                                                         \
      if (s < 3) {                                                                                                                 \
        const int co = ((2 * (s + 1) + h) ^ xr) << 4;                                                                              \
        a0n = *reinterpret_cast<const bf16x8*>(buf + aoff + co); a1n = *reinterpret_cast<const bf16x8*>(buf + aoff + 4096 + co);   \
        b0n = *reinterpret_cast<const bf16x8*>(buf + boff + co); b1n = *reinterpret_cast<const bf16x8*>(buf + boff + 4096 + co);   \
      }                                                                                                                            \
      if (TRANS) {                                                                                                                 \
        acc[0][0] = MFMA(a0, b0, acc[0][0]); acc[0][1] = MFMA(a0, b1, acc[0][1]);                                                  \
        acc[1][0] = MFMA(a1, b0, acc[1][0]); acc[1][1] = MFMA(a1, b1, acc[1][1]);                                                  \
      } else {                                                                                                                     \
        acc[0][0] = MFMA(b0, a0, acc[0][0]); acc[0][1] = MFMA(b1, a0, acc[0][1]);                                                  \
        acc[1][0] = MFMA(b0, a1, acc[1][0]); acc[1][1] = MFMA(b1, a1, acc[1][1]);                                                  \
      }                                                                                                                            \
      __builtin_amdgcn_sched_barrier(0);                                                                                           \
    }                                                                                                                              \
  }
  GL(SET0, 0);
  SS(SET0, 0);
  GL(SET1, 64);
  __syncthreads();
  for (int kt = 0; kt < KT; kt += 2) {
    const bool m2 = kt + 2 < KT;
    if (m2) { GL(SET0, (kt + 2) * 64); }
    COMPUTE(0);
    SS(SET1, 1);
    __syncthreads();
    if (m2) { GL(SET1, (kt + 3) * 64); }
    COMPUTE(1);
    if (m2) { SS(SET0, 0); }
    __syncthreads();
  }
#undef GLOAD
#undef SSTORE
#undef SET0
#undef SET1
#undef GL
#undef SS
#undef COMPUTE
}

enum { EPI_SWIGLU = 0, EPI_YF32 = 1, EPI_PROJ = 2, EPI_UQKV = 3, EPI_SG = 4, EPI_MERGE = 5 };
struct GemmDesc {
  int epi, mtiles, ntiles, K, lda, skipctx;
  const u16* A; const u16* W;
  void* dst;
};

template <bool MERGE>
DI void gemm_phase(const GemmDesc& d, const Params& P, char* lds) {
  const int tid = otid(), lane = tid & 63, wid = tid >> 6, r = lane & 31, h = lane >> 5;
  const int wm = wid >> 1, wn = wid & 1;
  char* ws = ows(P);
  const float* rope = reinterpret_cast<const float*>(ws + O_ROPE);
  const int ntl = d.mtiles * d.ntiles;
  for (int t = blockIdx.x; t < ntl; t += gridDim.x) {
    int mt = t / d.ntiles;
    int nt = t - mt * d.ntiles;
    if (d.ntiles == 8) {
      const int m4 = d.mtiles & ~3;
      if (t < 8 * m4) {
        const int x = t & 7, k = t >> 3;
        nt = 4 * (x & 1) + (k & 3);
        mt = 4 * (k >> 2) + (x >> 1);
      }
    }
    if (d.skipctx && mt >= 128) mt += 2;
    const u16* A = d.A; const u16* W = d.W; int lda = d.lda, K = d.K;
    bool trans = false;
    int uq = 0;
    if (d.epi == EPI_PROJ) {
      const int n0 = nt * 128;
      trans = (n0 >= 2048 && n0 < 3072) || (n0 >= 4352 && n0 < 4608);
    } else if (d.epi == EPI_UQKV) {
      if (nt < 12) { uq = 1; A = reinterpret_cast<const u16*>(ws + O_CQ); lda = 384; K = 384; W = reinterpret_cast<const u16*>(ws + O_WUQ); }
      else { nt -= 12; A = reinterpret_cast<const u16*>(ws + O_CKV); lda = 256; K = 256; W = reinterpret_cast<const u16*>(ws + O_WUKV); trans = (nt & 1); }
    }
    const int n0 = nt * 128;
    constexpr int nrep = MERGE ? 3 : 1;
    f32x16 acc[2][2];
#pragma unroll 1
    for (int rep = 0; rep < nrep; ++rep) {
#pragma unroll
      for (int a = 0; a < 2; ++a)
#pragma unroll
        for (int b = 0; b < 2; ++b)
#pragma unroll
          for (int i = 0; i < 16; ++i) acc[a][b][i] = 0.f;
      const u16* Ar = A + (long)rep * ((long)MB * DM) + (long)(mt * 128) * lda;
      const u16* Wr = W + (long)rep * ((long)DM * DM) + (long)n0 * K;
      if (trans) gemm_kloop<true>(Ar, lda, Wr, K, K, acc, lds);
      else gemm_kloop<false>(Ar, lda, Wr, K, K, acc, lds);
      if constexpr (MERGE) {
        const u16* sg = reinterpret_cast<const u16*>(ws + O_SG);
        float* macc = reinterpret_cast<float*>(ws + O_YO);
        u16* mo = reinterpret_cast<u16*>(d.dst);
#pragma unroll
        for (int mi = 0; mi < 2; ++mi)
#pragma unroll
          for (int ni = 0; ni < 2; ++ni) {
            const long row = mt * 128 + wm * 64 + mi * 32 + r;
            const int col = n0 + wn * 64 + ni * 32 + 4 * h;
            const u16* gp = sg + row * 3072 + rep * 1024 + col;
            float* mp = macc + row * DM + col;
#pragma unroll
            for (int q = 0; q < 4; ++q) {
              const u32x2 g = *GPC(u32x2, gp + 8 * q);
              f32x4 v = {0.f, 0.f, 0.f, 0.f};
              if (rep > 0) v = *GPC(f32x4, mp + 8 * q);
              v.x += bflo(g.x) * acc[mi][ni][4 * q + 0]; v.y += bfhi(g.x) * acc[mi][ni][4 * q + 1];
              v.z += bflo(g.y) * acc[mi][ni][4 * q + 2]; v.w += bfhi(g.y) * acc[mi][ni][4 * q + 3];
              if (rep < 2) *GP(f32x4, mp + 8 * q) = v;
              else { u32x2 o = {pk2(v.x, v.y), pk2(v.z, v.w)}; *GP(u32x2, mo + row * DM + col + 8 * q) = o; }
            }
          }
      }
    }
    const int cb = n0 + wn * 64;
    const int rowb = mt * 128 + wm * 64;
    if constexpr (MERGE) {
    } else if (d.epi == EPI_SWIGLU) {
      u16* act = reinterpret_cast<u16*>(d.dst);
      const int acol = (n0 >> 1) + wn * 32;
#pragma unroll
      for (int mi = 0; mi < 2; ++mi) {
        f32x16 o;
#pragma unroll
        for (int i = 0; i < 16; ++i) { float a = acc[mi][0][i], b = acc[mi][1][i]; o[i] = a * sigmoidf_(a) * b; }
        st_bf16_tile(o, act + (long)(rowb + mi * 32 + r) * FFN + acol, h);
      }
    } else if (d.epi == EPI_YF32) {
      float* y = reinterpret_cast<float*>(d.dst);
#pragma unroll
      for (int mi = 0; mi < 2; ++mi)
#pragma unroll
        for (int ni = 0; ni < 2; ++ni) st_f32_tile(acc[mi][ni], y + (long)(rowb + mi * 32 + r) * DM + cb + ni * 32, h);
    } else if (d.epi == EPI_SG) {
      u16* sg = reinterpret_cast<u16*>(d.dst);
#pragma unroll
      for (int mi = 0; mi < 2; ++mi)
#pragma unroll
        for (int ni = 0; ni < 2; ++ni) {
          f32x16 o;
#pragma unroll
          for (int i = 0; i < 16; ++i) o[i] = sigmoidf_(acc[mi][ni][i]);
          st_bf16_tile(o, sg + (long)(rowb + mi * 32 + r) * 3072 + cb + ni * 32, h);
        }
    } else if (trans) {
      u16* vt; int f0;
      if (d.epi == EPI_PROJ) {
        if (cb < 3072) { vt = reinterpret_cast<u16*>(ws + O_VAT); f0 = cb - 2048; }
        else { vt = reinterpret_cast<u16*>(ws + O_VBT); f0 = cb - 4352; }
      } else { vt = reinterpret_cast<u16*>(ws + O_VCT); f0 = (nt >> 1) * 128 + wn * 64; }
#pragma unroll
      for (int mi = 0; mi < 2; ++mi)
#pragma unroll
        for (int ni = 0; ni < 2; ++ni) st_bf16_tile_vt(acc[mi][ni], vt + (long)(f0 + ni * 32 + r) * MB + rowb + mi * 32, h);
    } else {
      u16* dst = nullptr; int ld = 0, cofs = 0; bool rp = false;
      if (d.epi == EPI_PROJ) {
        if (cb < 1024) { dst = reinterpret_cast<u16*>(ws + O_QA); ld = 1024; cofs = cb; rp = true; }
        else if (cb < 2048) { dst = reinterpret_cast<u16*>(ws + O_KA); ld = 1024; cofs = cb - 1024; rp = true; }
        else if (cb < 4096) { dst = reinterpret_cast<u16*>(ws + O_QB); ld = 1024; cofs = cb - 3072; rp = true; }
        else if (cb < 4352) { dst = reinterpret_cast<u16*>(ws + O_KB); ld = 256; cofs = cb - 4096; rp = true; }
        else if (cb < 4992) { dst = reinterpret_cast<u16*>(ws + O_CQ); ld = 384; cofs = cb - 4608; }
        else if (cb < 5248) { dst = reinterpret_cast<u16*>(ws + O_CKV); ld = 256; cofs = cb - 4992; }
        else if (cb < 5312) { dst = reinterpret_cast<u16*>(ws + O_KR); ld = 64; cofs = 0; rp = true; }
      } else {
        if (uq) { dst = reinterpret_cast<u16*>(ws + O_QC); ld = 1536; cofs = cb; rp = (cb % 192) == 128; }
        else { dst = reinterpret_cast<u16*>(ws + O_KCN); ld = 1024; cofs = (nt >> 1) * 128 + wn * 64; }
      }
      if (dst != nullptr) {
        const bool latent = mt < 128;
#pragma unroll
        for (int mi = 0; mi < 2; ++mi) {
          const int lr = rowb + mi * 32 + r;
#pragma unroll
          for (int ni = 0; ni < 2; ++ni) {
            f32x16 o = acc[mi][ni];
            if (rp && latent) rope_tile(o, rope, ni == 0 ? (lr >> 6) : (lr & 63), h);
            st_bf16_tile(o, dst + (long)lr * ld + cofs + ni * 32, h);
          }
        }
      }
    }
  }
}

struct RowDesc {
  int g0, g1, skipctx;
  const float* told_lat; const float* told_ctx;
  const float* ybuf; int yrow0;
  float gscale; int gate_idx, gpost_idx, layer;
  int has_u, ulayer, gpre_idx, shift_idx, scale_idx;
};

DI void rowop_phase(const RowDesc& d, const Params& P) {
  const int tid_ = otid(); const int lane = tid_ & 63, wid = tid_ >> 6;
  char* ws = ows(P);
  const float* mods = reinterpret_cast<const float*>(ws + O_MODS);
  const float* normg = P.in[6];
  float* tctx = reinterpret_cast<float*>(ws + O_TCTX);
  u16* U = reinterpret_cast<u16*>(ws + O_U);
  const int stride = gridDim.x * 4;
  const bool has_y = d.ybuf != nullptr;
  f32x4 tn[4], yn[4];
  bool vn = false;
#define LOADROW(g_)                                                                                              \
  {                                                                                                              \
    const int b_ = (g_) / MB, i_ = (g_) - b_ * MB;                                                               \
    const bool lat_ = i_ < SEQ;                                                                                  \
    vn = !(d.skipctx && !lat_);                                                                                  \
    if (vn) {                                                                                                    \
      const long toff_ = lat_ ? ((long)(b_ * SEQ + i_)) * DM : ((long)(b_ * CTX + i_ - SEQ)) * DM;               \
      const float* told_ = (lat_ ? d.told_lat : d.told_ctx) + toff_;                                             \
      _Pragma("unroll") for (int j = 0; j < 4; ++j) tn[j] = *GPC(f32x4, told_ + lane * 4 + 256 * j);             \
      if (has_y) {                                                                                               \
        const float* y_ = d.ybuf + (long)((g_) - d.yrow0) * DM;                                                  \
        _Pragma("unroll") for (int j = 0; j < 4; ++j) yn[j] = *GPC(f32x4, y_ + lane * 4 + 256 * j);              \
      }                                                                                                          \
    }                                                                                                            \
  }
  int gnext = d.g0 + blockIdx.x * 4 + wid;
  if (gnext < d.g1) { LOADROW(gnext) }
  while (gnext < d.g1) {
    const int g = gnext;
    const bool v = vn;
    f32x4 t[4], yv[4];
#pragma unroll
    for (int j = 0; j < 4; ++j) { t[j] = tn[j]; yv[j] = yn[j]; }
    gnext += stride;
    if (gnext < d.g1) { LOADROW(gnext) }
    if (!v) continue;
    const int b = g / MB, i = g - b * MB;
    const bool lat = i < SEQ;
    const int midx = lat ? b : 2;
    const long toff = lat ? ((long)(b * SEQ + i)) * DM : ((long)(b * CTX + i - SEQ)) * DM;
    if (has_y) {
      float ss = 0.f;
#pragma unroll
      for (int j = 0; j < 4; ++j) ss += yv[j].x * yv[j].x + yv[j].y * yv[j].y + yv[j].z * yv[j].z + yv[j].w * yv[j].w;
      ss = wave_sum(ss);
      const float rr = rsqrtf(ss * (1.f / DM) + EPS) * d.gscale;
      const float* gate = mods + (d.layer * 3 + midx) * 9216 + d.gate_idx * DM;
      const float* gp = normg + (d.layer * 6 + d.gpost_idx) * DM;
      float* tnew = (lat ? P.out : tctx) + toff;
#pragma unroll
      for (int j = 0; j < 4; ++j) {
        f32x4 ga = *GPC(f32x4, gate + lane * 4 + 256 * j);
        f32x4 gg = *GPC(f32x4, gp + lane * 4 + 256 * j);
        t[j].x += ga.x * (yv[j].x * rr * gg.x); t[j].y += ga.y * (yv[j].y * rr * gg.y);
        t[j].z += ga.z * (yv[j].z * rr * gg.z); t[j].w += ga.w * (yv[j].w * rr * gg.w);
        *GP(f32x4, tnew + lane * 4 + 256 * j) = t[j];
      }
    }
    if (d.has_u) {
      float ss = 0.f;
#pragma unroll
      for (int j = 0; j < 4; ++j) ss += t[j].x * t[j].x + t[j].y * t[j].y + t[j].z * t[j].z + t[j].w * t[j].w;
      ss = wave_sum(ss);
      const float rr = rsqrtf(ss * (1.f / DM) + EPS);
      const float* mu = mods + (d.ulayer * 3 + midx) * 9216;
      const float* sh = mu + d.shift_idx * DM; const float* sc = mu + d.scale_idx * DM;
      const float* gp = normg + (d.ulayer * 6 + d.gpre_idx) * DM;
      u16* u = U + (long)g * DM;
#pragma unroll
      for (int j = 0; j < 4; ++j) {
        f32x4 gg = *GPC(f32x4, gp + lane * 4 + 256 * j);
        f32x4 s1 = *GPC(f32x4, sc + lane * 4 + 256 * j);
        f32x4 s0 = *GPC(f32x4, sh + lane * 4 + 256 * j);
        float a = (t[j].x * rr * gg.x) * (1.f + s1.x) + s0.x, bb = (t[j].y * rr * gg.y) * (1.f + s1.y) + s0.y;
        float c = (t[j].z * rr * gg.z) * (1.f + s1.z) + s0.z, dd = (t[j].w * rr * gg.w) * (1.f + s1.w) + s0.w;
        u32x2 v2; v2.x = pk2(a, bb); v2.y = pk2(c, dd);
        *GP(u32x2, u + lane * 4 + 256 * j) = v2;
      }
    }
  }
#undef LOADROW
}

DI void r3_phase(int layer, const Params& P) {
  const int tid_ = otid(); const int lane = tid_ & 63, wid = tid_ >> 6;
  char* ws = ows(P);
  u16* cq = reinterpret_cast<u16*>(ws + O_CQ);
  u16* ckv = reinterpret_cast<u16*>(ws + O_CKV);
  const float* gq = P.in[13] + layer * 384;
  const float* gkv = P.in[14] + layer * 256;
  for (int row = blockIdx.x * 4 + wid; row < MB; row += gridDim.x * 4) {
    {
      u16* p = cq + (long)row * 384;
      float v[6]; float ss = 0.f;
#pragma unroll
      for (int j = 0; j < 3; ++j) {
        unsigned x = *GPC(unsigned, p + lane * 2 + 128 * j);
        v[2 * j] = bflo(x); v[2 * j + 1] = bfhi(x); ss += v[2 * j] * v[2 * j] + v[2 * j + 1] * v[2 * j + 1];
      }
      ss = wave_sum(ss);
      const float rr = rsqrtf(ss * (1.f / 384.f) + EPS);
#pragma unroll
      for (int j = 0; j < 3; ++j) {
        const int c = lane * 2 + 128 * j;
        *GP(unsigned, p + c) = pk2(v[2 * j] * rr * gq[c], v[2 * j + 1] * rr * gq[c + 1]);
      }
    }
    {
      u16* p = ckv + (long)row * 256;
      u32x2 x = *GPC(u32x2, p + lane * 4);
      float v0 = bflo(x.x), v1 = bfhi(x.x), v2 = bflo(x.y), v3 = bfhi(x.y);
      float ss = wave_sum(v0 * v0 + v1 * v1 + v2 * v2 + v3 * v3);
      const float rr = rsqrtf(ss * (1.f / 256.f) + EPS);
      const int c = lane * 4;
      u32x2 o; o.x = pk2(v0 * rr * gkv[c], v1 * rr * gkv[c + 1]); o.y = pk2(v2 * rr * gkv[c + 2], v3 * rr * gkv[c + 3]);
      *GP(u32x2, p + c) = o;
    }
  }
}

template <int DQK, int DV, int TYPE>
DI void attn_item(int layer, int qt, int head, char* lds, const Params& P) {
  const int tid = otid(), lane = tid & 63, wid = tid >> 6, r = lane & 31, h = lane >> 5;
  char* ws = ows(P);
  constexpr int NS = DQK / 16, NDV = DV / 32;
  constexpr bool DB = DQK == 64;
  constexpr int KBYTES = 64 * DQK * 2;
  constexpr int STAGE = DB ? 24576 : 0;
  constexpr int VOFF = DB ? 8192 : 24576;
  constexpr float SCALE = TYPE == 1 ? 0.07216878364870322f : 0.125f;
  constexpr float C = SCALE * LOG2E;
  const bool latent = qt < 128;
  int ta0, na, NT;
  if (!latent) { ta0 = 256; na = 4; NT = 4; }
  else if (TYPE == 2) { int lo = qt * 2 - 2; if (lo < 0) lo = 0; int hi = qt * 2 + 4; if (hi > 256) hi = 256; ta0 = lo; na = hi - lo; NT = na + 4; }
  else { ta0 = 0; na = 260; NT = 260; }
  const int qrow = qt * 128 + wid * 32 + r;
  const u16* Kp; int ldk; const u16* Vp;
  if (TYPE == 0) { Kp = reinterpret_cast<const u16*>(ws + O_KA) + head * 128; ldk = 1024; Vp = reinterpret_cast<const u16*>(ws + O_VAT) + (long)(head * 128) * MB; }
  else if (TYPE == 1) { Kp = reinterpret_cast<const u16*>(ws + O_KCN) + head * 128; ldk = 1024; Vp = reinterpret_cast<const u16*>(ws + O_VCT) + (long)(head * 128) * MB; }
  else { Kp = reinterpret_cast<const u16*>(ws + O_KB) + (head >> 2) * 64; ldk = 256; Vp = reinterpret_cast<const u16*>(ws + O_VBT) + (long)((head >> 2) * 64) * MB; }
  const u16* K2 = reinterpret_cast<const u16*>(ws + O_KR);
  const int kr_a = (DQK == 64) ? (tid >> 3) : (tid >> 4), kc_a = (DQK == 64) ? (tid & 7) : (tid & 15);
  const int kgo_a = kr_a * ldk + kc_a * 8;
  const int kso_a = kr_a * (DQK * 2) + ((kc_a ^ ((kr_a >> 1) & 7)) << 4);
  const int kr_b = tid >> 3, kc_b = 16 + (tid & 7);
  const int kgo_b = kr_b * 64 + (tid & 7) * 8;
  const int kso_b = kr_b * (DQK * 2) + ((kc_b ^ ((kr_b >> 1) & 7)) << 4);
  const int vdv = tid >> 3, vkc = tid & 7, vxs = (vdv >> 1) & 7;
  const unsigned vvo = (unsigned)(vdv * MB + vkc * 8) * 2u;
  const unsigned kvo_a = (unsigned)kgo_a * 2u, kvo_b = (unsigned)kgo_b * 2u;
  const int vso = VOFF + vdv * 128 + ((vkc ^ vxs) << 4);
  u32x4 kreg0, kreg1, kreg2, kreg3, kreg4, kreg5, vreg0, vreg1, vreg2, vreg3;
  const int xr = (r >> 1) & 7;
  constexpr int NMAPS = TYPE == 0 ? 2 : 1;
  u16* ya_dst = reinterpret_cast<u16*>(ws + O_YA) + (long)qrow * 1024 + head * 128;
  for (int map = 0; map < NMAPS; ++map) {
    const u16* Kb = Kp + map * 64;
    const u16* Qp;
    if (TYPE == 0) Qp = reinterpret_cast<const u16*>(ws + O_QA) + (long)qrow * 1024 + head * 128 + map * 64;
    else if (TYPE == 1) Qp = reinterpret_cast<const u16*>(ws + O_QC) + (long)qrow * 1536 + head * 192;
    else Qp = reinterpret_cast<const u16*>(ws + O_QB) + (long)qrow * 1024 + head * 64;
    constexpr int NQR = NS > 6 ? 6 : NS;
    bf16x8 qf[NQR];
#pragma unroll
    for (int s = 0; s < NQR; ++s) qf[s] = *GPC(bf16x8, Qp + 16 * s + 8 * h);
    char* qpark = lds + 40960 + tid * 16;
#pragma unroll
    for (int s = NQR; s < NS; ++s) *reinterpret_cast<bf16x8*>(qpark + (s - NQR) * 4096) = *GPC(bf16x8, Qp + 16 * s + 8 * h);
    float m_run, l_run;
    if (TYPE == 2) { m_run = P.in[12][layer * 16 + head] * (1.f / SCALE); l_run = 1.f; }
    else { m_run = -1e30f; l_run = 0.f; }
    f32x16 oacc[NDV];
#pragma unroll
    for (int d = 0; d < NDV; ++d)
#pragma unroll
      for (int i = 0; i < 16; ++i) oacc[d][i] = 0.f;
#define TILE_OF(j) ((j) < na ? ta0 + (j) : 256 + ((j) - na))
#define LDG(p) (*GPC(u32x4, p))
#define ATT_GLOAD(tile)                                                                                          \
  {                                                                                                              \
    const long key0 = (long)(tile) * 64;                                                                         \
    const char* kp_ = uptr(Kb + key0 * ldk);                                                    \
    if constexpr (DQK == 64) {                                                                                   \
      kreg0 = LDG(kp_ + kvo_a); kreg1 = LDG(kp_ + (long)64 * ldk + kvo_a);                                       \
    } else {                                                                                                     \
      kreg0 = LDG(kp_ + kvo_a); kreg1 = LDG(kp_ + (long)32 * ldk + kvo_a);                                       \
      kreg2 = LDG(kp_ + (long)64 * ldk + kvo_a); kreg3 = LDG(kp_ + (long)96 * ldk + kvo_a);                      \
      const char* k2_ = uptr(K2 + key0 * 64);                                           \
      kreg4 = LDG(k2_ + kvo_b); kreg5 = LDG(k2_ + 32 * 64 * 2 + kvo_b);                                          \
    }                                                                                                            \
    const char* vp_ = uptr(Vp + key0);                                                  \
    vreg0 = LDG(vp_ + vvo); vreg1 = LDG(vp_ + (long)64 * MB + vvo);                                              \
    if constexpr (DV == 128) { vreg2 = LDG(vp_ + (long)128 * MB + vvo); vreg3 = LDG(vp_ + (long)192 * MB + vvo); } \
  }
#define STV(sb, j, v) { *reinterpret_cast<u32x4*>((sb) + vso + (j) * 4096) = v; }
#define ATT_SSTORE(sb)                                                                                           \
  {                                                                                                              \
    if constexpr (DQK == 64) {                                                                                   \
      *reinterpret_cast<u32x4*>((sb) + kso_a) = kreg0; *reinterpret_cast<u32x4*>((sb) + kso_a + 4096) = kreg1;   \
    } else {                                                                                                     \
      *reinterpret_cast<u32x4*>((sb) + kso_a) = kreg0; *reinterpret_cast<u32x4*>((sb) + kso_a + 16 * 384) = kreg1; \
      *reinterpret_cast<u32x4*>((sb) + kso_a + 32 * 384) = kreg2; *reinterpret_cast<u32x4*>((sb) + kso_a + 48 * 384) = kreg3; \
      *reinterpret_cast<u32x4*>((sb) + kso_b) = kreg4; *reinterpret_cast<u32x4*>((sb) + kso_b + 32 * 384) = kreg5; \
    }                                                                                                            \
    STV(sb, 0, vreg0) STV(sb, 1, vreg1)                                                                          \
    if constexpr (DV == 128) { STV(sb, 2, vreg2) STV(sb, 3, vreg3) }                                             \
  }
    ATT_GLOAD(TILE_OF(0));
    ATT_SSTORE(lds);
    if constexpr (DB) { if (1 < NT) { ATT_GLOAD(TILE_OF(1)); } }
    __syncthreads();
    for (int j = 0; j < NT; ++j) {
      const int tile = TILE_OF(j);
      const char* sb = lds + (DB ? (j & 1) * STAGE : 0);
      if constexpr (DB) {
        char* sn = lds + ((j + 1) & 1) * STAGE;
        if (j + 1 < NT) { ATT_SSTORE(sn); }
        if (j + 2 < NT) { ATT_GLOAD(TILE_OF(j + 2)); }
      } else {
        if (j + 1 < NT) { ATT_GLOAD(TILE_OF(j + 1)); }
      }
      f32x16 s0, s1;
#pragma unroll
      for (int i = 0; i < 16; ++i) { s0[i] = 0.f; s1[i] = 0.f; }
      {
        bf16x8 kr0[3], kr1[3];
#define KFR(s_, slot_)                                                                          \
  {                                                                                             \
    const int co = ((2 * (s_) + h) ^ xr) << 4;                                                  \
    kr0[slot_] = *reinterpret_cast<const bf16x8*>(sb + r * (DQK * 2) + co);                     \
    kr1[slot_] = *reinterpret_cast<const bf16x8*>(sb + (32 + r) * (DQK * 2) + co);              \
  }
        KFR(0, 0) KFR(1, 1)
#pragma unroll
        for (int s = 0; s < NS; ++s) {
          if (s + 2 < NS) KFR(s + 2, (s + 2) % 3)
          bf16x8 qs;
          if constexpr (NS > NQR) { if (s < NQR) qs = qf[s < NQR ? s : 0]; else qs = *reinterpret_cast<const bf16x8*>(qpark + (s - NQR) * 4096); }
          else qs = qf[s];
          s0 = MFMA(kr0[s % 3], qs, s0);
          s1 = MFMA(kr1[s % 3], qs, s1);
          __builtin_amdgcn_sched_barrier(0);
        }
#undef KFR
      }
      if (TYPE == 2 && latent && j < na) {
        const int kb0 = tile * 64 - qrow;
#pragma unroll
        for (int i = 0; i < 16; ++i) {
          const int d0 = kb0 + crow(i, h), d1 = d0 + 32;
          if (d0 > 128 || d0 < -128) s0[i] = -1e30f;
          if (d1 > 128 || d1 < -128) s1[i] = -1e30f;
        }
      }
      asm volatile("s_nop 15" ::: "memory");
      __builtin_amdgcn_sched_barrier(0);
      const float tm0 = vmax3(s0[0], s0[1], s0[2]), tm1 = vmax3(s0[3], s0[4], s0[5]), tm2 = vmax3(s0[6], s0[7], s0[8]), tm3 = vmax3(s0[9], s0[10], s0[11]);
      const float tm4 = vmax3(s0[12], s0[13], s0[14]), tm5 = vmax3(s1[0], s1[1], s1[2]), tm6 = vmax3(s1[3], s1[4], s1[5]), tm7 = vmax3(s1[6], s1[7], s1[8]);
      const float tm8 = vmax3(s1[9], s1[10], s1[11]), tm9 = vmax3(s1[12], s1[13], s1[14]), tma = vmax3(s0[15], s1[15], tm0), tmb = vmax3(tm1, tm2, tm3);
      const float tmc = vmax3(tm4, tm5, tm6), tmd = vmax3(tm7, tm8, tm9);
      float tmax = xhalf_max(vmax3(vmax3(tma, tmb, tmc), tmd, tmd));
      const float mnew = fmaxf(m_run, tmax);
      const float alpha = __builtin_amdgcn_exp2f((m_run - mnew) * C);
      m_run = mnew;
      const float mc = -mnew * C;
      float pa = 0.f, pb = 0.f, pc = 0.f, pd = 0.f;
#pragma unroll
      for (int i = 0; i < 16; i += 2) {
        s0[i] = __builtin_amdgcn_exp2f(fmaf(s0[i], C, mc)); pa += s0[i];
        s0[i + 1] = __builtin_amdgcn_exp2f(fmaf(s0[i + 1], C, mc)); pb += s0[i + 1];
      }
#pragma unroll
      for (int i = 0; i < 16; i += 2) {
        s1[i] = __builtin_amdgcn_exp2f(fmaf(s1[i], C, mc)); pc += s1[i];
        s1[i + 1] = __builtin_amdgcn_exp2f(fmaf(s1[i + 1], C, mc)); pd += s1[i + 1];
      }
      const float ps = xhalf_sum((pa + pb) + (pc + pd));
      l_run = l_run * alpha + ps;
      if (__any(alpha != 1.f)) {
#pragma unroll
        for (int d = 0; d < NDV; ++d)
#pragma unroll
          for (int i = 0; i < 16; ++i) oacc[d][i] *= alpha;
      }
      bf16x8 pf[4];
#pragma unroll
      for (int sp = 0; sp < 2; ++sp) {
        u32x4 w0, w1;
        w0.x = pk2(s0[8 * sp + 0], s0[8 * sp + 1]); w0.y = pk2(s0[8 * sp + 2], s0[8 * sp + 3]);
        w0.z = pk2(s0[8 * sp + 4], s0[8 * sp + 5]); w0.w = pk2(s0[8 * sp + 6], s0[8 * sp + 7]);
        w1.x = pk2(s1[8 * sp + 0], s1[8 * sp + 1]); w1.y = pk2(s1[8 * sp + 2], s1[8 * sp + 3]);
        w1.z = pk2(s1[8 * sp + 4], s1[8 * sp + 5]); w1.w = pk2(s1[8 * sp + 6], s1[8 * sp + 7]);
        pf[sp] = __builtin_bit_cast(bf16x8, w0);
        pf[2 + sp] = __builtin_bit_cast(bf16x8, w1);
      }
      {
        const char* vb0 = sb + VOFF + r * 128;
#define VFRAG(d, B) (*reinterpret_cast<const bf16x8*>(vb0 + (d) * 4096 + (((2 * (B) + h) ^ xr) << 4)))
        bf16x8 vr[4];
        vr[0] = VFRAG(0, 0); vr[1] = VFRAG(0, 1); vr[2] = VFRAG(0, 2);
#pragma unroll
        for (int f = 0; f < NDV * 4; ++f) {
          if (f + 3 < NDV * 4) vr[(f + 3) & 3] = VFRAG((f + 3) >> 2, (f + 3) & 3);
          oacc[f >> 2] = MFMA(vr[f & 3], pf[f & 3], oacc[f >> 2]);
          __builtin_amdgcn_sched_barrier(0);
        }
#undef VFRAG
      }
      __syncthreads();
      if constexpr (!DB) {
        if (j + 1 < NT) { ATT_SSTORE(lds); }
        __syncthreads();
      }
    }
#undef ATT_GLOAD
#undef ATT_SSTORE
#undef STV
#undef LDG
#undef TILE_OF
    const float il = 1.f / l_run;
    if (TYPE == 0 && map == 0) {
#pragma unroll
      for (int d = 0; d < NDV; ++d) {
        f32x16 o;
#pragma unroll
        for (int i = 0; i < 16; ++i) o[i] = oacc[d][i] * il;
        st_bf16_tile(o, ya_dst + d * 32, h);
      }
    } else if (TYPE == 0) {
      const float lam = reinterpret_cast<const float*>(ws + O_LAM)[layer];
      float ss = 0.f;
#pragma unroll
      for (int d = 0; d < NDV; ++d) {
#pragma unroll
        for (int q = 0; q < 4; ++q) {
          const u32x2 w = *GPC(u32x2, ya_dst + d * 32 + 8 * q + 4 * h);
          const float v0 = bflo(w.x) - lam * (oacc[d][4 * q + 0] * il), v1 = bfhi(w.x) - lam * (oacc[d][4 * q + 1] * il);
          const float v2 = bflo(w.y) - lam * (oacc[d][4 * q + 2] * il), v3 = bfhi(w.y) - lam * (oacc[d][4 * q + 3] * il);
          oacc[d][4 * q + 0] = v0; oacc[d][4 * q + 1] = v1; oacc[d][4 * q + 2] = v2; oacc[d][4 * q + 3] = v3;
          ss += v0 * v0 + v1 * v1 + v2 * v2 + v3 * v3;
        }
      }
      ss = xhalf_sum(ss);
      const float rr = rsqrtf(ss * (1.f / 128.f) + EPS) * (1.f - P.linit[layer]);
      const float* sg = P.in[11] + layer * 128;
#pragma unroll
      for (int d = 0; d < NDV; ++d) {
        f32x16 o;
#pragma unroll
        for (int q = 0; q < 4; ++q) {
          const f32x4 g4 = *GPC(f32x4, sg + d * 32 + 8 * q + 4 * h);
          o[4 * q] = oacc[d][4 * q] * rr * g4.x; o[4 * q + 1] = oacc[d][4 * q + 1] * rr * g4.y;
          o[4 * q + 2] = oacc[d][4 * q + 2] * rr * g4.z; o[4 * q + 3] = oacc[d][4 * q + 3] * rr * g4.w;
        }
        st_bf16_tile(o, ya_dst + d * 32, h);
      }
    } else {
      u16* dst = TYPE == 1 ? reinterpret_cast<u16*>(ws + O_YA + 2 * SZ1) + (long)qrow * 1024 + head * 128
                           : reinterpret_cast<u16*>(ws + O_YA + SZ1) + (long)qrow * 1024 + head * 64;
#pragma unroll
      for (int d = 0; d < NDV; ++d) {
        f32x16 o;
#pragma unroll
        for (int i = 0; i < 16; ++i) o[i] = oacc[d][i] * il;
        st_bf16_tile(o, dst + d * 32, h);
      }
    }
  }
  __syncthreads();
}

DI void attn_phase(int layer, const Params& P, char* lds) {
  const int NITEMS = layer + 1 < DEPTH ? 4096 + 64 : 4096;
  for (int w = blockIdx.x; w < NITEMS; w += gridDim.x) {
    if (w < 1024) attn_item<64, 128, 0>(layer, w >> 3, w & 7, lds, P);
    else if (w < 2048) attn_item<192, 128, 1>(layer, (w - 1024) >> 3, w & 7, lds, P);
    else if (w < 4096) attn_item<64, 64, 2>(layer, (w - 2048) >> 4, w & 15, lds, P);
    else if (w < 4112) attn_item<64, 128, 0>(layer, 128 + ((w - 4096) >> 3), w & 7, lds, P);
    else if (w < 4128) attn_item<192, 128, 1>(layer, 128 + ((w - 4112) >> 3), w & 7, lds, P);
    else attn_item<64, 64, 2>(layer, 128 + ((w - 4128) >> 4), w & 15, lds, P);
  }
}

DI void conv_tile(const float* __restrict__ src, int K, int N, u16* __restrict__ dst, int tile, int perm, char* lds) {
  float* sm = reinterpret_cast<float*>(lds);
  const int tid = otid();
  const int nts = N >> 6;
  const int kt = tile / nts, ntile = tile - kt * nts;
  const int k0 = kt * 64, n0 = ntile * 64;
#pragma unroll
  for (int j = 0; j < 16; ++j) {
    const int k = j * 4 + (tid >> 6), n = tid & 63;
    sm[k * 65 + n] = src[(long)(k0 + k) * N + n0 + n];
  }
  __syncthreads();
#pragma unroll
  for (int j = 0; j < 2; ++j) {
    const int n = (tid >> 3) + 32 * j, kc = tid & 7;
    float v[8];
#pragma unroll
    for (int e = 0; e < 8; ++e) v[e] = sm[(kc * 8 + e) * 65 + n];
    int nn = n0 + n;
    if (perm) { const int s = nn >= FFN ? 1 : 0; const int jj = nn - s * FFN; nn = 64 * (jj >> 5) + 32 * s + (jj & 31); }
    u32x4 o; o.x = pk2(v[0], v[1]); o.y = pk2(v[2], v[3]); o.z = pk2(v[4], v[5]); o.w = pk2(v[6], v[7]);
    *GP(u32x4, dst + (long)nn * K + k0 + kc * 8) = o;
  }
  __syncthreads();
}

constexpr int CONV_TILES = 7616;
DI void conv_phase(int layer, const Params& P, char* lds, int extra_first) {
  char* ws = ows(P);
  for (int t = blockIdx.x + extra_first; t < CONV_TILES + extra_first; t += gridDim.x) {
    int x = t - extra_first;
    const float* src; int K, N, perm = 0; u16* dst;
    if (x < 2816) { const int s = x / 1408; x -= s * 1408; src = P.in[7] + ((long)(layer * 2 + s)) * DM * 2 * FFN; K = DM; N = 2 * FFN; perm = 1; dst = reinterpret_cast<u16*>(ws + O_WIN + s * SZ_WIN); }
    else if (x < 4224) { x -= 2816; const int s = x / 704; x -= s * 704; src = P.in[8] + ((long)(layer * 2 + s)) * FFN * DM; K = FFN; N = DM; dst = reinterpret_cast<u16*>(ws + O_WOUT + s * SZ_WOUT); }
    else if (x < 6320) { x -= 4224; src = P.in[9] + (long)layer * DM * MIXIN; K = DM; N = MIXIN; dst = reinterpret_cast<u16*>(ws + O_WMIX); }
    else if (x < 6464) { x -= 6320; src = P.in[15] + (long)layer * 384 * 1536; K = 384; N = 1536; dst = reinterpret_cast<u16*>(ws + O_WUQ); }
    else if (x < 6592) { x -= 6464; src = P.in[16] + (long)layer * 256 * 2048; K = 256; N = 2048; dst = reinterpret_cast<u16*>(ws + O_WUKV); }
    else if (x < 7360) { x -= 6592; const int br = x / 256; x -= br * 256; src = P.in[17] + ((long)(layer * 3 + br)) * DM * DM; K = DM; N = DM; dst = reinterpret_cast<u16*>(ws + O_WBR) + (long)br * DM * DM; }
    else { x -= 7360; src = P.in[18] + (long)layer * DM * DM; K = DM; N = DM; dst = reinterpret_cast<u16*>(ws + O_WMO); }
    conv_tile(src, K, N, dst, x, perm, lds);
  }
}

DI void mods_item(int item, const Params& P, char* lds) {
  float* sv = reinterpret_cast<float*>(lds);
  float* red = sv + 3 * 1024;
  const int tid = otid();
  const int l = item / 144, nb = item - l * 144;
  for (int e = tid; e < 3 * 1024; e += 256) {
    const int v = e >> 10, k = e & 1023;
    const float x = v < 2 ? P.in[1][v * DM + k] : P.in[3][k];
    sv[e] = x / (1.f + __expf(-x));
  }
  __syncthreads();
  const int c = tid & 63, kg = tid >> 6;
  const float* w = P.in[4] + (long)l * DM * 9216 + nb * 64 + c;
  float a0 = 0.f, a1 = 0.f, a2 = 0.f;
  for (int k = kg * 256; k < kg * 256 + 256; ++k) {
    const float wv = w[(long)k * 9216];
    a0 += sv[k] * wv; a1 += sv[1024 + k] * wv; a2 += sv[2048 + k] * wv;
  }
  red[(kg * 3 + 0) * 64 + c] = a0; red[(kg * 3 + 1) * 64 + c] = a1; red[(kg * 3 + 2) * 64 + c] = a2;
  __syncthreads();
  if (tid < 192) {
    const int v = tid >> 6, cc = tid & 63;
    float s = red[(0 * 3 + v) * 64 + cc] + red[(1 * 3 + v) * 64 + cc] + red[(2 * 3 + v) * 64 + cc] + red[(3 * 3 + v) * 64 + cc];
    const int n = nb * 64 + cc;
    reinterpret_cast<float*>(ows(P) + O_MODS)[(l * 3 + v) * 9216 + n] = s + P.in[5][l * 9216 + n];
  }
  __syncthreads();
}

DI void misc_item(const Params& P) {
  const int tid = otid();
  float* rope = reinterpret_cast<float*>(ows(P) + O_ROPE);
  for (int e = tid; e < 256 * 16; e += 256) {
    const int p = e >> 4, j = e & 15;
    const float ang = (float)p * P.inv_freq[j];
    double a = (double)ang;
    const double TWO_PI = 6.283185307179586476925;
    a -= TWO_PI * rint(a / TWO_PI);
    const double q = a * 0.25, q2 = q * q;
    double sn = q * (1.0 + q2 * (-1.0 / 6 + q2 * (1.0 / 120 + q2 * (-1.0 / 5040 + q2 * (1.0 / 362880 + q2 * (-1.0 / 39916800 + q2 * (1.0 / 6227020800.0)))))));
    double cs = 1.0 + q2 * (-0.5 + q2 * (1.0 / 24 + q2 * (-1.0 / 720 + q2 * (1.0 / 40320 + q2 * (-1.0 / 3628800 + q2 * (1.0 / 479001600.0 + q2 * (-1.0 / 87178291200.0)))))));
    double s2 = 2 * sn * cs, c2 = cs * cs - sn * sn;
    double s4 = 2 * s2 * c2, c4 = c2 * c2 - s2 * s2;
    rope[e] = (float)c4;
    rope[256 * 16 + e] = (float)s4;
  }
  if (tid < DEPTH) {
    const float* dl = P.in[10] + tid * 4 * 64;
    float d01 = 0.f, d23 = 0.f;
    for (int i = 0; i < 64; ++i) { d01 += dl[i] * dl[64 + i]; d23 += dl[128 + i] * dl[192 + i]; }
    reinterpret_cast<float*>(ows(P) + O_LAM)[tid] = expf(d01) - expf(d23) + P.linit[tid];
  }
}

#define XB_TMO      128
#define XB_XCNT(j)  (256  + 64 * (j))
#define XB_XSUB(j)  (1280 + 64 * (j))
#define XB_XGEN(j)  (2304 + 64 * (j))
#define XB_TOP      3328
#define XB_TOPGEN   3392
#define XCD_BAR_WORDS 3456
#define XB_SPIN_CAP (1u << 18)
#define LAS __attribute__((address_space(3)))
DI unsigned xb_ld(unsigned* p) { return __hip_atomic_load(p, __ATOMIC_RELAXED, __HIP_MEMORY_SCOPE_AGENT); }
DI unsigned xb_add(unsigned* p, unsigned v) { return __hip_atomic_fetch_add(p, v, __ATOMIC_RELAXED, __HIP_MEMORY_SCOPE_AGENT); }
DI unsigned xb_xcc_id() { return (unsigned)__builtin_amdgcn_s_getreg((3 << 11) | 20) & 0xFu; }
#define XB_SPIN(cond, bar) do { unsigned _sp = 0; while (cond) { __builtin_amdgcn_s_sleep(1); \
    if ((++_sp & 255u) == 0u) { if (xb_ld(&(bar)[XB_TMO])) break; if (_sp > XB_SPIN_CAP) { atomicAdd(&(bar)[XB_TMO], 1u); break; } } } } while (0)
struct XcdBarrier { unsigned* bar; unsigned x; volatile LAS unsigned* st; };
DI XcdBarrier xcd_barrier_post(unsigned* bar, volatile LAS unsigned* st) {
  XcdBarrier b; b.bar = bar; b.x = xb_xcc_id(); b.st = st;
  if (threadIdx.x == 0) (void)xb_add(&bar[XB_XCNT(b.x)], 1u);
  return b;
}
DI void xcd_barrier_complete(unsigned* bar, unsigned x, unsigned& nloc, unsigned& nx) {
  const unsigned G = gridDim.x * gridDim.y * gridDim.z;
  unsigned sum, cnt, mine, sp = 0u;
  for (;;) {
    sum = 0u; cnt = 0u; mine = 0u;
#pragma unroll
    for (unsigned j = 0; j < 16; ++j) { const unsigned c = xb_ld(&bar[XB_XCNT(j)]); sum += c; cnt += (c > 0u) ? 1u : 0u; mine = (j == x) ? c : mine; }
    if (sum == G) break;
    __builtin_amdgcn_s_sleep(1);
    if ((++sp & 255u) == 0u) { if (xb_ld(&bar[XB_TMO])) break; if (sp > XB_SPIN_CAP) { atomicAdd(&bar[XB_TMO], 1u); break; } }
  }
  nloc = mine > 0u ? mine : 1u; nx = cnt > 0u ? cnt : 1u;
}
DI void xcd_barrier(const XcdBarrier& b) {
  asm volatile("s_waitcnt vmcnt(0)" ::: "memory");
  __syncthreads();
  if (threadIdx.x == 0) {
    unsigned* bar = b.bar;
    __builtin_amdgcn_s_waitcnt(0);
    unsigned nloc = b.st[0], nx = b.st[1];
    if (nloc == 0u) { xcd_barrier_complete(bar, b.x, nloc, nx); b.st[0] = nloc; b.st[1] = nx; }
    const unsigned old = xb_add(&bar[XB_XSUB(b.x)], 1u);
    const unsigned gen = old / nloc;
    if (old + 1u == (gen + 1u) * nloc) {
      __builtin_amdgcn_fence(__ATOMIC_RELEASE, "agent");
      asm volatile("s_waitcnt vmcnt(0)" ::: "memory");
      const unsigned og = xb_add(&bar[XB_TOP], 1u);
      const unsigned tg = og / nx;
      if (og + 1u == (tg + 1u) * nx) xb_add(&bar[XB_TOPGEN], 1u);
      else XB_SPIN(xb_ld(&bar[XB_TOPGEN]) == tg, bar);
      __builtin_amdgcn_fence(__ATOMIC_ACQUIRE, "agent");
      xb_add(&bar[XB_XGEN(b.x)], 1u);
      asm volatile("s_waitcnt vmcnt(0)" ::: "memory");
    } else {
      XB_SPIN(xb_ld(&bar[XB_XGEN(b.x)]) == gen, bar);
      __builtin_amdgcn_fence(__ATOMIC_ACQUIRE, "agent");
      asm volatile("s_waitcnt vmcnt(0)" ::: "memory");
    }
  }
  __syncthreads();
}

constexpr size_t LDS_BYTES = 65536 + 64;
constexpr int NPL = 23;
constexpr int NPH = 1 + DEPTH * NPL;

__global__ void __launch_bounds__(256, 2) fwd_megakernel(Params P) {
  extern __shared__ __attribute__((aligned(16))) char lds[];
  cg::grid_group grid = cg::this_grid();
  volatile LAS unsigned* xst = (volatile LAS unsigned*)(lds + 65536);
  if (threadIdx.x == 0) { xst[0] = 0u; xst[1] = 0u; }
  __syncthreads();
  const XcdBarrier xb = xcd_barrier_post(reinterpret_cast<unsigned*>(P.ws + O_BAR), xst);
  char* ws = P.ws;
  u16* U = reinterpret_cast<u16*>(ws + O_U);
  float* tctx = reinterpret_cast<float*>(ws + O_TCTX);
  for (int ph = 0; ph < NPH; ++ph) {
    int kind = 0;
    GemmDesc gd; RowDesc rd;
    gd.skipctx = 0; gd.epi = 0; gd.mtiles = 0; gd.ntiles = 0; gd.K = 0; gd.lda = 0; gd.A = nullptr; gd.W = nullptr; gd.dst = nullptr;
    rd.skipctx = 0; rd.g0 = 0; rd.g1 = 0; rd.told_lat = P.out; rd.told_ctx = tctx; rd.ybuf = nullptr; rd.yrow0 = 0; rd.gscale = 1.f;
    rd.gate_idx = 0; rd.gpost_idx = 0; rd.layer = 0; rd.has_u = 0; rd.ulayer = 0; rd.gpre_idx = 0; rd.shift_idx = 0; rd.scale_idx = 0;
    int layer = 0, conv_layer = -1;
    if (ph == 0) {
      for (int t = blockIdx.x; t < 289; t += gridDim.x) { if (t < 288) mods_item(t, P, lds); else misc_item(P); }
      conv_phase(0, P, lds, 0);
    } else {
      layer = (ph - 1) / NPL;
      const int q = (ph - 1) - layer * NPL;
      const bool first = layer == 0;
      if (q == 0) {
        if (first) { kind = 2; rd.g0 = 0; rd.g1 = MT; rd.told_lat = P.in[0]; rd.told_ctx = P.in[2]; rd.has_u = 1; rd.ulayer = 0; rd.gpre_idx = 0; rd.shift_idx = 0; rd.scale_idx = 1; }
        else kind = -1;
      } else if (q == 1 || q == 20) {
        const int s = q == 1 ? 0 : 1;
        kind = 1; gd.epi = EPI_SWIGLU; gd.mtiles = MT / 128;
        if (s == 1 && layer + 1 == DEPTH) { gd.mtiles = 256; gd.skipctx = 1; } gd.ntiles = 44; gd.K = DM; gd.lda = DM; gd.A = U;
        gd.W = reinterpret_cast<const u16*>(ws + O_WIN + s * SZ_WIN); gd.dst = ws + O_ACT;
      } else if (q == 2 || q == 21) {
        const int s = q == 2 ? 0 : 1;
        kind = 1; gd.epi = EPI_YF32; gd.mtiles = MT / 128;
        if (s == 1 && layer + 1 == DEPTH) { gd.mtiles = 256; gd.skipctx = 1; } gd.ntiles = 8; gd.K = FFN; gd.lda = FFN; gd.A = reinterpret_cast<const u16*>(ws + O_ACT);
        gd.W = reinterpret_cast<const u16*>(ws + O_WOUT + s * SZ_WOUT); gd.dst = ws + O_Y;
      } else if (q == 3) {
        kind = 2; rd.g0 = 0; rd.g1 = MT;
        if (first) { rd.told_lat = P.in[0]; rd.told_ctx = P.in[2]; }
        rd.ybuf = reinterpret_cast<const float*>(ws + O_Y); rd.yrow0 = 0; rd.gscale = 0.5f; rd.gate_idx = 2; rd.gpost_idx = 1; rd.layer = layer;
        rd.has_u = 1; rd.ulayer = layer; rd.gpre_idx = 2; rd.shift_idx = 3; rd.scale_idx = 4;
      } else if (q < 20) {
        const int b = (q - 4) >> 3, qq = (q - 4) & 7;
        const u16* Ub = U + (long)b * MB * DM;
        const int mtq = layer + 1 == DEPTH ? 128 : 130;
        if (qq == 0) { kind = 1; gd.epi = EPI_PROJ; gd.mtiles = 130; gd.ntiles = 42; gd.K = DM; gd.lda = DM; gd.A = Ub; gd.W = reinterpret_cast<const u16*>(ws + O_WMIX); }
        else if (qq == 1) { kind = 3; }
        else if (qq == 2) { kind = 1; gd.epi = EPI_UQKV; gd.mtiles = 130; gd.ntiles = 28; }
        else if (qq == 3) { kind = 4; }
        else if (qq == 4) { kind = 1; gd.epi = EPI_SG; gd.mtiles = mtq; gd.ntiles = 24; gd.K = DM; gd.lda = DM; gd.A = Ub; gd.W = reinterpret_cast<const u16*>(ws + O_WMIX) + (long)NPROJ * DM; gd.dst = ws + O_SG; }
        else if (qq == 5) { kind = 5; gd.epi = EPI_MERGE; gd.mtiles = mtq; gd.ntiles = 8; gd.K = DM; gd.lda = DM; gd.A = reinterpret_cast<const u16*>(ws + O_YA); gd.W = reinterpret_cast<const u16*>(ws + O_WBR); gd.dst = ws + O_MERGED; }
        else if (qq == 6) { kind = 1; gd.epi = EPI_YF32; gd.mtiles = mtq; gd.ntiles = 8; gd.K = DM; gd.lda = DM; gd.A = reinterpret_cast<const u16*>(ws + O_MERGED); gd.W = reinterpret_cast<const u16*>(ws + O_WMO); gd.dst = ws + O_YO; }
        else {
          kind = 2; rd.g0 = b * MB; rd.g1 = (b + 1) * MB; rd.skipctx = layer + 1 == DEPTH; rd.ybuf = reinterpret_cast<const float*>(ws + O_YO); rd.yrow0 = b * MB; rd.gscale = 1.f;
          rd.gate_idx = 5; rd.gpost_idx = 3; rd.layer = layer; rd.has_u = 1; rd.ulayer = layer; rd.gpre_idx = 4; rd.shift_idx = 6; rd.scale_idx = 7;
        }
      } else {
        kind = 2; rd.g0 = 0; rd.g1 = MT; rd.skipctx = layer + 1 == DEPTH; rd.ybuf = reinterpret_cast<const float*>(ws + O_Y); rd.yrow0 = 0; rd.gscale = 0.5f; rd.gate_idx = 8; rd.gpost_idx = 5; rd.layer = layer;
        if (layer + 1 < DEPTH) { rd.has_u = 1; rd.ulayer = layer + 1; rd.gpre_idx = 0; rd.shift_idx = 0; rd.scale_idx = 1; conv_layer = layer + 1; }
      }
    }
    if (kind == 1) gemm_phase<false>(gd, P, lds);
    else if (kind == 5) gemm_phase<true>(gd, P, lds);
    else if (kind == 2) rowop_phase(rd, P);
    else if (kind == 3) r3_phase(layer, P);
    else if (kind == 4) attn_phase(layer, P, lds);
    if (conv_layer >= 0) conv_phase(conv_layer, P, lds, 0);
    if (kind != -1 && ph + 1 < NPH) {
      if (P.pad[0] == 0x7fffffff) grid.sync();
      xcd_barrier(xb);
    }
  }
}

extern "C" void kernel_launch(void* const* d_in, const int* in_sizes, int n_in, void* d_out, int out_size, void* d_ws, size_t ws_size,
                              hipStream_t stream) {
  static int grid_blocks = 0;
  if (!grid_blocks) {
    int dev = 0, cus = 0, per_cu = 0;
    (void)hipGetDevice(&dev);
    (void)hipDeviceGetAttribute(&cus, hipDeviceAttributeMultiprocessorCount, dev);
    (void)hipFuncSetAttribute((const void*)fwd_megakernel, hipFuncAttributeMaxDynamicSharedMemorySize, (int)LDS_BYTES);
    (void)hipOccupancyMaxActiveBlocksPerMultiprocessor(&per_cu, fwd_megakernel, 256, LDS_BYTES);
    if (per_cu > 2) per_cu = 2;
    if (per_cu < 1) per_cu = 1;
    grid_blocks = cus * per_cu;
    fprintf(stderr, "megakernel: cus %d per_cu %d grid %d ws_need %zu ws_size %zu\n", cus, per_cu, grid_blocks, (size_t)WS_NEED, ws_size);
  }
  if (n_in != 19 || ws_size < WS_NEED) {
    fprintf(stderr, "kernel_launch: bad setup n_in %d ws_size %zu need %zu\n", n_in, ws_size, (size_t)WS_NEED);
    return;
  }
  Params p{};
  for (int i = 0; i < 19; ++i) p.in[i] = reinterpret_cast<const float*>(d_in[i]);
  p.out = reinterpret_cast<float*>(d_out);
  p.ws = reinterpret_cast<char*>(d_ws);
  for (int j = 0; j < 16; ++j) p.inv_freq[j] = 1.0f / powf(10000.0f, (float)j / 16.0f);
  for (int l = 0; l < DEPTH; ++l) p.linit[l] = (float)(0.8 - 0.6 * exp(-0.3 * (double)l));
  (void)hipMemsetAsync(reinterpret_cast<char*>(d_ws) + O_BAR, 0, XCD_BAR_WORDS * 4, stream);
  void* args[] = {&p};
  hipError_t e = hipLaunchCooperativeKernel((void*)fwd_megakernel, dim3(grid_blocks), dim3(256), args, LDS_BYTES, stream);
  if (e != hipSuccess) fprintf(stderr, "cooperative launch failed: %s (grid %d)\n", hipGetErrorString(e), grid_blocks);
}
```

```cpp
#include <hip/hip_runtime.h>
#include <hip/hip_cooperative_groups.h>
#include <cstdio>
#include <cstdint>
#include <cmath>
namespace cg = cooperative_groups;

typedef unsigned short u16;
using bf16x8 = __attribute__((ext_vector_type(8))) short;
using f32x16 = __attribute__((ext_vector_type(16))) float;
using u32x4 = __attribute__((ext_vector_type(4))) unsigned;
using u32x2 = __attribute__((ext_vector_type(2))) unsigned;
using f32x4 = __attribute__((ext_vector_type(4))) float;
#define GAS __attribute__((address_space(1)))
#define GP(T, p) (reinterpret_cast<GAS T*>(reinterpret_cast<uintptr_t>(p)))
#define GPC(T, p) (reinterpret_cast<const GAS T*>(reinterpret_cast<uintptr_t>(p)))
typedef __bf16 bf2_t __attribute__((ext_vector_type(2)));
typedef float f2_t __attribute__((ext_vector_type(2)));
#define DI __device__ __forceinline__
#define MFMA(a, b, c) __builtin_amdgcn_mfma_f32_32x32x16_bf16((a), (b), (c), 0, 0, 0)

constexpr int DM = 1024, NB = 2, SEQ = 16384, CTX = 256, DEPTH = 2;
constexpr int MB = SEQ + CTX;
constexpr int MT = NB * MB;
constexpr int FFN = 2816;
constexpr int MIXIN = 8384, NPROJ = 5312;
constexpr float EPS = 1e-6f;
constexpr float LOG2E = 1.4426950408889634f;

constexpr size_t SZ_WIN = (size_t)2 * FFN * DM * 2;
constexpr size_t SZ_WOUT = (size_t)DM * FFN * 2;
constexpr size_t O_WIN = 0;
constexpr size_t O_WOUT = O_WIN + 2 * SZ_WIN;
constexpr size_t O_WMIX = O_WOUT + 2 * SZ_WOUT;
constexpr size_t O_WUQ = O_WMIX + (size_t)MIXIN * DM * 2;
constexpr size_t O_WUKV = O_WUQ + (size_t)1536 * 384 * 2;
constexpr size_t O_WBR = O_WUKV + (size_t)2048 * 256 * 2;
constexpr size_t O_WMO = O_WBR + (size_t)3 * DM * DM * 2;
constexpr size_t O_MODS = O_WMO + (size_t)DM * DM * 2;
constexpr size_t O_ROPE = O_MODS + (size_t)DEPTH * 3 * 9216 * 4;
constexpr size_t O_LAM = O_ROPE + 2 * 256 * 16 * 4;
constexpr size_t O_BAR = O_LAM + 256;
constexpr size_t O_TCTX = O_BAR + 16384;
constexpr size_t O_U = O_TCTX + (size_t)NB * CTX * DM * 4;
constexpr size_t O_RX = O_U + (size_t)MT * DM * 2;
constexpr size_t O_ACT = O_RX;
constexpr size_t O_Y = O_ACT + (size_t)MT * FFN * 2;
constexpr size_t END_FFN = O_Y + (size_t)MT * DM * 4;
constexpr size_t SZ1 = (size_t)MB * DM * 2;
constexpr size_t SZQ = (size_t)MB * 256 * 2;
constexpr size_t O_QA = O_RX;
constexpr size_t O_KA = O_QA + SZ1;
constexpr size_t O_VAT = O_KA + SZ1;
constexpr size_t O_QB = O_VAT + SZ1;
constexpr size_t O_KB = O_QB + SZ1;
constexpr size_t O_VBT = O_KB + SZQ;
constexpr size_t O_CQ = O_VBT + SZQ;
constexpr size_t O_CKV = O_CQ + (size_t)MB * 384 * 2;
constexpr size_t O_KR = O_CKV + SZQ;
constexpr size_t O_QC = O_KR + (size_t)MB * 64 * 2;
constexpr size_t O_KCN = O_QC + (size_t)MB * 1536 * 2;
constexpr size_t O_VCT = O_KCN + SZ1;
constexpr size_t O_YA = O_VCT + SZ1;
constexpr size_t END_MIX = O_YA + 3 * SZ1;
constexpr size_t O_SG = O_QA;
constexpr size_t O_MERGED = O_QB;
constexpr size_t O_YO = O_KCN;
constexpr size_t WS_NEED = END_MIX > END_FFN ? END_MIX : END_FFN;

struct Params {
  const float* in[19];
  float* out;
  char* ws;
  float inv_freq[16];
  float linit[2];
  int pad[2];
};

DI int otid() { int t = threadIdx.x; asm volatile("" : "+v"(t)); return t; }
DI char* ows(const Params& P) {
  const unsigned long long w = reinterpret_cast<unsigned long long>(P.ws);
  unsigned lo = __builtin_amdgcn_readfirstlane((unsigned)w), hi = __builtin_amdgcn_readfirstlane((unsigned)(w >> 32));
  asm volatile("" : "+s"(lo), "+s"(hi));
  return reinterpret_cast<char*>(((unsigned long long)hi << 32) | lo);
}
DI const char* uptr(const void* p) {
  const unsigned long long w = reinterpret_cast<unsigned long long>(p);
  const unsigned lo = __builtin_amdgcn_readfirstlane((unsigned)w), hi = __builtin_amdgcn_readfirstlane((unsigned)(w >> 32));
  return reinterpret_cast<const char*>(((unsigned long long)hi << 32) | lo);
}
DI int crow(int i, int h) { return (i & 3) + 8 * (i >> 2) + 4 * h; }
DI unsigned pk2(float a, float b) { f2_t v = {a, b}; bf2_t r = __builtin_convertvector(v, bf2_t); return __builtin_bit_cast(unsigned, r); }
DI float bflo(unsigned x) { return __uint_as_float(x << 16); }
DI float bfhi(unsigned x) { return __uint_as_float(x & 0xffff0000u); }
DI float wave_sum(float v) {
#pragma unroll
  for (int o = 32; o > 0; o >>= 1) v += __shfl_xor(v, o);
  return v;
}
DI float xhalf_max(float v) {
  auto rr = __builtin_amdgcn_permlane32_swap(__float_as_uint(v), __float_as_uint(v), false, false);
  return fmaxf(__uint_as_float(rr[0]), __uint_as_float(rr[1]));
}
DI float xhalf_sum(float v) {
  auto rr = __builtin_amdgcn_permlane32_swap(__float_as_uint(v), __float_as_uint(v), false, false);
  return __uint_as_float(rr[0]) + __uint_as_float(rr[1]);
}
DI float vmax3(float a, float b, float c) { float r; asm("v_max3_f32 %0, %1, %2, %3" : "=v"(r) : "v"(a), "v"(b), "v"(c)); return r; }
DI float vmax3w(float a, float b, float c, float dep) { float r; asm volatile("s_nop 15\n\tv_max3_f32 %0, %1, %2, %3" : "=v"(r) : "v"(a), "v"(b), "v"(c), "v"(dep)); return r; }
DI float vmax3d(float a, float b, float c, float dep) { float r; asm("v_max3_f32 %0, %1, %2, %3" : "=v"(r) : "v"(a), "v"(b), "v"(c), "v"(dep)); return r; }
DI float sigmoidf_(float x) { return __builtin_amdgcn_rcpf(1.f + __builtin_amdgcn_exp2f(-LOG2E * x)); }
DI void st_bf16_tile(const f32x16& c, u16* dst, int h) {
#pragma unroll
  for (int q = 0; q < 4; ++q) {
    u32x2 v; v.x = pk2(c[4 * q], c[4 * q + 1]); v.y = pk2(c[4 * q + 2], c[4 * q + 3]);
    *GP(u32x2, dst + 8 * q + 4 * h) = v;
  }
}
DI void st_bf16_tile_vt(const f32x16& c, u16* dst, int h) {
#pragma unroll
  for (int q = 0; q < 4; ++q) {
    u32x2 v; v.x = pk2(c[4 * q], c[4 * q + 1]); v.y = pk2(c[4 * q + 2], c[4 * q + 3]);
    *GP(u32x2, dst + 16 * (q >> 1) + 8 * h + 4 * (q & 1)) = v;
  }
}
DI void st_f32_tile(const f32x16& c, float* dst, int h) {
#pragma unroll
  for (int q = 0; q < 4; ++q) {
    f32x4 v = {c[4 * q], c[4 * q + 1], c[4 * q + 2], c[4 * q + 3]};
    *GP(f32x4, dst + 8 * q + 4 * h) = v;
  }
}
DI void rope_tile(f32x16& c, const float* __restrict__ rope, int idx, int h) {
  const float* cp = rope + idx * 16 + 4 * h;
  const float* sp = cp + 256 * 16;
  const f32x4 c0 = *GPC(f32x4, cp), c1 = *GPC(f32x4, cp + 8);
  const f32x4 s0 = *GPC(f32x4, sp), s1 = *GPC(f32x4, sp + 8);
#define ROPE1(i, CS, SN) { const float x1 = c[i], x2 = c[(i) + 8]; c[i] = x1 * (CS) - x2 * (SN); c[(i) + 8] = x2 * (CS) + x1 * (SN); }
  ROPE1(0, c0.x, s0.x) ROPE1(1, c0.y, s0.y) ROPE1(2, c0.z, s0.z) ROPE1(3, c0.w, s0.w)
  ROPE1(4, c1.x, s1.x) ROPE1(5, c1.y, s1.y) ROPE1(6, c1.z, s1.z) ROPE1(7, c1.w, s1.w)
#undef ROPE1
}

template <bool TRANS>
DI void gemm_kloop(const u16* __restrict__ A, int lda, const u16* __restrict__ W, int ldw, int K, f32x16 (&acc)[2][2], char* lds) {
  const int tid = otid(), lane = tid & 63, wid = tid >> 6, r = lane & 31, h = lane >> 5;
  const int wm = wid >> 1, wn = wid & 1;
  const int lrow = tid >> 3, lkc = tid & 7;
  const unsigned voa = (unsigned)(lrow * lda + lkc * 8) * 2u, vob = (unsigned)(lrow * ldw + lkc * 8) * 2u;
  const char* Ab = reinterpret_cast<const char*>(A);
  const char* Wb = reinterpret_cast<const char*>(W);
  const int soff0 = lrow * 128 + ((lkc ^ ((lrow >> 1) & 7)) << 4);
  u32x4 ra0, ra1, ra2, ra3, rb0, rb1, rb2, rb3, rc0, rc1, rc2, rc3, rd0, rd1, rd2, rd3;
#define GLOAD(A0, A1, A2, A3, B0, B1, B2, B3, k0)                                \
  {                                                                              \
    const char* pa_ = Ab + (long)(k0) * 2;                                       \
    const char* pw_ = Wb + (long)(k0) * 2;                                       \
    A0 = *GPC(u32x4, pa_ + voa);                                                 \
    A1 = *GPC(u32x4, pa_ + (long)64 * lda + voa);                                \
    A2 = *GPC(u32x4, pa_ + (long)128 * lda + voa);                               \
    A3 = *GPC(u32x4, pa_ + (long)192 * lda + voa);                               \
    B0 = *GPC(u32x4, pw_ + vob);                                                 \
    B1 = *GPC(u32x4, pw_ + (long)64 * ldw + vob);                                \
    B2 = *GPC(u32x4, pw_ + (long)128 * ldw + vob);                               \
    B3 = *GPC(u32x4, pw_ + (long)192 * ldw + vob);                               \
  }
#define SSTORE(A0, A1, A2, A3, B0, B1, B2, B3, bufi)                             \
  {                                                                              \
    char* sb = lds + (bufi) * 32768 + soff0;                                     \
    *reinterpret_cast<u32x4*>(sb) = A0;                                          \
    *reinterpret_cast<u32x4*>(sb + 4096) = A1;                                   \
    *reinterpret_cast<u32x4*>(sb + 8192) = A2;                                   \
    *reinterpret_cast<u32x4*>(sb + 12288) = A3;                                  \
    *reinterpret_cast<u32x4*>(sb + 16384) = B0;                                  \
    *reinterpret_cast<u32x4*>(sb + 16384 + 4096) = B1;                           \
    *reinterpret_cast<u32x4*>(sb + 16384 + 8192) = B2;                           \
    *reinterpret_cast<u32x4*>(sb + 16384 + 12288) = B3;                          \
  }
#define SET0 ra0, ra1, ra2, ra3, rb0, rb1, rb2, rb3
#define SET1 rc0, rc1, rc2, rc3, rd0, rd1, rd2, rd3
#define GL(...) GLOAD(__VA_ARGS__)
#define SS(...) SSTORE(__VA_ARGS__)
  const int KT = K >> 6;
  const int xr = (r >> 1) & 7;
  const int aoff = (wm * 64 + r) * 128, boff = 16384 + (wn * 64 + r) * 128;
#define COMPUTE(bufi)                                                                                                              \
  {                                                                                                                                \
    const char* buf = lds + (bufi) * 32768;                                                                                        \
    bf16x8 a0n, a1n, b0n, b1n;                                                                                                     \
    {                                                                                                                              \
      const int co = (h ^ xr) << 4;                                                                                                \
      a0n = *reinterpret_cast<const bf16x8*>(buf + aoff + co); a1n = *reinterpret_cast<const bf16x8*>(buf + aoff + 4096 + co);     \
      b0n = *reinterpret_cast<const bf16x8*>(buf + boff + co); b1n = *reinterpret_cast<const bf16x8*>(buf + boff + 4096 + co);     \
    }                                                                                                                              \
    _Pragma("unroll") for (int s = 0; s < 4; ++s) {                                                                                \
      const bf16x8 a0 = a0n, a1 = a1n, b0 = b0n, b1 = b1n;                                                                         \
      if (s < 3) {                                                                                                                 \
        const int co = ((2 * (s + 1) + h) ^ xr) << 4;                                                                              \
        a0n = *reinterpret_cast<const bf16x8*>(buf + aoff + co); a1n = *reinterpret_cast<const bf16x8*>(buf + aoff + 4096 + co);   \
        b0n = *reinterpret_cast<const bf16x8*>(buf + boff + co); b1n = *reinterpret_cast<const bf16x8*>(buf + boff + 4096 + co);   \
      }                                                                                                                            \
      if (TRANS) {                                                                                                                 \
        acc[0][0] = MFMA(a0, b0, acc[0][0]); acc[0][1] = MFMA(a0, b1, acc[0][1]);                                                  \
        acc[1][0] = MFMA(a1, b0, acc[1][0]); acc[1][1] = MFMA(a1, b1, acc[1][1]);                                                  \
      } else {                                                                                                                     \
        acc[0][0] = MFMA(b0, a0, acc[0][0]); acc[0][1] = MFMA(b1, a0, acc[0][1]);                                                  \
        acc[1][0] = MFMA(b0, a1, acc[1][0]); acc[1][1] = MFMA(b1, a1, acc[1][1]);                                                  \
      }                                                                                                                            \
      __builtin_amdgcn_sched_barrier(0);                                                                                           \
    }                                                                                                                              \
  }
  GL(SET0, 0);
  SS(SET0, 0);
  GL(SET1, 64);
  __syncthreads();
  for (int kt = 0; kt < KT; kt += 2) {
    const bool m2 = kt + 2 < KT;
    if (m2) { GL(SET0, (kt + 2) * 64); }
    COMPUTE(0);
    SS(SET1, 1);
    __syncthreads();
    if (m2) { GL(SET1, (kt + 3) * 64); }
    COMPUTE(1);
    if (m2) { SS(SET0, 0); }
    __syncthreads();
  }
#undef GLOAD
#undef SSTORE
#undef SET0
#undef SET1
#undef GL
#undef SS
#undef COMPUTE
}

enum { EPI_SWIGLU = 0, EPI_YF32 = 1, EPI_PROJ = 2, EPI_UQKV = 3, EPI_SG = 4, EPI_MERGE = 5 };
struct GemmDesc {
  int epi, mtiles, ntiles, K, lda, skipctx;
  const u16* A; const u16* W;
  void* dst;
};

template <bool MERGE>
DI void gemm_phase(const GemmDesc& d, const Params& P, char* lds) {
  const int tid = otid(), lane = tid & 63, wid = tid >> 6, r = lane & 31, h = lane >> 5;
  const int wm = wid >> 1, wn = wid & 1;
  char* ws = ows(P);
  const float* rope = reinterpret_cast<const float*>(ws + O_ROPE);
  const int ntl = d.mtiles * d.ntiles;
  for (int t = blockIdx.x; t < ntl; t += gridDim.x) {
    int mt = t / d.ntiles;
    int nt = t - mt * d.ntiles;
    if (d.ntiles == 8) {
      const int m4 = d.mtiles & ~3;
      if (t < 8 * m4) {
        const int x = t & 7, k = t >> 3;
        nt = 4 * (x & 1) + (k & 3);
        mt = 4 * (k >> 2) + (x >> 1);
      }
    }
    if (d.skipctx && mt >= 128) mt += 2;
    const u16* A = d.A; const u16* W = d.W; int lda = d.lda, K = d.K;
    bool trans = false;
    int uq = 0;
    if (d.epi == EPI_PROJ) {
      const int n0 = nt * 128;
      trans = (n0 >= 2048 && n0 < 3072) || (n0 >= 4352 && n0 < 4608);
    } else if (d.epi == EPI_UQKV) {
      if (nt < 12) { uq = 1; A = reinterpret_cast<const u16*>(ws + O_CQ); lda = 384; K = 384; W = reinterpret_cast<const u16*>(ws + O_WUQ); }
      else { nt -= 12; A = reinterpret_cast<const u16*>(ws + O_CKV); lda = 256; K = 256; W = reinterpret_cast<const u16*>(ws + O_WUKV); trans = (nt & 1); }
    }
    const int n0 = nt * 128;
    constexpr int nrep = MERGE ? 3 : 1;
    f32x16 acc[2][2];
#pragma unroll 1
    for (int rep = 0; rep < nrep; ++rep) {
#pragma unroll
      for (int a = 0; a < 2; ++a)
#pragma unroll
        for (int b = 0; b < 2; ++b)
#pragma unroll
          for (int i = 0; i < 16; ++i) acc[a][b][i] = 0.f;
      const u16* Ar = A + (long)rep * ((long)MB * DM) + (long)(mt * 128) * lda;
      const u16* Wr = W + (long)rep * ((long)DM * DM) + (long)n0 * K;
      if (trans) gemm_kloop<true>(Ar, lda, Wr, K, K, acc, lds);
      else gemm_kloop<false>(Ar, lda, Wr, K, K, acc, lds);
      if constexpr (MERGE) {
        const u16* sg = reinterpret_cast<const u16*>(ws + O_SG);
        float* macc = reinterpret_cast<float*>(ws + O_YO);
        u16* mo = reinterpret_cast<u16*>(d.dst);
#pragma unroll
        for (int mi = 0; mi < 2; ++mi)
#pragma unroll
          for (int ni = 0; ni < 2; ++ni) {
            const long row = mt * 128 + wm * 64 + mi * 32 + r;
            const int col = n0 + wn * 64 + ni * 32 + 4 * h;
            const u16* gp = sg + row * 3072 + rep * 1024 + col;
            float* mp = macc + row * DM + col;
#pragma unroll
            for (int q = 0; q < 4; ++q) {
              const u32x2 g = *GPC(u32x2, gp + 8 * q);
              f32x4 v = {0.f, 0.f, 0.f, 0.f};
              if (rep > 0) v = *GPC(f32x4, mp + 8 * q);
              v.x += bflo(g.x) * acc[mi][ni][4 * q + 0]; v.y += bfhi(g.x) * acc[mi][ni][4 * q + 1];
              v.z += bflo(g.y) * acc[mi][ni][4 * q + 2]; v.w += bfhi(g.y) * acc[mi][ni][4 * q + 3];
              if (rep < 2) *GP(f32x4, mp + 8 * q) = v;
              else { u32x2 o = {pk2(v.x, v.y), pk2(v.z, v.w)}; *GP(u32x2, mo + row * DM + col + 8 * q) = o; }
            }
          }
      }
    }
    const int cb = n0 + wn * 64;
    const int rowb = mt * 128 + wm * 64;
    if constexpr (MERGE) {
    } else if (d.epi == EPI_SWIGLU) {
      u16* act = reinterpret_cast<u16*>(d.dst);
      const int acol = (n0 >> 1) + wn * 32;
#pragma unroll
      for (int mi = 0; mi < 2; ++mi) {
        f32x16 o;
#pragma unroll
        for (int i = 0; i < 16; ++i) { float a = acc[mi][0][i], b = acc[mi][1][i]; o[i] = a * sigmoidf_(a) * b; }
        st_bf16_tile(o, act + (long)(rowb + mi * 32 + r) * FFN + acol, h);
      }
    } else if (d.epi == EPI_YF32) {
      float* y = reinterpret_cast<float*>(d.dst);
#pragma unroll
      for (int mi = 0; mi < 2; ++mi)
#pragma unroll
        for (int ni = 0; ni < 2; ++ni) st_f32_tile(acc[mi][ni], y + (long)(rowb + mi * 32 + r) * DM + cb + ni * 32, h);
    } else if (d.epi == EPI_SG) {
      u16* sg = reinterpret_cast<u16*>(d.dst);
#pragma unroll
      for (int mi = 0; mi < 2; ++mi)
#pragma unroll
        for (int ni = 0; ni < 2; ++ni) {
          f32x16 o;
#pragma unroll
          for (int i = 0; i < 16; ++i) o[i] = sigmoidf_(acc[mi][ni][i]);
          st_bf16_tile(o, sg + (long)(rowb + mi * 32 + r) * 3072 + cb + ni * 32, h);
        }
    } else if (trans) {
      u16* vt; int f0;
      if (d.epi == EPI_PROJ) {
        if (cb < 3072) { vt = reinterpret_cast<u16*>(ws + O_VAT); f0 = cb - 2048; }
        else { vt = reinterpret_cast<u16*>(ws + O_VBT); f0 = cb - 4352; }
      } else { vt = reinterpret_cast<u16*>(ws + O_VCT); f0 = (nt >> 1) * 128 + wn * 64; }
#pragma unroll
      for (int mi = 0; mi < 2; ++mi)
#pragma unroll
        for (int ni = 0; ni < 2; ++ni) st_bf16_tile_vt(acc[mi][ni], vt + (long)(f0 + ni * 32 + r) * MB + rowb + mi * 32, h);
    } else {
      u16* dst = nullptr; int ld = 0, cofs = 0; bool rp = false;
      if (d.epi == EPI_PROJ) {
        if (cb < 1024) { dst = reinterpret_cast<u16*>(ws + O_QA); ld = 1024; cofs = cb; rp = true; }
        else if (cb < 2048) { dst = reinterpret_cast<u16*>(ws + O_KA); ld = 1024; cofs = cb - 1024; rp = true; }
        else if (cb < 4096) { dst = reinterpret_cast<u16*>(ws + O_QB); ld = 1024; cofs = cb - 3072; rp = true; }
        else if (cb < 4352) { dst = reinterpret_cast<u16*>(ws + O_KB); ld = 256; cofs = cb - 4096; rp = true; }
        else if (cb < 4992) { dst = reinterpret_cast<u16*>(ws + O_CQ); ld = 384; cofs = cb - 4608; }
        else if (cb < 5248) { dst = reinterpret_cast<u16*>(ws + O_CKV); ld = 256; cofs = cb - 4992; }
        else if (cb < 5312) { dst = reinterpret_cast<u16*>(ws + O_KR); ld = 64; cofs = 0; rp = true; }
      } else {
        if (uq) { dst = reinterpret_cast<u16*>(ws + O_QC); ld = 1536; cofs = cb; rp = (cb % 192) == 128; }
        else { dst = reinterpret_cast<u16*>(ws + O_KCN); ld = 1024; cofs = (nt >> 1) * 128 + wn * 64; }
      }
      if (dst != nullptr) {
        const bool latent = mt < 128;
#pragma unroll
        for (int mi = 0; mi < 2; ++mi) {
          const int lr = rowb + mi * 32 + r;
#pragma unroll
          for (int ni = 0; ni < 2; ++ni) {
            f32x16 o = acc[mi][ni];
            if (rp && latent) rope_tile(o, rope, ni == 0 ? (lr >> 6) : (lr & 63), h);
            st_bf16_tile(o, dst + (long)lr * ld + cofs + ni * 32, h);
          }
        }
      }
    }
  }
}

struct RowDesc {
  int g0, g1, skipctx;
  const float* told_lat; const float* told_ctx;
  const float* ybuf; int yrow0;
  float gscale; int gate_idx, gpost_idx, layer;
  int has_u, ulayer, gpre_idx, shift_idx, scale_idx;
};

DI void rowop_phase(const RowDesc& d, const Params& P) {
  const int tid_ = otid(); const int lane = tid_ & 63, wid = tid_ >> 6;
  char* ws = ows(P);
  const float* mods = reinterpret_cast<const float*>(ws + O_MODS);
  const float* normg = P.in[6];
  float* tctx = reinterpret_cast<float*>(ws + O_TCTX);
  u16* U = reinterpret_cast<u16*>(ws + O_U);
  const int stride = gridDim.x * 4;
  const bool has_y = d.ybuf != nullptr;
  f32x4 tn[4], yn[4];
  bool vn = false;
#define LOADROW(g_)                                                                                              \
  {                                                                                                              \
    const int b_ = (g_) / MB, i_ = (g_) - b_ * MB;                                                               \
    const bool lat_ = i_ < SEQ;                                                                                  \
    vn = !(d.skipctx && !lat_);                                                                                  \
    if (vn) {                                                                                                    \
      const long toff_ = lat_ ? ((long)(b_ * SEQ + i_)) * DM : ((long)(b_ * CTX + i_ - SEQ)) * DM;               \
      const float* told_ = (lat_ ? d.told_lat : d.told_ctx) + toff_;                                             \
      _Pragma("unroll") for (int j = 0; j < 4; ++j) tn[j] = *GPC(f32x4, told_ + lane * 4 + 256 * j);             \
      if (has_y) {                                                                                               \
        const float* y_ = d.ybuf + (long)((g_) - d.yrow0) * DM;                                                  \
        _Pragma("unroll") for (int j = 0; j < 4; ++j) yn[j] = *GPC(f32x4, y_ + lane * 4 + 256 * j);              \
      }                                                                                                          \
    }                                                                                                            \
  }
  int gnext = d.g0 + blockIdx.x * 4 + wid;
  if (gnext < d.g1) { LOADROW(gnext) }
  while (gnext < d.g1) {
    const int g = gnext;
    const bool v = vn;
    f32x4 t[4], yv[4];
#pragma unroll
    for (int j = 0; j < 4; ++j) { t[j] = tn[j]; yv[j] = yn[j]; }
    gnext += stride;
    if (gnext < d.g1) { LOADROW(gnext) }
    if (!v) continue;
    const int b = g / MB, i = g - b * MB;
    const bool lat = i < SEQ;
    const int midx = lat ? b : 2;
    const long toff = lat ? ((long)(b * SEQ + i)) * DM : ((long)(b * CTX + i - SEQ)) * DM;
    if (has_y) {
      float ss = 0.f;
#pragma unroll
      for (int j = 0; j < 4; ++j) ss += yv[j].x * yv[j].x + yv[j].y * yv[j].y + yv[j].z * yv[j].z + yv[j].w * yv[j].w;
      ss = wave_sum(ss);
      const float rr = rsqrtf(ss * (1.f / DM) + EPS) * d.gscale;
      const float* gate = mods + (d.layer * 3 + midx) * 9216 + d.gate_idx * DM;
      const float* gp = normg + (d.layer * 6 + d.gpost_idx) * DM;
      float* tnew = (lat ? P.out : tctx) + toff;
#pragma unroll
      for (int j = 0; j < 4; ++j) {
        f32x4 ga = *GPC(f32x4, gate + lane * 4 + 256 * j);
        f32x4 gg = *GPC(f32x4, gp + lane * 4 + 256 * j);
        t[j].x += ga.x * (yv[j].x * rr * gg.x); t[j].y += ga.y * (yv[j].y * rr * gg.y);
        t[j].z += ga.z * (yv[j].z * rr * gg.z); t[j].w += ga.w * (yv[j].w * rr * gg.w);
        *GP(f32x4, tnew + lane * 4 + 256 * j) = t[j];
      }
    }
    if (d.has_u) {
      float ss = 0.f;
#pragma unroll
      for (int j = 0; j < 4; ++j) ss += t[j].x * t[j].x + t[j].y * t[j].y + t[j].z * t[j].z + t[j].w * t[j].w;
      ss = wave_sum(ss);
      const float rr = rsqrtf(ss * (1.f / DM) + EPS);
      const float* mu = mods + (d.ulayer * 3 + midx) * 9216;
      const float* sh = mu + d.shift_idx * DM; const float* sc = mu + d.scale_idx * DM;
      const float* gp = normg + (d.ulayer * 6 + d.gpre_idx) * DM;
      u16* u = U + (long)g * DM;
#pragma unroll
      for (int j = 0; j < 4; ++j) {
        f32x4 gg = *GPC(f32x4, gp + lane * 4 + 256 * j);
        f32x4 s1 = *GPC(f32x4, sc + lane * 4 + 256 * j);
        f32x4 s0 = *GPC(f32x4, sh + lane * 4 + 256 * j);
        float a = (t[j].x * rr * gg.x) * (1.f + s1.x) + s0.x, bb = (t[j].y * rr * gg.y) * (1.f + s1.y) + s0.y;
        float c = (t[j].z * rr * gg.z) * (1.f + s1.z) + s0.z, dd = (t[j].w * rr * gg.w) * (1.f + s1.w) + s0.w;
        u32x2 v2; v2.x = pk2(a, bb); v2.y = pk2(c, dd);
        *GP(u32x2, u + lane * 4 + 256 * j) = v2;
      }
    }
  }
#undef LOADROW
}

DI void r3_phase(int layer, const Params& P) {
  const int tid_ = otid(); const int lane = tid_ & 63, wid = tid_ >> 6;
  char* ws = ows(P);
  u16* cq = reinterpret_cast<u16*>(ws + O_CQ);
  u16* ckv = reinterpret_cast<u16*>(ws + O_CKV);
  const float* gq = P.in[13] + layer * 384;
  const float* gkv = P.in[14] + layer * 256;
  for (int row = blockIdx.x * 4 + wid; row < MB; row += gridDim.x * 4) {
    {
      u16* p = cq + (long)row * 384;
      float v[6]; float ss = 0.f;
#pragma unroll
      for (int j = 0; j < 3; ++j) {
        unsigned x = *GPC(unsigned, p + lane * 2 + 128 * j);
        v[2 * j] = bflo(x); v[2 * j + 1] = bfhi(x); ss += v[2 * j] * v[2 * j] + v[2 * j + 1] * v[2 * j + 1];
      }
      ss = wave_sum(ss);
      const float rr = rsqrtf(ss * (1.f / 384.f) + EPS);
#pragma unroll
      for (int j = 0; j < 3; ++j) {
        const int c = lane * 2 + 128 * j;
        *GP(unsigned, p + c) = pk2(v[2 * j] * rr * gq[c], v[2 * j + 1] * rr * gq[c + 1]);
      }
    }
    {
      u16* p = ckv + (long)row * 256;
      u32x2 x = *GPC(u32x2, p + lane * 4);
      float v0 = bflo(x.x), v1 = bfhi(x.x), v2 = bflo(x.y), v3 = bfhi(x.y);
      float ss = wave_sum(v0 * v0 + v1 * v1 + v2 * v2 + v3 * v3);
      const float rr = rsqrtf(ss * (1.f / 256.f) + EPS);
      const int c = lane * 4;
      u32x2 o; o.x = pk2(v0 * rr * gkv[c], v1 * rr * gkv[c + 1]); o.y = pk2(v2 * rr * gkv[c + 2], v3 * rr * gkv[c + 3]);
      *GP(u32x2, p + c) = o;
    }
  }
}

template <int DQK, int DV, int TYPE>
DI void attn_item(int layer, int qt, int head, char* lds, const Params& P) {
  const int tid = otid(), lane = tid & 63, wid = tid >> 6, r = lane & 31, h = lane >> 5;
  char* ws = ows(P);
  constexpr int NS = DQK / 16, NDV = DV / 32;
  constexpr bool DB = DQK == 64;
  constexpr int KBYTES = 64 * DQK * 2;
  constexpr int STAGE = DB ? 24576 : 0;
  constexpr int VOFF = DB ? 8192 : 24576;
  constexpr float SCALE = TYPE == 1 ? 0.07216878364870322f : 0.125f;
  constexpr float C = SCALE * LOG2E;
  const bool latent = qt < 128;
  int ta0, na, NT;
  if (!latent) { ta0 = 256; na = 4; NT = 4; }
  else if (TYPE == 2) { int lo = qt * 2 - 2; if (lo < 0) lo = 0; int hi = qt * 2 + 4; if (hi > 256) hi = 256; ta0 = lo; na = hi - lo; NT = na + 4; }
  else { ta0 = 0; na = 260; NT = 260; }
  const int qrow = qt * 128 + wid * 32 + r;
  const u16* Kp; int ldk; const u16* Vp;
  if (TYPE == 0) { Kp = reinterpret_cast<const u16*>(ws + O_KA) + head * 128; ldk = 1024; Vp = reinterpret_cast<const u16*>(ws + O_VAT) + (long)(head * 128) * MB; }
  else if (TYPE == 1) { Kp = reinterpret_cast<const u16*>(ws + O_KCN) + head * 128; ldk = 1024; Vp = reinterpret_cast<const u16*>(ws + O_VCT) + (long)(head * 128) * MB; }
  else { Kp = reinterpret_cast<const u16*>(ws + O_KB) + (head >> 2) * 64; ldk = 256; Vp = reinterpret_cast<const u16*>(ws + O_VBT) + (long)((head >> 2) * 64) * MB; }
  const u16* K2 = reinterpret_cast<const u16*>(ws + O_KR);
  const int kr_a = (DQK == 64) ? (tid >> 3) : (tid >> 4), kc_a = (DQK == 64) ? (tid & 7) : (tid & 15);
  const int kgo_a = kr_a * ldk + kc_a * 8;
  const int kso_a = kr_a * (DQK * 2) + ((kc_a ^ ((kr_a >> 1) & 7)) << 4);
  const int kr_b = tid >> 3, kc_b = 16 + (tid & 7);
  const int kgo_b = kr_b * 64 + (tid & 7) * 8;
  const int kso_b = kr_b * (DQK * 2) + ((kc_b ^ ((kr_b >> 1) & 7)) << 4);
  const int vdv = tid >> 3, vkc = tid & 7, vxs = (vdv >> 1) & 7;
  const unsigned vvo = (unsigned)(vdv * MB + vkc * 8) * 2u;
  const unsigned kvo_a = (unsigned)kgo_a * 2u, kvo_b = (unsigned)kgo_b * 2u;
  const int vso = VOFF + vdv * 128 + ((vkc ^ vxs) << 4);
  u32x4 kreg0, kreg1, kreg2, kreg3, kreg4, kreg5, vreg0, vreg1, vreg2, vreg3;
  const int xr = (r >> 1) & 7;
  constexpr int NMAPS = TYPE == 0 ? 2 : 1;
  u16* ya_dst = reinterpret_cast<u16*>(ws + O_YA) + (long)qrow * 1024 + head * 128;
  for (int map = 0; map < NMAPS; ++map) {
    const u16* Kb = Kp + map * 64;
    const u16* Qp;
    if (TYPE == 0) Qp = reinterpret_cast<const u16*>(ws + O_QA) + (long)qrow * 1024 + head * 128 + map * 64;
    else if (TYPE == 1) Qp = reinterpret_cast<const u16*>(ws + O_QC) + (long)qrow * 1536 + head * 192;
    else Qp = reinterpret_cast<const u16*>(ws + O_QB) + (long)qrow * 1024 + head * 64;
    constexpr int NQR = NS > 6 ? 6 : NS;
    bf16x8 qf[NQR];
#pragma unroll
    for (int s = 0; s < NQR; ++s) qf[s] = *GPC(bf16x8, Qp + 16 * s + 8 * h);
    char* qpark = lds + 40960 + tid * 16;
#pragma unroll
    for (int s = NQR; s < NS; ++s) *reinterpret_cast<bf16x8*>(qpark + (s - NQR) * 4096) = *GPC(bf16x8, Qp + 16 * s + 8 * h);
    float m_run, l_run;
    if (TYPE == 2) { m_run = P.in[12][layer * 16 + head] * (1.f / SCALE); l_run = 1.f; }
    else { m_run = -1e30f; l_run = 0.f; }
    f32x16 oacc[NDV];
#pragma unroll
    for (int d = 0; d < NDV; ++d)
#pragma unroll
      for (int i = 0; i < 16; ++i) oacc[d][i] = 0.f;
#define TILE_OF(j) ((j) < na ? ta0 + (j) : 256 + ((j) - na))
#define LDG(p) (*GPC(u32x4, p))
#define ATT_GLOAD(tile)                                                                                          \
  {                                                                                                              \
    const long key0 = (long)(tile) * 64;                                                                         \
    const char* kp_ = uptr(Kb + key0 * ldk);                                                    \
    if constexpr (DQK == 64) {                                                                                   \
      kreg0 = LDG(kp_ + kvo_a); kreg1 = LDG(kp_ + (long)64 * ldk + kvo_a);                                       \
    } else {                                                                                                     \
      kreg0 = LDG(kp_ + kvo_a); kreg1 = LDG(kp_ + (long)32 * ldk + kvo_a);                                       \
      kreg2 = LDG(kp_ + (long)64 * ldk + kvo_a); kreg3 = LDG(kp_ + (long)96 * ldk + kvo_a);                      \
      const char* k2_ = uptr(K2 + key0 * 64);                                           \
      kreg4 = LDG(k2_ + kvo_b); kreg5 = LDG(k2_ + 32 * 64 * 2 + kvo_b);                                          \
    }                                                                                                            \
    const char* vp_ = uptr(Vp + key0);                                                  \
    vreg0 = LDG(vp_ + vvo); vreg1 = LDG(vp_ + (long)64 * MB + vvo);                                              \
    if constexpr (DV == 128) { vreg2 = LDG(vp_ + (long)128 * MB + vvo); vreg3 = LDG(vp_ + (long)192 * MB + vvo); } \
  }
#define STV(sb, j, v) { *reinterpret_cast<u32x4*>((sb) + vso + (j) * 4096) = v; }
#define ATT_SSTORE(sb)                                                                                           \
  {                                                                                                              \
    if constexpr (DQK == 64) {                                                                                   \
      *reinterpret_cast<u32x4*>((sb) + kso_a) = kreg0; *reinterpret_cast<u32x4*>((sb) + kso_a + 4096) = kreg1;   \
    } else {                                                                                                     \
      *reinterpret_cast<u32x4*>((sb) + kso_a) = kreg0; *reinterpret_cast<u32x4*>((sb) + kso_a + 16 * 384) = kreg1; \
      *reinterpret_cast<u32x4*>((sb) + kso_a + 32 * 384) = kreg2; *reinterpret_cast<u32x4*>((sb) + kso_a + 48 * 384) = kreg3; \
      *reinterpret_cast<u32x4*>((sb) + kso_b) = kreg4; *reinterpret_cast<u32x4*>((sb) + kso_b + 32 * 384) = kreg5; \
    }                                                                                                            \
    STV(sb, 0, vreg0) STV(sb, 1, vreg1)                                                                          \
    if constexpr (DV == 128) { STV(sb, 2, vreg2) STV(sb, 3, vreg3) }                                             \
  }
    ATT_GLOAD(TILE_OF(0));
    ATT_SSTORE(lds);
    if constexpr (DB) { if (1 < NT) { ATT_GLOAD(TILE_OF(1)); } }
    __syncthreads();
    for (int j = 0; j < NT; ++j) {
      const int tile = TILE_OF(j);
      const char* sb = lds + (DB ? (j & 1) * STAGE : 0);
      constexpr int KD = 2, KRING = 3;
      bf16x8 kr0[KRING], kr1[KRING];
#define KFR(s_, slot_)                                                                          \
  {                                                                                             \
    const int co = ((2 * (s_) + h) ^ xr) << 4;                                                  \
    kr0[slot_] = *reinterpret_cast<const bf16x8*>(sb + r * (DQK * 2) + co);                     \
    kr1[slot_] = *reinterpret_cast<const bf16x8*>(sb + (32 + r) * (DQK * 2) + co);              \
  }
#pragma unroll
      for (int s = 0; s < KD; ++s) KFR(s, s)
      __builtin_amdgcn_sched_barrier(0);
      if constexpr (DB) {
        char* sn = lds + ((j + 1) & 1) * STAGE;
        if (j + 1 < NT) { ATT_SSTORE(sn); }
        if (j + 2 < NT) { ATT_GLOAD(TILE_OF(j + 2)); }
      } else {
        if (j + 1 < NT) { ATT_GLOAD(TILE_OF(j + 1)); }
      }
      f32x16 s0, s1;
#pragma unroll
      for (int i = 0; i < 16; ++i) { s0[i] = 0.f; s1[i] = 0.f; }
      {
#pragma unroll
        for (int s = 0; s < NS; ++s) {
          if (s + KD < NS) KFR(s + KD, (s + KD) % KRING)
          bf16x8 qs;
          if constexpr (NS > NQR) { if (s < NQR) qs = qf[s < NQR ? s : 0]; else qs = *reinterpret_cast<const bf16x8*>(qpark + (s - NQR) * 4096); }
          else qs = qf[s];
          s0 = MFMA(kr0[s % KRING], qs, s0);
          s1 = MFMA(kr1[s % KRING], qs, s1);
          __builtin_amdgcn_sched_barrier(0);
        }
#undef KFR
      }
      const char* vb0 = sb + VOFF + r * 128;
#define VFRAG(d, B) (*reinterpret_cast<const bf16x8*>(vb0 + (d) * 4096 + (((2 * (B) + h) ^ xr) << 4)))
      constexpr int VD = 3;
      bf16x8 vr[8];
#pragma unroll
      for (int g = 0; g < VD; ++g) vr[g] = VFRAG(g >> 2, g & 3);
      if (TYPE == 2 && latent && j < na) {
        const int kb0 = tile * 64 - qrow;
#pragma unroll
        for (int i = 0; i < 16; ++i) {
          const int d0 = kb0 + crow(i, h), d1 = d0 + 32;
          if (d0 > 128 || d0 < -128) s0[i] = -1e30f;
          if (d1 > 128 || d1 < -128) s1[i] = -1e30f;
        }
      }
      const float tm0 = vmax3w(s0[0], s0[1], s0[2], s1[0]);
      const float tm1 = vmax3d(s0[3], s0[4], s0[5], tm0), tm2 = vmax3d(s0[6], s0[7], s0[8], tm1), tm3 = vmax3d(s0[9], s0[10], s0[11], tm2);
      const float tm4 = vmax3d(s0[12], s0[13], s0[14], tm3);
      const float tm5 = vmax3d(s1[0], s1[1], s1[2], tm4), tm6 = vmax3d(s1[3], s1[4], s1[5], tm5), tm7 = vmax3d(s1[6], s1[7], s1[8], tm5);
      const float tm8 = vmax3d(s1[9], s1[10], s1[11], tm5), tm9 = vmax3d(s1[12], s1[13], s1[14], tm5), tma = vmax3d(s0[15], s1[15], tm0, tm5), tmb = vmax3(tm1, tm2, tm3);
      const float tmc = vmax3(tm4, tm5, tm6), tmd = vmax3(tm7, tm8, tm9);
      float tmax = xhalf_max(vmax3(vmax3(tma, tmb, tmc), tmd, tmd));
      const float mnew = fmaxf(m_run, tmax);
      const float alpha = __builtin_amdgcn_exp2f((m_run - mnew) * C);
      m_run = mnew;
      const float mc = -mnew * C;
      float pa = 0.f, pb = 0.f, pc = 0.f, pd = 0.f;
#pragma unroll
      for (int i = 0; i < 16; i += 2) {
        s0[i] = __builtin_amdgcn_exp2f(fmaf(s0[i], C, mc)); pa += s0[i];
        s0[i + 1] = __builtin_amdgcn_exp2f(fmaf(s0[i + 1], C, mc)); pb += s0[i + 1];
      }
#pragma unroll
      for (int i = 0; i < 16; i += 2) {
        s1[i] = __builtin_amdgcn_exp2f(fmaf(s1[i], C, mc)); pc += s1[i];
        s1[i + 1] = __builtin_amdgcn_exp2f(fmaf(s1[i + 1], C, mc)); pd += s1[i + 1];
      }
      const float ps = xhalf_sum((pa + pb) + (pc + pd));
      l_run = l_run * alpha + ps;
      if (__any(alpha != 1.f)) {
#pragma unroll
        for (int d = 0; d < NDV; ++d)
#pragma unroll
          for (int i = 0; i < 16; ++i) oacc[d][i] *= alpha;
      }
      bf16x8 pf[4];
#pragma unroll
      for (int sp = 0; sp < 2; ++sp) {
        u32x4 w0, w1;
        w0.x = pk2(s0[8 * sp + 0], s0[8 * sp + 1]); w0.y = pk2(s0[8 * sp + 2], s0[8 * sp + 3]);
        w0.z = pk2(s0[8 * sp + 4], s0[8 * sp + 5]); w0.w = pk2(s0[8 * sp + 6], s0[8 * sp + 7]);
        w1.x = pk2(s1[8 * sp + 0], s1[8 * sp + 1]); w1.y = pk2(s1[8 * sp + 2], s1[8 * sp + 3]);
        w1.z = pk2(s1[8 * sp + 4], s1[8 * sp + 5]); w1.w = pk2(s1[8 * sp + 6], s1[8 * sp + 7]);
        pf[sp] = __builtin_bit_cast(bf16x8, w0);
        pf[2 + sp] = __builtin_bit_cast(bf16x8, w1);
      }
      {
#pragma unroll
        for (int f = 0; f < NDV * 4; ++f) {
          if (f + VD < NDV * 4) vr[(f + VD) & 7] = VFRAG((f + VD) >> 2, (f + VD) & 3);
          oacc[f >> 2] = MFMA(vr[f & 7], pf[f & 3], oacc[f >> 2]);
          __builtin_amdgcn_sched_barrier(0);
        }
#undef VFRAG
      }
      __syncthreads();
      if constexpr (!DB) {
        if (j + 1 < NT) { ATT_SSTORE(lds); }
        __syncthreads();
      }
    }
#undef ATT_GLOAD
#undef ATT_SSTORE
#undef STV
#undef LDG
#undef TILE_OF
    const float il = 1.f / l_run;
    if (TYPE == 0 && map == 0) {
#pragma unroll
      for (int d = 0; d < NDV; ++d) {
        f32x16 o;
#pragma unroll
        for (int i = 0; i < 16; ++i) o[i] = oacc[d][i] * il;
        st_bf16_tile(o, ya_dst + d * 32, h);
      }
    } else if (TYPE == 0) {
      const float lam = reinterpret_cast<const float*>(ws + O_LAM)[layer];
      float ss = 0.f;
#pragma unroll
      for (int d = 0; d < NDV; ++d) {
#pragma unroll
        for (int q = 0; q < 4; ++q) {
          const u32x2 w = *GPC(u32x2, ya_dst + d * 32 + 8 * q + 4 * h);
          const float v0 = bflo(w.x) - lam * (oacc[d][4 * q + 0] * il), v1 = bfhi(w.x) - lam * (oacc[d][4 * q + 1] * il);
          const float v2 = bflo(w.y) - lam * (oacc[d][4 * q + 2] * il), v3 = bfhi(w.y) - lam * (oacc[d][4 * q + 3] * il);
          oacc[d][4 * q + 0] = v0; oacc[d][4 * q + 1] = v1; oacc[d][4 * q + 2] = v2; oacc[d][4 * q + 3] = v3;
          ss += v0 * v0 + v1 * v1 + v2 * v2 + v3 * v3;
        }
      }
      ss = xhalf_sum(ss);
      const float rr = rsqrtf(ss * (1.f / 128.f) + EPS) * (1.f - P.linit[layer]);
      const float* sg = P.in[11] + layer * 128;
#pragma unroll
      for (int d = 0; d < NDV; ++d) {
        f32x16 o;
#pragma unroll
        for (int q = 0; q < 4; ++q) {
          const f32x4 g4 = *GPC(f32x4, sg + d * 32 + 8 * q + 4 * h);
          o[4 * q] = oacc[d][4 * q] * rr * g4.x; o[4 * q + 1] = oacc[d][4 * q + 1] * rr * g4.y;
          o[4 * q + 2] = oacc[d][4 * q + 2] * rr * g4.z; o[4 * q + 3] = oacc[d][4 * q + 3] * rr * g4.w;
        }
        st_bf16_tile(o, ya_dst + d * 32, h);
      }
    } else {
      u16* dst = TYPE == 1 ? reinterpret_cast<u16*>(ws + O_YA + 2 * SZ1) + (long)qrow * 1024 + head * 128
                           : reinterpret_cast<u16*>(ws + O_YA + SZ1) + (long)qrow * 1024 + head * 64;
#pragma unroll
      for (int d = 0; d < NDV; ++d) {
        f32x16 o;
#pragma unroll
        for (int i = 0; i < 16; ++i) o[i] = oacc[d][i] * il;
        st_bf16_tile(o, dst + d * 32, h);
      }
    }
  }
  __syncthreads();
}

DI void attn_phase(int layer, const Params& P, char* lds) {
  const int NITEMS = layer + 1 < DEPTH ? 4096 + 64 : 4096;
  for (int w = blockIdx.x; w < NITEMS; w += gridDim.x) {
    if (w < 1024) attn_item<64, 128, 0>(layer, w >> 3, w & 7, lds, P);
    else if (w < 2048) attn_item<192, 128, 1>(layer, (w - 1024) >> 3, w & 7, lds, P);
    else if (w < 4096) attn_item<64, 64, 2>(layer, (w - 2048) >> 4, w & 15, lds, P);
    else if (w < 4112) attn_item<64, 128, 0>(layer, 128 + ((w - 4096) >> 3), w & 7, lds, P);
    else if (w < 4128) attn_item<192, 128, 1>(layer, 128 + ((w - 4112) >> 3), w & 7, lds, P);
    else attn_item<64, 64, 2>(layer, 128 + ((w - 4128) >> 4), w & 15, lds, P);
  }
}

DI void conv_tile(const float* __restrict__ src, int K, int N, u16* __restrict__ dst, int tile, int perm, char* lds) {
  float* sm = reinterpret_cast<float*>(lds);
  const int tid = otid();
  const int nts = N >> 6;
  const int kt = tile / nts, ntile = tile - kt * nts;
  const int k0 = kt * 64, n0 = ntile * 64;
#pragma unroll
  for (int j = 0; j < 16; ++j) {
    const int k = j * 4 + (tid >> 6), n = tid & 63;
    sm[k * 65 + n] = src[(long)(k0 + k) * N + n0 + n];
  }
  __syncthreads();
#pragma unroll
  for (int j = 0; j < 2; ++j) {
    const int n = (tid >> 3) + 32 * j, kc = tid & 7;
    float v[8];
#pragma unroll
    for (int e = 0; e < 8; ++e) v[e] = sm[(kc * 8 + e) * 65 + n];
    int nn = n0 + n;
    if (perm) { const int s = nn >= FFN ? 1 : 0; const int jj = nn - s * FFN; nn = 64 * (jj >> 5) + 32 * s + (jj & 31); }
    u32x4 o; o.x = pk2(v[0], v[1]); o.y = pk2(v[2], v[3]); o.z = pk2(v[4], v[5]); o.w = pk2(v[6], v[7]);
    *GP(u32x4, dst + (long)nn * K + k0 + kc * 8) = o;
  }
  __syncthreads();
}

constexpr int CONV_TILES = 7616;
DI void conv_phase(int layer, const Params& P, char* lds, int extra_first) {
  char* ws = ows(P);
  for (int t = blockIdx.x + extra_first; t < CONV_TILES + extra_first; t += gridDim.x) {
    int x = t - extra_first;
    const float* src; int K, N, perm = 0; u16* dst;
    if (x < 2816) { const int s = x / 1408; x -= s * 1408; src = P.in[7] + ((long)(layer * 2 + s)) * DM * 2 * FFN; K = DM; N = 2 * FFN; perm = 1; dst = reinterpret_cast<u16*>(ws + O_WIN + s * SZ_WIN); }
    else if (x < 4224) { x -= 2816; const int s = x / 704; x -= s * 704; src = P.in[8] + ((long)(layer * 2 + s)) * FFN * DM; K = FFN; N = DM; dst = reinterpret_cast<u16*>(ws + O_WOUT + s * SZ_WOUT); }
    else if (x < 6320) { x -= 4224; src = P.in[9] + (long)layer * DM * MIXIN; K = DM; N = MIXIN; dst = reinterpret_cast<u16*>(ws + O_WMIX); }
    else if (x < 6464) { x -= 6320; src = P.in[15] + (long)layer * 384 * 1536; K = 384; N = 1536; dst = reinterpret_cast<u16*>(ws + O_WUQ); }
    else if (x < 6592) { x -= 6464; src = P.in[16] + (long)layer * 256 * 2048; K = 256; N = 2048; dst = reinterpret_cast<u16*>(ws + O_WUKV); }
    else if (x < 7360) { x -= 6592; const int br = x / 256; x -= br * 256; src = P.in[17] + ((long)(layer * 3 + br)) * DM * DM; K = DM; N = DM; dst = reinterpret_cast<u16*>(ws + O_WBR) + (long)br * DM * DM; }
    else { x -= 7360; src = P.in[18] + (long)layer * DM * DM; K = DM; N = DM; dst = reinterpret_cast<u16*>(ws + O_WMO); }
    conv_tile(src, K, N, dst, x, perm, lds);
  }
}

DI void mods_item(int item, const Params& P, char* lds) {
  float* sv = reinterpret_cast<float*>(lds);
  float* red = sv + 3 * 1024;
  const int tid = otid();
  const int l = item / 144, nb = item - l * 144;
  for (int e = tid; e < 3 * 1024; e += 256) {
    const int v = e >> 10, k = e & 1023;
    const float x = v < 2 ? P.in[1][v * DM + k] : P.in[3][k];
    sv[e] = x / (1.f + __expf(-x));
  }
  __syncthreads();
  const int c = tid & 63, kg = tid >> 6;
  const float* w = P.in[4] + (long)l * DM * 9216 + nb * 64 + c;
  float a0 = 0.f, a1 = 0.f, a2 = 0.f;
  for (int k = kg * 256; k < kg * 256 + 256; ++k) {
    const float wv = w[(long)k * 9216];
    a0 += sv[k] * wv; a1 += sv[1024 + k] * wv; a2 += sv[2048 + k] * wv;
  }
  red[(kg * 3 + 0) * 64 + c] = a0; red[(kg * 3 + 1) * 64 + c] = a1; red[(kg * 3 + 2) * 64 + c] = a2;
  __syncthreads();
  if (tid < 192) {
    const int v = tid >> 6, cc = tid & 63;
    float s = red[(0 * 3 + v) * 64 + cc] + red[(1 * 3 + v) * 64 + cc] + red[(2 * 3 + v) * 64 + cc] + red[(3 * 3 + v) * 64 + cc];
    const int n = nb * 64 + cc;
    reinterpret_cast<float*>(ows(P) + O_MODS)[(l * 3 + v) * 9216 + n] = s + P.in[5][l * 9216 + n];
  }
  __syncthreads();
}

DI void misc_item(const Params& P) {
  const int tid = otid();
  float* rope = reinterpret_cast<float*>(ows(P) + O_ROPE);
  for (int e = tid; e < 256 * 16; e += 256) {
    const int p = e >> 4, j = e & 15;
    const float ang = (float)p * P.inv_freq[j];
    double a = (double)ang;
    const double TWO_PI = 6.283185307179586476925;
    a -= TWO_PI * rint(a / TWO_PI);
    const double q = a * 0.25, q2 = q * q;
    double sn = q * (1.0 + q2 * (-1.0 / 6 + q2 * (1.0 / 120 + q2 * (-1.0 / 5040 + q2 * (1.0 / 362880 + q2 * (-1.0 / 39916800 + q2 * (1.0 / 6227020800.0)))))));
    double cs = 1.0 + q2 * (-0.5 + q2 * (1.0 / 24 + q2 * (-1.0 / 720 + q2 * (1.0 / 40320 + q2 * (-1.0 / 3628800 + q2 * (1.0 / 479001600.0 + q2 * (-1.0 / 87178291200.0)))))));
    double s2 = 2 * sn * cs, c2 = cs * cs - sn * sn;
    double s4 = 2 * s2 * c2, c4 = c2 * c2 - s2 * s2;
    rope[e] = (float)c4;
    rope[256 * 16 + e] = (float)s4;
  }
  if (tid < DEPTH) {
    const float* dl = P.in[10] + tid * 4 * 64;
    float d01 = 0.f, d23 = 0.f;
    for (int i = 0; i < 64; ++i) { d01 += dl[i] * dl[64 + i]; d23 += dl[128 + i] * dl[192 + i]; }
    reinterpret_cast<float*>(ows(P) + O_LAM)[tid] = expf(d01) - expf(d23) + P.linit[tid];
  }
}

#define XB_TMO      128
#define XB_XCNT(j)  (256  + 64 * (j))
#define XB_XSUB(j)  (1280 + 64 * (j))
#define XB_XGEN(j)  (2304 + 64 * (j))
#define XB_TOP      3328
#define XB_TOPGEN   3392
#define XCD_BAR_WORDS 3456
#define XB_SPIN_CAP (1u << 18)
#define LAS __attribute__((address_space(3)))
DI unsigned xb_ld(unsigned* p) { return __hip_atomic_load(p, __ATOMIC_RELAXED, __HIP_MEMORY_SCOPE_AGENT); }
DI unsigned xb_add(unsigned* p, unsigned v) { return __hip_atomic_fetch_add(p, v, __ATOMIC_RELAXED, __HIP_MEMORY_SCOPE_AGENT); }
DI unsigned xb_xcc_id() { return (unsigned)__builtin_amdgcn_s_getreg((3 << 11) | 20) & 0xFu; }
#define XB_SPIN(cond, bar) do { unsigned _sp = 0; while (cond) { __builtin_amdgcn_s_sleep(1); \
    if ((++_sp & 255u) == 0u) { if (xb_ld(&(bar)[XB_TMO])) break; if (_sp > XB_SPIN_CAP) { atomicAdd(&(bar)[XB_TMO], 1u); break; } } } } while (0)
struct XcdBarrier { unsigned* bar; unsigned x; volatile LAS unsigned* st; };
DI XcdBarrier xcd_barrier_post(unsigned* bar, volatile LAS unsigned* st) {
  XcdBarrier b; b.bar = bar; b.x = xb_xcc_id(); b.st = st;
  if (threadIdx.x == 0) (void)xb_add(&bar[XB_XCNT(b.x)], 1u);
  return b;
}
DI void xcd_barrier_complete(unsigned* bar, unsigned x, unsigned& nloc, unsigned& nx) {
  const unsigned G = gridDim.x * gridDim.y * gridDim.z;
  unsigned sum, cnt, mine, sp = 0u;
  for (;;) {
    sum = 0u; cnt = 0u; mine = 0u;
#pragma unroll
    for (unsigned j = 0; j < 16; ++j) { const unsigned c = xb_ld(&bar[XB_XCNT(j)]); sum += c; cnt += (c > 0u) ? 1u : 0u; mine = (j == x) ? c : mine; }
    if (sum == G) break;
    __builtin_amdgcn_s_sleep(1);
    if ((++sp & 255u) == 0u) { if (xb_ld(&bar[XB_TMO])) break; if (sp > XB_SPIN_CAP) { atomicAdd(&bar[XB_TMO], 1u); break; } }
  }
  nloc = mine > 0u ? mine : 1u; nx = cnt > 0u ? cnt : 1u;
}
DI void xcd_barrier(const XcdBarrier& b) {
  asm volatile("s_waitcnt vmcnt(0)" ::: "memory");
  __syncthreads();
  if (threadIdx.x == 0) {
    unsigned* bar = b.bar;
    __builtin_amdgcn_s_waitcnt(0);
    unsigned nloc = b.st[0], nx = b.st[1];
    if (nloc == 0u) { xcd_barrier_complete(bar, b.x, nloc, nx); b.st[0] = nloc; b.st[1] = nx; }
    const unsigned old = xb_add(&bar[XB_XSUB(b.x)], 1u);
    const unsigned gen = old / nloc;
    if (old + 1u == (gen + 1u) * nloc) {
      __builtin_amdgcn_fence(__ATOMIC_RELEASE, "agent");
      asm volatile("s_waitcnt vmcnt(0)" ::: "memory");
      const unsigned og = xb_add(&bar[XB_TOP], 1u);
      const unsigned tg = og / nx;
      if (og + 1u == (tg + 1u) * nx) xb_add(&bar[XB_TOPGEN], 1u);
      else XB_SPIN(xb_ld(&bar[XB_TOPGEN]) == tg, bar);
      __builtin_amdgcn_fence(__ATOMIC_ACQUIRE, "agent");
      xb_add(&bar[XB_XGEN(b.x)], 1u);
      asm volatile("s_waitcnt vmcnt(0)" ::: "memory");
    } else {
      XB_SPIN(xb_ld(&bar[XB_XGEN(b.x)]) == gen, bar);
      __builtin_amdgcn_fence(__ATOMIC_ACQUIRE, "agent");
      asm volatile("s_waitcnt vmcnt(0)" ::: "memory");
    }
  }
  __syncthreads();
}

constexpr size_t LDS_BYTES = 65536 + 64;
constexpr int NPL = 23;
constexpr int NPH = 1 + DEPTH * NPL;

__global__ void __launch_bounds__(256, 2) fwd_megakernel(Params P) {
  extern __shared__ __attribute__((aligned(16))) char lds[];
  cg::grid_group grid = cg::this_grid();
  volatile LAS unsigned* xst = (volatile LAS unsigned*)(lds + 65536);
  if (threadIdx.x == 0) { xst[0] = 0u; xst[1] = 0u; }
  __syncthreads();
  const XcdBarrier xb = xcd_barrier_post(reinterpret_cast<unsigned*>(P.ws + O_BAR), xst);
  char* ws = P.ws;
  u16* U = reinterpret_cast<u16*>(ws + O_U);
  float* tctx = reinterpret_cast<float*>(ws + O_TCTX);
  for (int ph = 0; ph < NPH; ++ph) {
    int kind = 0;
    GemmDesc gd; RowDesc rd;
    gd.skipctx = 0; gd.epi = 0; gd.mtiles = 0; gd.ntiles = 0; gd.K = 0; gd.lda = 0; gd.A = nullptr; gd.W = nullptr; gd.dst = nullptr;
    rd.skipctx = 0; rd.g0 = 0; rd.g1 = 0; rd.told_lat = P.out; rd.told_ctx = tctx; rd.ybuf = nullptr; rd.yrow0 = 0; rd.gscale = 1.f;
    rd.gate_idx = 0; rd.gpost_idx = 0; rd.layer = 0; rd.has_u = 0; rd.ulayer = 0; rd.gpre_idx = 0; rd.shift_idx = 0; rd.scale_idx = 0;
    int layer = 0, conv_layer = -1;
    if (ph == 0) {
      for (int t = blockIdx.x; t < 289; t += gridDim.x) { if (t < 288) mods_item(t, P, lds); else misc_item(P); }
      conv_phase(0, P, lds, 0);
    } else {
      layer = (ph - 1) / NPL;
      const int q = (ph - 1) - layer * NPL;
      const bool first = layer == 0;
      if (q == 0) {
        if (first) { kind = 2; rd.g0 = 0; rd.g1 = MT; rd.told_lat = P.in[0]; rd.told_ctx = P.in[2]; rd.has_u = 1; rd.ulayer = 0; rd.gpre_idx = 0; rd.shift_idx = 0; rd.scale_idx = 1; }
        else kind = -1;
      } else if (q == 1 || q == 20) {
        const int s = q == 1 ? 0 : 1;
        kind = 1; gd.epi = EPI_SWIGLU; gd.mtiles = MT / 128;
        if (s == 1 && layer + 1 == DEPTH) { gd.mtiles = 256; gd.skipctx = 1; } gd.ntiles = 44; gd.K = DM; gd.lda = DM; gd.A = U;
        gd.W = reinterpret_cast<const u16*>(ws + O_WIN + s * SZ_WIN); gd.dst = ws + O_ACT;
      } else if (q == 2 || q == 21) {
        const int s = q == 2 ? 0 : 1;
        kind = 1; gd.epi = EPI_YF32; gd.mtiles = MT / 128;
        if (s == 1 && layer + 1 == DEPTH) { gd.mtiles = 256; gd.skipctx = 1; } gd.ntiles = 8; gd.K = FFN; gd.lda = FFN; gd.A = reinterpret_cast<const u16*>(ws + O_ACT);
        gd.W = reinterpret_cast<const u16*>(ws + O_WOUT + s * SZ_WOUT); gd.dst = ws + O_Y;
      } else if (q == 3) {
        kind = 2; rd.g0 = 0; rd.g1 = MT;
        if (first) { rd.told_lat = P.in[0]; rd.told_ctx = P.in[2]; }
        rd.ybuf = reinterpret_cast<const float*>(ws + O_Y); rd.yrow0 = 0; rd.gscale = 0.5f; rd.gate_idx = 2; rd.gpost_idx = 1; rd.layer = layer;
        rd.has_u = 1; rd.ulayer = layer; rd.gpre_idx = 2; rd.shift_idx = 3; rd.scale_idx = 4;
      } else if (q < 20) {
        const int b = (q - 4) >> 3, qq = (q - 4) & 7;
        const u16* Ub = U + (long)b * MB * DM;
        const int mtq = layer + 1 == DEPTH ? 128 : 130;
        if (qq == 0) { kind = 1; gd.epi = EPI_PROJ; gd.mtiles = 130; gd.ntiles = 42; gd.K = DM; gd.lda = DM; gd.A = Ub; gd.W = reinterpret_cast<const u16*>(ws + O_WMIX); }
        else if (qq == 1) { kind = 3; }
        else if (qq == 2) { kind = 1; gd.epi = EPI_UQKV; gd.mtiles = 130; gd.ntiles = 28; }
        else if (qq == 3) { kind = 4; }
        else if (qq == 4) { kind = 1; gd.epi = EPI_SG; gd.mtiles = mtq; gd.ntiles = 24; gd.K = DM; gd.lda = DM; gd.A = Ub; gd.W = reinterpret_cast<const u16*>(ws + O_WMIX) + (long)NPROJ * DM; gd.dst = ws + O_SG; }
        else if (qq == 5) { kind = 5; gd.epi = EPI_MERGE; gd.mtiles = mtq; gd.ntiles = 8; gd.K = DM; gd.lda = DM; gd.A = reinterpret_cast<const u16*>(ws + O_YA); gd.W = reinterpret_cast<const u16*>(ws + O_WBR); gd.dst = ws + O_MERGED; }
        else if (qq == 6) { kind = 1; gd.epi = EPI_YF32; gd.mtiles = mtq; gd.ntiles = 8; gd.K = DM; gd.lda = DM; gd.A = reinterpret_cast<const u16*>(ws + O_MERGED); gd.W = reinterpret_cast<const u16*>(ws + O_WMO); gd.dst = ws + O_YO; }
        else {
          kind = 2; rd.g0 = b * MB; rd.g1 = (b + 1) * MB; rd.skipctx = layer + 1 == DEPTH; rd.ybuf = reinterpret_cast<const float*>(ws + O_YO); rd.yrow0 = b * MB; rd.gscale = 1.f;
          rd.gate_idx = 5; rd.gpost_idx = 3; rd.layer = layer; rd.has_u = 1; rd.ulayer = layer; rd.gpre_idx = 4; rd.shift_idx = 6; rd.scale_idx = 7;
        }
      } else {
        kind = 2; rd.g0 = 0; rd.g1 = MT; rd.skipctx = layer + 1 == DEPTH; rd.ybuf = reinterpret_cast<const float*>(ws + O_Y); rd.yrow0 = 0; rd.gscale = 0.5f; rd.gate_idx = 8; rd.gpost_idx = 5; rd.layer = layer;
        if (layer + 1 < DEPTH) { rd.has_u = 1; rd.ulayer = layer + 1; rd.gpre_idx = 0; rd.shift_idx = 0; rd.scale_idx = 1; conv_layer = layer + 1; }
      }
    }
    if (kind == 1) gemm_phase<false>(gd, P, lds);
    else if (kind == 5) gemm_phase<true>(gd, P, lds);
    else if (kind == 2) rowop_phase(rd, P);
    else if (kind == 3) r3_phase(layer, P);
    else if (kind == 4) attn_phase(layer, P, lds);
    if (conv_layer >= 0) conv_phase(conv_layer, P, lds, 0);
    if (kind != -1 && ph + 1 < NPH) {
      if (P.pad[0] == 0x7fffffff) grid.sync();
      xcd_barrier(xb);
    }
  }
}

extern "C" void kernel_launch(void* const* d_in, const int* in_sizes, int n_in, void* d_out, int out_size, void* d_ws, size_t ws_size,
                              hipStream_t stream) {
  static int grid_blocks = 0;
  if (!grid_blocks) {
    int dev = 0, cus = 0, per_cu = 0;
    (void)hipGetDevice(&dev);
    (void)hipDeviceGetAttribute(&cus, hipDeviceAttributeMultiprocessorCount, dev);
    (void)hipFuncSetAttribute((const void*)fwd_megakernel, hipFuncAttributeMaxDynamicSharedMemorySize, (int)LDS_BYTES);
    (void)hipOccupancyMaxActiveBlocksPerMultiprocessor(&per_cu, fwd_megakernel, 256, LDS_BYTES);
    if (per_cu > 2) per_cu = 2;
    if (per_cu < 1) per_cu = 1;
    grid_blocks = cus * per_cu;
    fprintf(stderr, "megakernel: cus %d per_cu %d grid %d ws_need %zu ws_size %zu\n", cus, per_cu, grid_blocks, (size_t)WS_NEED, ws_size);
  }
  if (n_in != 19 || ws_size < WS_NEED) {
    fprintf(stderr, "kernel_launch: bad setup n_in %d ws_size %zu need %zu\n", n_in, ws_size, (size_t)WS_NEED);
    return;
  }
  Params p{};
  for (int i = 0; i < 19; ++i) p.in[i] = reinterpret_cast<const float*>(d_in[i]);
  p.out = reinterpret_cast<float*>(d_out);
  p.ws = reinterpret_cast<char*>(d_ws);
  for (int j = 0; j < 16; ++j) p.inv_freq[j] = 1.0f / powf(10000.0f, (float)j / 16.0f);
  for (int l = 0; l < DEPTH; ++l) p.linit[l] = (float)(0.8 - 0.6 * exp(-0.3 * (double)l));
  (void)hipMemsetAsync(reinterpret_cast<char*>(d_ws) + O_BAR, 0, XCD_BAR_WORDS * 4, stream);
  void* args[] = {&p};
  hipError_t e = hipLaunchCooperativeKernel((void*)fwd_megakernel, dim3(grid_blocks), dim3(256), args, LDS_BYTES, stream);
  if (e != hipSuccess) fprintf(stderr, "cooperative launch failed: %s (grid %d)\n", hipGetErrorString(e), grid_blocks);
}
```

```cpp
#include <hip/hip_runtime.h>
#include <hip/hip_cooperative_groups.h>
#include <cstdio>
#include <cstdint>
#include <cmath>
namespace cg = cooperative_groups;

typedef unsigned short u16;
using bf16x8 = __attribute__((ext_vector_type(8))) short;
using f32x16 = __attribute__((ext_vector_type(16))) float;
using u32x4 = __attribute__((ext_vector_type(4))) unsigned;
using u32x2 = __attribute__((ext_vector_type(2))) unsigned;
using f32x4 = __attribute__((ext_vector_type(4))) float;
#define GAS __attribute__((address_space(1)))
#define GP(T, p) (reinterpret_cast<GAS T*>(reinterpret_cast<uintptr_t>(p)))
#define GPC(T, p) (reinterpret_cast<const GAS T*>(reinterpret_cast<uintptr_t>(p)))
typedef __bf16 bf2_t __attribute__((ext_vector_type(2)));
typedef float f2_t __attribute__((ext_vector_type(2)));
#define DI __device__ __forceinline__
#define MFMA(a, b, c) __builtin_amdgcn_mfma_f32_32x32x16_bf16((a), (b), (c), 0, 0, 0)

constexpr int DM = 1024, NB = 2, SEQ = 16384, CTX = 256, DEPTH = 2;
constexpr int MB = SEQ + CTX;
constexpr int MT = NB * MB;
constexpr int FFN = 2816;
constexpr int MIXIN = 8384, NPROJ = 5312;
constexpr float EPS = 1e-6f;
constexpr float LOG2E = 1.4426950408889634f;

constexpr size_t SZ_WIN = (size_t)2 * FFN * DM * 2;
constexpr size_t SZ_WOUT = (size_t)DM * FFN * 2;
constexpr size_t O_WIN = 0;
constexpr size_t O_WOUT = O_WIN + 2 * SZ_WIN;
constexpr size_t O_WMIX = O_WOUT + 2 * SZ_WOUT;
constexpr size_t O_WUQ = O_WMIX + (size_t)MIXIN * DM * 2;
constexpr size_t O_WUKV = O_WUQ + (size_t)1536 * 384 * 2;
constexpr size_t O_WBR = O_WUKV + (size_t)2048 * 256 * 2;
constexpr size_t O_WMO = O_WBR + (size_t)3 * DM * DM * 2;
constexpr size_t O_MODS = O_WMO + (size_t)DM * DM * 2;
constexpr size_t O_ROPE = O_MODS + (size_t)DEPTH * 3 * 9216 * 4;
constexpr size_t O_LAM = O_ROPE + 2 * 256 * 16 * 4;
constexpr size_t O_BAR = O_LAM + 256;
constexpr size_t O_TCTX = O_BAR + 16384;
constexpr size_t O_U = O_TCTX + (size_t)NB * CTX * DM * 4;
constexpr size_t O_RX = O_U + (size_t)MT * DM * 2;
constexpr size_t O_ACT = O_RX;
constexpr size_t O_Y = O_ACT + (size_t)MT * FFN * 2;
constexpr size_t END_FFN = O_Y + (size_t)MT * DM * 4;
constexpr size_t SZ1 = (size_t)MB * DM * 2;
constexpr size_t SZQ = (size_t)MB * 256 * 2;
constexpr size_t O_QA = O_RX;
constexpr size_t O_KA = O_QA + SZ1;
constexpr size_t O_VAT = O_KA + SZ1;
constexpr size_t O_QB = O_VAT + SZ1;
constexpr size_t O_KB = O_QB + SZ1;
constexpr size_t O_VBT = O_KB + SZQ;
constexpr size_t O_CQ = O_VBT + SZQ;
constexpr size_t O_CKV = O_CQ + (size_t)MB * 384 * 2;
constexpr size_t O_KR = O_CKV + SZQ;
constexpr size_t O_QC = O_KR + (size_t)MB * 64 * 2;
constexpr size_t O_KCN = O_QC + (size_t)MB * 1536 * 2;
constexpr size_t O_VCT = O_KCN + SZ1;
constexpr size_t O_YA = O_VCT + SZ1;
constexpr size_t END_MIX = O_YA + 3 * SZ1;
constexpr size_t O_SG = O_QA;
constexpr size_t O_MERGED = O_QB;
constexpr size_t O_YO = O_KCN;
constexpr size_t WS_NEED = END_MIX > END_FFN ? END_MIX : END_FFN;

struct Params {
  const float* in[19];
  float* out;
  char* ws;
  float inv_freq[16];
  float linit[2];
  int pad[2];
};

DI int otid() { int t = threadIdx.x; asm volatile("" : "+v"(t)); return t; }
DI char* ows(const Params& P) {
  const unsigned long long w = reinterpret_cast<unsigned long long>(P.ws);
  unsigned lo = __builtin_amdgcn_readfirstlane((unsigned)w), hi = __builtin_amdgcn_readfirstlane((unsigned)(w >> 32));
  asm volatile("" : "+s"(lo), "+s"(hi));
  return reinterpret_cast<char*>(((unsigned long long)hi << 32) | lo);
}
DI const char* uptr(const void* p) {
  const unsigned long long w = reinterpret_cast<unsigned long long>(p);
  const unsigned lo = __builtin_amdgcn_readfirstlane((unsigned)w), hi = __builtin_amdgcn_readfirstlane((unsigned)(w >> 32));
  return reinterpret_cast<const char*>(((unsigned long long)hi << 32) | lo);
}
DI int crow(int i, int h) { return (i & 3) + 8 * (i >> 2) + 4 * h; }
DI unsigned pk2(float a, float b) { f2_t v = {a, b}; bf2_t r = __builtin_convertvector(v, bf2_t); return __builtin_bit_cast(unsigned, r); }
DI float bflo(unsigned x) { return __uint_as_float(x << 16); }
DI float bfhi(unsigned x) { return __uint_as_float(x & 0xffff0000u); }
DI float wave_sum(float v) {
#pragma unroll
  for (int o = 32; o > 0; o >>= 1) v += __shfl_xor(v, o);
  return v;
}
DI float xhalf_max(float v) {
  auto rr = __builtin_amdgcn_permlane32_swap(__float_as_uint(v), __float_as_uint(v), false, false);
  return fmaxf(__uint_as_float(rr[0]), __uint_as_float(rr[1]));
}
DI float xhalf_sum(float v) {
  auto rr = __builtin_amdgcn_permlane32_swap(__float_as_uint(v), __float_as_uint(v), false, false);
  return __uint_as_float(rr[0]) + __uint_as_float(rr[1]);
}
DI float vmax3(float a, float b, float c) { float r; asm("v_max3_f32 %0, %1, %2, %3" : "=v"(r) : "v"(a), "v"(b), "v"(c)); return r; }
DI float vmax3w(float a, float b, float c, float dep) { float r; asm volatile("s_nop 15\n\tv_max3_f32 %0, %1, %2, %3" : "=v"(r) : "v"(a), "v"(b), "v"(c), "v"(dep)); return r; }
DI float vmax3d4(float a, float b, float c, float d1, float d2, float d3, float d4) { float r; asm("v_max3_f32 %0, %1, %2, %3" : "=v"(r) : "v"(a), "v"(b), "v"(c), "v"(d1), "v"(d2), "v"(d3), "v"(d4)); return r; }
DI float vmax3d(float a, float b, float c, float dep) { float r; asm("v_max3_f32 %0, %1, %2, %3" : "=v"(r) : "v"(a), "v"(b), "v"(c), "v"(dep)); return r; }
DI float sigmoidf_(float x) { return __builtin_amdgcn_rcpf(1.f + __builtin_amdgcn_exp2f(-LOG2E * x)); }
DI void st_bf16_tile(const f32x16& c, u16* dst, int h) {
#pragma unroll
  for (int q = 0; q < 4; ++q) {
    u32x2 v; v.x = pk2(c[4 * q], c[4 * q + 1]); v.y = pk2(c[4 * q + 2], c[4 * q + 3]);
    *GP(u32x2, dst + 8 * q + 4 * h) = v;
  }
}
DI void st_bf16_tile_vt(const f32x16& c, u16* dst, int h) {
#pragma unroll
  for (int q = 0; q < 4; ++q) {
    u32x2 v; v.x = pk2(c[4 * q], c[4 * q + 1]); v.y = pk2(c[4 * q + 2], c[4 * q + 3]);
    *GP(u32x2, dst + 16 * (q >> 1) + 8 * h + 4 * (q & 1)) = v;
  }
}
DI void st_f32_tile(const f32x16& c, float* dst, int h) {
#pragma unroll
  for (int q = 0; q < 4; ++q) {
    f32x4 v = {c[4 * q], c[4 * q + 1], c[4 * q + 2], c[4 * q + 3]};
    *GP(f32x4, dst + 8 * q + 4 * h) = v;
  }
}
DI void rope_tile(f32x16& c, const float* __restrict__ rope, int idx, int h) {
  const float* cp = rope + idx * 16 + 4 * h;
  const float* sp = cp + 256 * 16;
  const f32x4 c0 = *GPC(f32x4, cp), c1 = *GPC(f32x4, cp + 8);
  const f32x4 s0 = *GPC(f32x4, sp), s1 = *GPC(f32x4, sp + 8);
#define ROPE1(i, CS, SN) { const float x1 = c[i], x2 = c[(i) + 8]; c[i] = x1 * (CS) - x2 * (SN); c[(i) + 8] = x2 * (CS) + x1 * (SN); }
  ROPE1(0, c0.x, s0.x) ROPE1(1, c0.y, s0.y) ROPE1(2, c0.z, s0.z) ROPE1(3, c0.w, s0.w)
  ROPE1(4, c1.x, s1.x) ROPE1(5, c1.y, s1.y) ROPE1(6, c1.z, s1.z) ROPE1(7, c1.w, s1.w)
#undef ROPE1
}

template <bool TRANS>
DI void gemm_kloop(const u16* __restrict__ A, int lda, const u16* __restrict__ W, int ldw, int K, f32x16 (&acc)[2][2], char* lds) {
  const int tid = otid(), lane = tid & 63, wid = tid >> 6, r = lane & 31, h = lane >> 5;
  const int wm = wid >> 1, wn = wid & 1;
  const int lrow = tid >> 3, lkc = tid & 7;
  const unsigned voa = (unsigned)(lrow * lda + lkc * 8) * 2u, vob = (unsigned)(lrow * ldw + lkc * 8) * 2u;
  const char* Ab = reinterpret_cast<const char*>(A);
  const char* Wb = reinterpret_cast<const char*>(W);
  const int soff0 = lrow * 128 + ((lkc ^ ((lrow >> 1) & 7)) << 4);
  u32x4 ra0, ra1, ra2, ra3, rb0, rb1, rb2, rb3, rc0, rc1, rc2, rc3, rd0, rd1, rd2, rd3;
#define GLOAD(A0, A1, A2, A3, B0, B1, B2, B3, k0)                                \
  {                                                                              \
    const char* pa_ = Ab + (long)(k0) * 2;                                       \
    const char* pw_ = Wb + (long)(k0) * 2;                                       \
    A0 = *GPC(u32x4, pa_ + voa);                                                 \
    A1 = *GPC(u32x4, pa_ + (long)64 * lda + voa);                                \
    A2 = *GPC(u32x4, pa_ + (long)128 * lda + voa);                               \
    A3 = *GPC(u32x4, pa_ + (long)192 * lda + voa);                               \
    B0 = *GPC(u32x4, pw_ + vob);                                                 \
    B1 = *GPC(u32x4, pw_ + (long)64 * ldw + vob);                                \
    B2 = *GPC(u32x4, pw_ + (long)128 * ldw + vob);                               \
    B3 = *GPC(u32x4, pw_ + (long)192 * ldw + vob);                               \
  }
#define SSTORE(A0, A1, A2, A3, B0, B1, B2, B3, bufi)                             \
  {                                                                              \
    char* sb = lds + (bufi) * 32768 + soff0;                                     \
    *reinterpret_cast<u32x4*>(sb) = A0;                                          \
    *reinterpret_cast<u32x4*>(sb + 4096) = A1;                                   \
    *reinterpret_cast<u32x4*>(sb + 8192) = A2;                                   \
    *reinterpret_cast<u32x4*>(sb + 12288) = A3;                                  \
    *reinterpret_cast<u32x4*>(sb + 16384) = B0;                                  \
    *reinterpret_cast<u32x4*>(sb + 16384 + 4096) = B1;                           \
    *reinterpret_cast<u32x4*>(sb + 16384 + 8192) = B2;                           \
    *reinterpret_cast<u32x4*>(sb + 16384 + 12288) = B3;                          \
  }
#define SET0 ra0, ra1, ra2, ra3, rb0, rb1, rb2, rb3
#define SET1 rc0, rc1, rc2, rc3, rd0, rd1, rd2, rd3
#define GL(...) GLOAD(__VA_ARGS__)
#define SS(...) SSTORE(__VA_ARGS__)
  const int KT = K >> 6;
  const int xr = (r >> 1) & 7;
  const int aoff = (wm * 64 + r) * 128, boff = 16384 + (wn * 64 + r) * 128;
#define COMPUTE(bufi)                                                                                                              \
  {                                                                                                                                \
    const char* buf = lds + (bufi) * 32768;                                                                                        \
    bf16x8 a0n, a1n, b0n, b1n;                                                                                                     \
    {                                                                                                                              \
      const int co = (h ^ xr) << 4;                                                                                                \
      a0n = *reinterpret_cast<const bf16x8*>(buf + aoff + co); a1n = *reinterpret_cast<const bf16x8*>(buf + aoff + 4096 + co);     \
      b0n = *reinterpret_cast<const bf16x8*>(buf + boff + co); b1n = *reinterpret_cast<const bf16x8*>(buf + boff + 4096 + co);     \
    }                                                                                                                              \
    _Pragma("unroll") for (int s = 0; s < 4; ++s) {                                                                                \
      const bf16x8 a0 = a0n, a1 = a1n, b0 = b0n, b1 = b1n;                                                                         \
      if (s < 3) {                                                                                                                 \
        const int co = ((2 * (s + 1) + h) ^ xr) << 4;                                                                              \
        a0n = *reinterpret_cast<const bf16x8*>(buf + aoff + co); a1n = *reinterpret_cast<const bf16x8*>(buf + aoff + 4096 + co);   \
        b0n = *reinterpret_cast<const bf16x8*>(buf + boff + co); b1n = *reinterpret_cast<const bf16x8*>(buf + boff + 4096 + co);   \
      }                                                                                                                            \
      if (TRANS) {                                                                                                                 \
        acc[0][0] = MFMA(a0, b0, acc[0][0]); acc[0][1] = MFMA(a0, b1, acc[0][1]);                                                  \
        acc[1][0] = MFMA(a1, b0, acc[1][0]); acc[1][1] = MFMA(a1, b1, acc[1][1]);                                                  \
      } else {                                                                                                                     \
        acc[0][0] = MFMA(b0, a0, acc[0][0]); acc[0][1] = MFMA(b1, a0, acc[0][1]);                                                  \
        acc[1][0] = MFMA(b0, a1, acc[1][0]); acc[1][1] = MFMA(b1, a1, acc[1][1]);                                                  \
      }                                                                                                                            \
      __builtin_amdgcn_sched_barrier(0);                                                                                           \
    }                                                                                                                              \
  }
  GL(SET0, 0);
  SS(SET0, 0);
  GL(SET1, 64);
  __syncthreads();
  for (int kt = 0; kt < KT; kt += 2) {
    const bool m2 = kt + 2 < KT;
    if (m2) { GL(SET0, (kt + 2) * 64); }
    COMPUTE(0);
    SS(SET1, 1);
    __syncthreads();
    if (m2) { GL(SET1, (kt + 3) * 64); }
    COMPUTE(1);
    if (m2) { SS(SET0, 0); }
    __syncthreads();
  }
#undef GLOAD
#undef SSTORE
#undef SET0
#undef SET1
#undef GL
#undef SS
#undef COMPUTE
}

enum { EPI_SWIGLU = 0, EPI_YF32 = 1, EPI_PROJ = 2, EPI_UQKV = 3, EPI_SG = 4, EPI_MERGE = 5 };
struct GemmDesc {
  int epi, mtiles, ntiles, K, lda, skipctx;
  const u16* A; const u16* W;
  void* dst;
};

template <bool MERGE>
DI void gemm_phase(const GemmDesc& d, const Params& P, char* lds) {
  const int tid = otid(), lane = tid & 63, wid = tid >> 6, r = lane & 31, h = lane >> 5;
  const int wm = wid >> 1, wn = wid & 1;
  char* ws = ows(P);
  const float* rope = reinterpret_cast<const float*>(ws + O_ROPE);
  const int ntl = d.mtiles * d.ntiles;
  for (int t = blockIdx.x; t < ntl; t += gridDim.x) {
    int mt = t / d.ntiles;
    int nt = t - mt * d.ntiles;
    if (d.ntiles == 8) {
      const int m4 = d.mtiles & ~3;
      if (t < 8 * m4) {
        const int x = t & 7, k = t >> 3;
        nt = 4 * (x & 1) + (k & 3);
        mt = 4 * (k >> 2) + (x >> 1);
      }
    }
    if (d.skipctx && mt >= 128) mt += 2;
    const u16* A = d.A; const u16* W = d.W; int lda = d.lda, K = d.K;
    bool trans = false;
    int uq = 0;
    if (d.epi == EPI_PROJ) {
      const int n0 = nt * 128;
      trans = (n0 >= 2048 && n0 < 3072) || (n0 >= 4352 && n0 < 4608);
    } else if (d.epi == EPI_UQKV) {
      if (nt < 12) { uq = 1; A = reinterpret_cast<const u16*>(ws + O_CQ); lda = 384; K = 384; W = reinterpret_cast<const u16*>(ws + O_WUQ); }
      else { nt -= 12; A = reinterpret_cast<const u16*>(ws + O_CKV); lda = 256; K = 256; W = reinterpret_cast<const u16*>(ws + O_WUKV); trans = (nt & 1); }
    }
    const int n0 = nt * 128;
    constexpr int nrep = MERGE ? 3 : 1;
    f32x16 acc[2][2];
#pragma unroll 1
    for (int rep = 0; rep < nrep; ++rep) {
#pragma unroll
      for (int a = 0; a < 2; ++a)
#pragma unroll
        for (int b = 0; b < 2; ++b)
#pragma unroll
          for (int i = 0; i < 16; ++i) acc[a][b][i] = 0.f;
      const u16* Ar = A + (long)rep * ((long)MB * DM) + (long)(mt * 128) * lda;
      const u16* Wr = W + (long)rep * ((long)DM * DM) + (long)n0 * K;
      if (trans) gemm_kloop<true>(Ar, lda, Wr, K, K, acc, lds);
      else gemm_kloop<false>(Ar, lda, Wr, K, K, acc, lds);
      if constexpr (MERGE) {
        const u16* sg = reinterpret_cast<const u16*>(ws + O_SG);
        float* macc = reinterpret_cast<float*>(ws + O_YO);
        u16* mo = reinterpret_cast<u16*>(d.dst);
#pragma unroll
        for (int mi = 0; mi < 2; ++mi)
#pragma unroll
          for (int ni = 0; ni < 2; ++ni) {
            const long row = mt * 128 + wm * 64 + mi * 32 + r;
            const int col = n0 + wn * 64 + ni * 32 + 4 * h;
            const u16* gp = sg + row * 3072 + rep * 1024 + col;
            float* mp = macc + row * DM + col;
#pragma unroll
            for (int q = 0; q < 4; ++q) {
              const u32x2 g = *GPC(u32x2, gp + 8 * q);
              f32x4 v = {0.f, 0.f, 0.f, 0.f};
              if (rep > 0) v = *GPC(f32x4, mp + 8 * q);
              v.x += bflo(g.x) * acc[mi][ni][4 * q + 0]; v.y += bfhi(g.x) * acc[mi][ni][4 * q + 1];
              v.z += bflo(g.y) * acc[mi][ni][4 * q + 2]; v.w += bfhi(g.y) * acc[mi][ni][4 * q + 3];
              if (rep < 2) *GP(f32x4, mp + 8 * q) = v;
              else { u32x2 o = {pk2(v.x, v.y), pk2(v.z, v.w)}; *GP(u32x2, mo + row * DM + col + 8 * q) = o; }
            }
          }
      }
    }
    const int cb = n0 + wn * 64;
    const int rowb = mt * 128 + wm * 64;
    if constexpr (MERGE) {
    } else if (d.epi == EPI_SWIGLU) {
      u16* act = reinterpret_cast<u16*>(d.dst);
      const int acol = (n0 >> 1) + wn * 32;
#pragma unroll
      for (int mi = 0; mi < 2; ++mi) {
        f32x16 o;
#pragma unroll
        for (int i = 0; i < 16; ++i) { float a = acc[mi][0][i], b = acc[mi][1][i]; o[i] = a * sigmoidf_(a) * b; }
        st_bf16_tile(o, act + (long)(rowb + mi * 32 + r) * FFN + acol, h);
      }
    } else if (d.epi == EPI_YF32) {
      float* y = reinterpret_cast<float*>(d.dst);
#pragma unroll
      for (int mi = 0; mi < 2; ++mi)
#pragma unroll
        for (int ni = 0; ni < 2; ++ni) st_f32_tile(acc[mi][ni], y + (long)(rowb + mi * 32 + r) * DM + cb + ni * 32, h);
    } else if (d.epi == EPI_SG) {
      u16* sg = reinterpret_cast<u16*>(d.dst);
#pragma unroll
      for (int mi = 0; mi < 2; ++mi)
#pragma unroll
        for (int ni = 0; ni < 2; ++ni) {
          f32x16 o;
#pragma unroll
          for (int i = 0; i < 16; ++i) o[i] = sigmoidf_(acc[mi][ni][i]);
          st_bf16_tile(o, sg + (long)(rowb + mi * 32 + r) * 3072 + cb + ni * 32, h);
        }
    } else if (trans) {
      u16* vt; int f0;
      if (d.epi == EPI_PROJ) {
        if (cb < 3072) { vt = reinterpret_cast<u16*>(ws + O_VAT); f0 = cb - 2048; }
        else { vt = reinterpret_cast<u16*>(ws + O_VBT); f0 = cb - 4352; }
      } else { vt = reinterpret_cast<u16*>(ws + O_VCT); f0 = (nt >> 1) * 128 + wn * 64; }
#pragma unroll
      for (int mi = 0; mi < 2; ++mi)
#pragma unroll
        for (int ni = 0; ni < 2; ++ni) st_bf16_tile_vt(acc[mi][ni], vt + (long)(f0 + ni * 32 + r) * MB + rowb + mi * 32, h);
    } else {
      u16* dst = nullptr; int ld = 0, cofs = 0; bool rp = false;
      if (d.epi == EPI_PROJ) {
        if (cb < 1024) { dst = reinterpret_cast<u16*>(ws + O_QA); ld = 1024; cofs = cb; rp = true; }
        else if (cb < 2048) { dst = reinterpret_cast<u16*>(ws + O_KA); ld = 1024; cofs = cb - 1024; rp = true; }
        else if (cb < 4096) { dst = reinterpret_cast<u16*>(ws + O_QB); ld = 1024; cofs = cb - 3072; rp = true; }
        else if (cb < 4352) { dst = reinterpret_cast<u16*>(ws + O_KB); ld = 256; cofs = cb - 4096; rp = true; }
        else if (cb < 4992) { dst = reinterpret_cast<u16*>(ws + O_CQ); ld = 384; cofs = cb - 4608; }
        else if (cb < 5248) { dst = reinterpret_cast<u16*>(ws + O_CKV); ld = 256; cofs = cb - 4992; }
        else if (cb < 5312) { dst = reinterpret_cast<u16*>(ws + O_KR); ld = 64; cofs = 0; rp = true; }
      } else {
        if (uq) { dst = reinterpret_cast<u16*>(ws + O_QC); ld = 1536; cofs = cb; rp = (cb % 192) == 128; }
        else { dst = reinterpret_cast<u16*>(ws + O_KCN); ld = 1024; cofs = (nt >> 1) * 128 + wn * 64; }
      }
      if (dst != nullptr) {
        const bool latent = mt < 128;
#pragma unroll
        for (int mi = 0; mi < 2; ++mi) {
          const int lr = rowb + mi * 32 + r;
#pragma unroll
          for (int ni = 0; ni < 2; ++ni) {
            f32x16 o = acc[mi][ni];
            if (rp && latent) rope_tile(o, rope, ni == 0 ? (lr >> 6) : (lr & 63), h);
            st_bf16_tile(o, dst + (long)lr * ld + cofs + ni * 32, h);
          }
        }
      }
    }
  }
}

struct RowDesc {
  int g0, g1, skipctx;
  const float* told_lat; const float* told_ctx;
  const float* ybuf; int yrow0;
  float gscale; int gate_idx, gpost_idx, layer;
  int has_u, ulayer, gpre_idx, shift_idx, scale_idx;
};

DI void rowop_phase(const RowDesc& d, const Params& P) {
  const int tid_ = otid(); const int lane = tid_ & 63, wid = tid_ >> 6;
  char* ws = ows(P);
  const float* mods = reinterpret_cast<const float*>(ws + O_MODS);
  const float* normg = P.in[6];
  float* tctx = reinterpret_cast<float*>(ws + O_TCTX);
  u16* U = reinterpret_cast<u16*>(ws + O_U);
  const int stride = gridDim.x * 4;
  const bool has_y = d.ybuf != nullptr;
  f32x4 tn[4], yn[4];
  bool vn = false;
#define LOADROW(g_)                                                                                              \
  {                                                                                                              \
    const int b_ = (g_) / MB, i_ = (g_) - b_ * MB;                                                               \
    const bool lat_ = i_ < SEQ;                                                                                  \
    vn = !(d.skipctx && !lat_);                                                                                  \
    if (vn) {                                                                                                    \
      const long toff_ = lat_ ? ((long)(b_ * SEQ + i_)) * DM : ((long)(b_ * CTX + i_ - SEQ)) * DM;               \
      const float* told_ = (lat_ ? d.told_lat : d.told_ctx) + toff_;                                             \
      _Pragma("unroll") for (int j = 0; j < 4; ++j) tn[j] = *GPC(f32x4, told_ + lane * 4 + 256 * j);             \
      if (has_y) {                                                                                               \
        const float* y_ = d.ybuf + (long)((g_) - d.yrow0) * DM;                                                  \
        _Pragma("unroll") for (int j = 0; j < 4; ++j) yn[j] = *GPC(f32x4, y_ + lane * 4 + 256 * j);              \
      }                                                                                                          \
    }                                                                                                            \
  }
  int gnext = d.g0 + blockIdx.x * 4 + wid;
  if (gnext < d.g1) { LOADROW(gnext) }
  while (gnext < d.g1) {
    const int g = gnext;
    const bool v = vn;
    f32x4 t[4], yv[4];
#pragma unroll
    for (int j = 0; j < 4; ++j) { t[j] = tn[j]; yv[j] = yn[j]; }
    gnext += stride;
    if (gnext < d.g1) { LOADROW(gnext) }
    if (!v) continue;
    const int b = g / MB, i = g - b * MB;
    const bool lat = i < SEQ;
    const int midx = lat ? b : 2;
    const long toff = lat ? ((long)(b * SEQ + i)) * DM : ((long)(b * CTX + i - SEQ)) * DM;
    if (has_y) {
      float ss = 0.f;
#pragma unroll
      for (int j = 0; j < 4; ++j) ss += yv[j].x * yv[j].x + yv[j].y * yv[j].y + yv[j].z * yv[j].z + yv[j].w * yv[j].w;
      ss = wave_sum(ss);
      const float rr = rsqrtf(ss * (1.f / DM) + EPS) * d.gscale;
      const float* gate = mods + (d.layer * 3 + midx) * 9216 + d.gate_idx * DM;
      const float* gp = normg + (d.layer * 6 + d.gpost_idx) * DM;
      float* tnew = (lat ? P.out : tctx) + toff;
#pragma unroll
      for (int j = 0; j < 4; ++j) {
        f32x4 ga = *GPC(f32x4, gate + lane * 4 + 256 * j);
        f32x4 gg = *GPC(f32x4, gp + lane * 4 + 256 * j);
        t[j].x += ga.x * (yv[j].x * rr * gg.x); t[j].y += ga.y * (yv[j].y * rr * gg.y);
        t[j].z += ga.z * (yv[j].z * rr * gg.z); t[j].w += ga.w * (yv[j].w * rr * gg.w);
        *GP(f32x4, tnew + lane * 4 + 256 * j) = t[j];
      }
    }
    if (d.has_u) {
      float ss = 0.f;
#pragma unroll
      for (int j = 0; j < 4; ++j) ss += t[j].x * t[j].x + t[j].y * t[j].y + t[j].z * t[j].z + t[j].w * t[j].w;
      ss = wave_sum(ss);
      const float rr = rsqrtf(ss * (1.f / DM) + EPS);
      const float* mu = mods + (d.ulayer * 3 + midx) * 9216;
      const float* sh = mu + d.shift_idx * DM; const float* sc = mu + d.scale_idx * DM;
      const float* gp = normg + (d.ulayer * 6 + d.gpre_idx) * DM;
      u16* u = U + (long)g * DM;
#pragma unroll
      for (int j = 0; j < 4; ++j) {
        f32x4 gg = *GPC(f32x4, gp + lane * 4 + 256 * j);
        f32x4 s1 = *GPC(f32x4, sc + lane * 4 + 256 * j);
        f32x4 s0 = *GPC(f32x4, sh + lane * 4 + 256 * j);
        float a = (t[j].x * rr * gg.x) * (1.f + s1.x) + s0.x, bb = (t[j].y * rr * gg.y) * (1.f + s1.y) + s0.y;
        float c = (t[j].z * rr * gg.z) * (1.f + s1.z) + s0.z, dd = (t[j].w * rr * gg.w) * (1.f + s1.w) + s0.w;
        u32x2 v2; v2.x = pk2(a, bb); v2.y = pk2(c, dd);
        *GP(u32x2, u + lane * 4 + 256 * j) = v2;
      }
    }
  }
#undef LOADROW
}

DI void r3_phase(int layer, const Params& P) {
  const int tid_ = otid(); const int lane = tid_ & 63, wid = tid_ >> 6;
  char* ws = ows(P);
  u16* cq = reinterpret_cast<u16*>(ws + O_CQ);
  u16* ckv = reinterpret_cast<u16*>(ws + O_CKV);
  const float* gq = P.in[13] + layer * 384;
  const float* gkv = P.in[14] + layer * 256;
  for (int row = blockIdx.x * 4 + wid; row < MB; row += gridDim.x * 4) {
    {
      u16* p = cq + (long)row * 384;
      float v[6]; float ss = 0.f;
#pragma unroll
      for (int j = 0; j < 3; ++j) {
        unsigned x = *GPC(unsigned, p + lane * 2 + 128 * j);
        v[2 * j] = bflo(x); v[2 * j + 1] = bfhi(x); ss += v[2 * j] * v[2 * j] + v[2 * j + 1] * v[2 * j + 1];
      }
      ss = wave_sum(ss);
      const float rr = rsqrtf(ss * (1.f / 384.f) + EPS);
#pragma unroll
      for (int j = 0; j < 3; ++j) {
        const int c = lane * 2 + 128 * j;
        *GP(unsigned, p + c) = pk2(v[2 * j] * rr * gq[c], v[2 * j + 1] * rr * gq[c + 1]);
      }
    }
    {
      u16* p = ckv + (long)row * 256;
      u32x2 x = *GPC(u32x2, p + lane * 4);
      float v0 = bflo(x.x), v1 = bfhi(x.x), v2 = bflo(x.y), v3 = bfhi(x.y);
      float ss = wave_sum(v0 * v0 + v1 * v1 + v2 * v2 + v3 * v3);
      const float rr = rsqrtf(ss * (1.f / 256.f) + EPS);
      const int c = lane * 4;
      u32x2 o; o.x = pk2(v0 * rr * gkv[c], v1 * rr * gkv[c + 1]); o.y = pk2(v2 * rr * gkv[c + 2], v3 * rr * gkv[c + 3]);
      *GP(u32x2, p + c) = o;
    }
  }
}

template <int DQK, int DV, int TYPE>
DI void attn_item(int layer, int qt, int head, char* lds, const Params& P) {
  const int tid = otid(), lane = tid & 63, wid = tid >> 6, r = lane & 31, h = lane >> 5;
  char* ws = ows(P);
  constexpr int NS = DQK / 16, NDV = DV / 32;
  constexpr bool DB = DQK == 64;
  constexpr int KBYTES = 64 * DQK * 2;
  constexpr int STAGE = DB ? 24576 : 0;
  constexpr int VOFF = DB ? 8192 : 24576;
  constexpr float SCALE = TYPE == 1 ? 0.07216878364870322f : 0.125f;
  constexpr float C = SCALE * LOG2E;
  const bool latent = qt < 128;
  int ta0, na, NT;
  if (!latent) { ta0 = 256; na = 4; NT = 4; }
  else if (TYPE == 2) { int lo = qt * 2 - 2; if (lo < 0) lo = 0; int hi = qt * 2 + 4; if (hi > 256) hi = 256; ta0 = lo; na = hi - lo; NT = na + 4; }
  else { ta0 = 0; na = 260; NT = 260; }
  const int qrow = qt * 128 + wid * 32 + r;
  const u16* Kp; int ldk; const u16* Vp;
  if (TYPE == 0) { Kp = reinterpret_cast<const u16*>(ws + O_KA) + head * 128; ldk = 1024; Vp = reinterpret_cast<const u16*>(ws + O_VAT) + (long)(head * 128) * MB; }
  else if (TYPE == 1) { Kp = reinterpret_cast<const u16*>(ws + O_KCN) + head * 128; ldk = 1024; Vp = reinterpret_cast<const u16*>(ws + O_VCT) + (long)(head * 128) * MB; }
  else { Kp = reinterpret_cast<const u16*>(ws + O_KB) + (head >> 2) * 64; ldk = 256; Vp = reinterpret_cast<const u16*>(ws + O_VBT) + (long)((head >> 2) * 64) * MB; }
  const u16* K2 = reinterpret_cast<const u16*>(ws + O_KR);
  const int kr_a = (DQK == 64) ? (tid >> 3) : (tid >> 4), kc_a = (DQK == 64) ? (tid & 7) : (tid & 15);
  const int kgo_a = kr_a * ldk + kc_a * 8;
  const int kso_a = kr_a * (DQK * 2) + ((kc_a ^ ((kr_a >> 1) & 7)) << 4);
  const int kr_b = tid >> 3, kc_b = 16 + (tid & 7);
  const int kgo_b = kr_b * 64 + (tid & 7) * 8;
  const int kso_b = kr_b * (DQK * 2) + ((kc_b ^ ((kr_b >> 1) & 7)) << 4);
  const int vdv = tid >> 3, vkc = tid & 7, vxs = (vdv >> 1) & 7;
  const unsigned vvo = (unsigned)(vdv * MB + vkc * 8) * 2u;
  const unsigned kvo_a = (unsigned)kgo_a * 2u, kvo_b = (unsigned)kgo_b * 2u;
  const int vso = VOFF + vdv * 128 + ((vkc ^ vxs) << 4);
  u32x4 kreg0, kreg1, kreg2, kreg3, kreg4, kreg5, vreg0, vreg1, vreg2, vreg3;
  const int xr = (r >> 1) & 7;
  constexpr int NMAPS = TYPE == 0 ? 2 : 1;
  u16* ya_dst = reinterpret_cast<u16*>(ws + O_YA) + (long)qrow * 1024 + head * 128;
  for (int map = 0; map < NMAPS; ++map) {
    const u16* Kb = Kp + map * 64;
    const u16* Qp;
    if (TYPE == 0) Qp = reinterpret_cast<const u16*>(ws + O_QA) + (long)qrow * 1024 + head * 128 + map * 64;
    else if (TYPE == 1) Qp = reinterpret_cast<const u16*>(ws + O_QC) + (long)qrow * 1536 + head * 192;
    else Qp = reinterpret_cast<const u16*>(ws + O_QB) + (long)qrow * 1024 + head * 64;
    constexpr int NQR = NS > 6 ? 6 : NS;
    bf16x8 qf[NQR];
#pragma unroll
    for (int s = 0; s < NQR; ++s) qf[s] = *GPC(bf16x8, Qp + 16 * s + 8 * h);
    char* qpark = lds + 40960 + tid * 16;
#pragma unroll
    for (int s = NQR; s < NS; ++s) *reinterpret_cast<bf16x8*>(qpark + (s - NQR) * 4096) = *GPC(bf16x8, Qp + 16 * s + 8 * h);
    float m_run, l_run;
    if (TYPE == 2) { m_run = P.in[12][layer * 16 + head] * (1.f / SCALE); l_run = 1.f; }
    else { m_run = -1e30f; l_run = 0.f; }
    f32x16 oacc[NDV];
#pragma unroll
    for (int d = 0; d < NDV; ++d)
#pragma unroll
      for (int i = 0; i < 16; ++i) oacc[d][i] = 0.f;
#define TILE_OF(j) ((j) < na ? ta0 + (j) : 256 + ((j) - na))
#define LDG(p) (*GPC(u32x4, p))
#define ATT_GLOAD(tile)                                                                                          \
  {                                                                                                              \
    const long key0 = (long)(tile) * 64;                                                                         \
    const char* kp_ = uptr(Kb + key0 * ldk);                                                    \
    if constexpr (DQK == 64) {                                                                                   \
      kreg0 = LDG(kp_ + kvo_a); kreg1 = LDG(kp_ + (long)64 * ldk + kvo_a);                                       \
    } else {                                                                                                     \
      kreg0 = LDG(kp_ + kvo_a); kreg1 = LDG(kp_ + (long)32 * ldk + kvo_a);                                       \
      kreg2 = LDG(kp_ + (long)64 * ldk + kvo_a); kreg3 = LDG(kp_ + (long)96 * ldk + kvo_a);                      \
      const char* k2_ = uptr(K2 + key0 * 64);                                           \
      kreg4 = LDG(k2_ + kvo_b); kreg5 = LDG(k2_ + 32 * 64 * 2 + kvo_b);                                          \
    }                                                                                                            \
    const char* vp_ = uptr(Vp + key0);                                                  \
    vreg0 = LDG(vp_ + vvo); vreg1 = LDG(vp_ + (long)64 * MB + vvo);                                              \
    if constexpr (DV == 128) { vreg2 = LDG(vp_ + (long)128 * MB + vvo); vreg3 = LDG(vp_ + (long)192 * MB + vvo); } \
  }
#define STV(sb, j, v) { *reinterpret_cast<u32x4*>((sb) + vso + (j) * 4096) = v; }
#define ATT_SSTORE(sb)                                                                                           \
  {                                                                                                              \
    if constexpr (DQK == 64) {                                                                                   \
      *reinterpret_cast<u32x4*>((sb) + kso_a) = kreg0; *reinterpret_cast<u32x4*>((sb) + kso_a + 4096) = kreg1;   \
    } else {                                                                                                     \
      *reinterpret_cast<u32x4*>((sb) + kso_a) = kreg0; *reinterpret_cast<u32x4*>((sb) + kso_a + 16 * 384) = kreg1; \
      *reinterpret_cast<u32x4*>((sb) + kso_a + 32 * 384) = kreg2; *reinterpret_cast<u32x4*>((sb) + kso_a + 48 * 384) = kreg3; \
      *reinterpret_cast<u32x4*>((sb) + kso_b) = kreg4; *reinterpret_cast<u32x4*>((sb) + kso_b + 32 * 384) = kreg5; \
    }                                                                                                            \
    STV(sb, 0, vreg0) STV(sb, 1, vreg1)                                                                          \
    if constexpr (DV == 128) { STV(sb, 2, vreg2) STV(sb, 3, vreg3) }                                             \
  }
    ATT_GLOAD(TILE_OF(0));
    ATT_SSTORE(lds);
    if constexpr (DB) { if (1 < NT) { ATT_GLOAD(TILE_OF(1)); } }
    __syncthreads();
    for (int j = 0; j < NT; ++j) {
      const int tile = TILE_OF(j);
      const char* sb = lds + (DB ? (j & 1) * STAGE : 0);
      constexpr int KD = 2, KRING = 3;
      bf16x8 kr0[KRING], kr1[KRING];
#define KFR(s_, slot_)                                                                          \
  {                                                                                             \
    const int co = ((2 * (s_) + h) ^ xr) << 4;                                                  \
    kr0[slot_] = *reinterpret_cast<const bf16x8*>(sb + r * (DQK * 2) + co);                     \
    kr1[slot_] = *reinterpret_cast<const bf16x8*>(sb + (32 + r) * (DQK * 2) + co);              \
  }
#pragma unroll
      for (int s = 0; s < KD; ++s) KFR(s, s)
      __builtin_amdgcn_sched_barrier(0);
      if constexpr (DB) {
        char* sn = lds + ((j + 1) & 1) * STAGE;
        if (j + 1 < NT) { ATT_SSTORE(sn); }
        if (j + 2 < NT) { ATT_GLOAD(TILE_OF(j + 2)); }
      } else {
        if (j + 1 < NT) { ATT_GLOAD(TILE_OF(j + 1)); }
      }
      f32x16 s0, s1;
#pragma unroll
      for (int i = 0; i < 16; ++i) { s0[i] = 0.f; s1[i] = 0.f; }
      {
#pragma unroll
        for (int s = 0; s < NS; ++s) {
          if (s + KD < NS) KFR(s + KD, (s + KD) % KRING)
          bf16x8 qs;
          if constexpr (NS > NQR) { if (s < NQR) qs = qf[s < NQR ? s : 0]; else qs = *reinterpret_cast<const bf16x8*>(qpark + (s - NQR) * 4096); }
          else qs = qf[s];
          s0 = MFMA(kr0[s % KRING], qs, s0);
          s1 = MFMA(kr1[s % KRING], qs, s1);
          __builtin_amdgcn_sched_barrier(0);
        }
#undef KFR
      }
      const char* vb0 = sb + VOFF + r * 128;
#define VFRAG(d, B) (*reinterpret_cast<const bf16x8*>(vb0 + (d) * 4096 + (((2 * (B) + h) ^ xr) << 4)))
      constexpr int VD = 3;
      bf16x8 vr[8];
#pragma unroll
      for (int g = 0; g < VD; ++g) vr[g] = VFRAG(g >> 2, g & 3);
      if (TYPE == 2 && latent && j < na) {
        const int kb0 = tile * 64 - qrow;
#pragma unroll
        for (int i = 0; i < 16; ++i) {
          const int d0 = kb0 + crow(i, h), d1 = d0 + 32;
          if (d0 > 128 || d0 < -128) s0[i] = -1e30f;
          if (d1 > 128 || d1 < -128) s1[i] = -1e30f;
        }
      }
      const float tm0 = vmax3w(s0[0], s0[1], s0[2], s1[0]);
      const float tm1 = vmax3d(s0[3], s0[4], s0[5], tm0), tm2 = vmax3d(s0[6], s0[7], s0[8], tm0), tm3 = vmax3d(s0[9], s0[10], s0[11], tm0);
      const float tm4 = vmax3d(s0[12], s0[13], s0[14], tm0);
      const float tm5 = vmax3d4(s1[0], s1[1], s1[2], tm1, tm2, tm3, tm4), tm6 = vmax3d(s1[3], s1[4], s1[5], tm5), tm7 = vmax3d(s1[6], s1[7], s1[8], tm5);
      const float tm8 = vmax3d(s1[9], s1[10], s1[11], tm5), tm9 = vmax3d(s1[12], s1[13], s1[14], tm5), tma = vmax3d(s0[15], s1[15], tm0, tm5), tmb = vmax3(tm1, tm2, tm3);
      const float tmc = vmax3(tm4, tm5, tm6), tmd = vmax3(tm7, tm8, tm9);
      float tmax = xhalf_max(vmax3(vmax3(tma, tmb, tmc), tmd, tmd));
      const float mnew = fmaxf(m_run, tmax);
      const float alpha = __builtin_amdgcn_exp2f((m_run - mnew) * C);
      m_run = mnew;
      const float mc = -mnew * C;
      float pa = 0.f, pb = 0.f, pc = 0.f, pd = 0.f;
#pragma unroll
      for (int i = 0; i < 16; i += 2) {
        s0[i] = __builtin_amdgcn_exp2f(fmaf(s0[i], C, mc)); pa += s0[i];
        s0[i + 1] = __builtin_amdgcn_exp2f(fmaf(s0[i + 1], C, mc)); pb += s0[i + 1];
      }
#pragma unroll
      for (int i = 0; i < 16; i += 2) {
        s1[i] = __builtin_amdgcn_exp2f(fmaf(s1[i], C, mc)); pc += s1[i];
        s1[i + 1] = __builtin_amdgcn_exp2f(fmaf(s1[i + 1], C, mc)); pd += s1[i + 1];
      }
      const float ps = xhalf_sum((pa + pb) + (pc + pd));
      l_run = l_run * alpha + ps;
      if (__any(alpha != 1.f)) {
#pragma unroll
        for (int d = 0; d < NDV; ++d)
#pragma unroll
          for (int i = 0; i < 16; ++i) oacc[d][i] *= alpha;
      }
      bf16x8 pf[4];
#pragma unroll
      for (int sp = 0; sp < 2; ++sp) {
        u32x4 w0, w1;
        w0.x = pk2(s0[8 * sp + 0], s0[8 * sp + 1]); w0.y = pk2(s0[8 * sp + 2], s0[8 * sp + 3]);
        w0.z = pk2(s0[8 * sp + 4], s0[8 * sp + 5]); w0.w = pk2(s0[8 * sp + 6], s0[8 * sp + 7]);
        w1.x = pk2(s1[8 * sp + 0], s1[8 * sp + 1]); w1.y = pk2(s1[8 * sp + 2], s1[8 * sp + 3]);
        w1.z = pk2(s1[8 * sp + 4], s1[8 * sp + 5]); w1.w = pk2(s1[8 * sp + 6], s1[8 * sp + 7]);
        pf[sp] = __builtin_bit_cast(bf16x8, w0);
        pf[2 + sp] = __builtin_bit_cast(bf16x8, w1);
      }
      {
#pragma unroll
        for (int f = 0; f < NDV * 4; ++f) {
          if (f + VD < NDV * 4) vr[(f + VD) & 7] = VFRAG((f + VD) >> 2, (f + VD) & 3);
          oacc[f >> 2] = MFMA(vr[f & 7], pf[f & 3], oacc[f >> 2]);
          __builtin_amdgcn_sched_barrier(0);
        }
#undef VFRAG
      }
      __syncthreads();
      if constexpr (!DB) {
        if (j + 1 < NT) { ATT_SSTORE(lds); }
        __syncthreads();
      }
    }
#undef ATT_GLOAD
#undef ATT_SSTORE
#undef STV
#undef LDG
#undef TILE_OF
    const float il = 1.f / l_run;
    if (TYPE == 0 && map == 0) {
#pragma unroll
      for (int d = 0; d < NDV; ++d) {
        f32x16 o;
#pragma unroll
        for (int i = 0; i < 16; ++i) o[i] = oacc[d][i] * il;
        st_bf16_tile(o, ya_dst + d * 32, h);
      }
    } else if (TYPE == 0) {
      const float lam = reinterpret_cast<const float*>(ws + O_LAM)[layer];
      float ss = 0.f;
#pragma unroll
      for (int d = 0; d < NDV; ++d) {
#pragma unroll
        for (int q = 0; q < 4; ++q) {
          const u32x2 w = *GPC(u32x2, ya_dst + d * 32 + 8 * q + 4 * h);
          const float v0 = bflo(w.x) - lam * (oacc[d][4 * q + 0] * il), v1 = bfhi(w.x) - lam * (oacc[d][4 * q + 1] * il);
          const float v2 = bflo(w.y) - lam * (oacc[d][4 * q + 2] * il), v3 = bfhi(w.y) - lam * (oacc[d][4 * q + 3] * il);
          oacc[d][4 * q + 0] = v0; oacc[d][4 * q + 1] = v1; oacc[d][4 * q + 2] = v2; oacc[d][4 * q + 3] = v3;
          ss += v0 * v0 + v1 * v1 + v2 * v2 + v3 * v3;
        }
      }
      ss = xhalf_sum(ss);
      const float rr = rsqrtf(ss * (1.f / 128.f) + EPS) * (1.f - P.linit[layer]);
      const float* sg = P.in[11] + layer * 128;
#pragma unroll
      for (int d = 0; d < NDV; ++d) {
        f32x16 o;
#pragma unroll
        for (int q = 0; q < 4; ++q) {
          const f32x4 g4 = *GPC(f32x4, sg + d * 32 + 8 * q + 4 * h);
          o[4 * q] = oacc[d][4 * q] * rr * g4.x; o[4 * q + 1] = oacc[d][4 * q + 1] * rr * g4.y;
          o[4 * q + 2] = oacc[d][4 * q + 2] * rr * g4.z; o[4 * q + 3] = oacc[d][4 * q + 3] * rr * g4.w;
        }
        st_bf16_tile(o, ya_dst + d * 32, h);
      }
    } else {
      u16* dst = TYPE == 1 ? reinterpret_cast<u16*>(ws + O_YA + 2 * SZ1) + (long)qrow * 1024 + head * 128
                           : reinterpret_cast<u16*>(ws + O_YA + SZ1) + (long)qrow * 1024 + head * 64;
#pragma unroll
      for (int d = 0; d < NDV; ++d) {
        f32x16 o;
#pragma unroll
        for (int i = 0; i < 16; ++i) o[i] = oacc[d][i] * il;
        st_bf16_tile(o, dst + d * 32, h);
      }
    }
  }
  __syncthreads();
}

DI void attn_phase(int layer, const Params& P, char* lds) {
  const int NITEMS = layer + 1 < DEPTH ? 4096 + 64 : 4096;
  for (int w = blockIdx.x; w < NITEMS; w += gridDim.x) {
    if (w < 1024) attn_item<64, 128, 0>(layer, w >> 3, w & 7, lds, P);
    else if (w < 2048) attn_item<192, 128, 1>(layer, (w - 1024) >> 3, w & 7, lds, P);
    else if (w < 4096) attn_item<64, 64, 2>(layer, (w - 2048) >> 4, w & 15, lds, P);
    else if (w < 4112) attn_item<64, 128, 0>(layer, 128 + ((w - 4096) >> 3), w & 7, lds, P);
    else if (w < 4128) attn_item<192, 128, 1>(layer, 128 + ((w - 4112) >> 3), w & 7, lds, P);
    else attn_item<64, 64, 2>(layer, 128 + ((w - 4128) >> 4), w & 15, lds, P);
  }
}

DI void conv_tile(const float* __restrict__ src, int K, int N, u16* __restrict__ dst, int tile, int perm, char* lds) {
  float* sm = reinterpret_cast<float*>(lds);
  const int tid = otid();
  const int nts = N >> 6;
  const int kt = tile / nts, ntile = tile - kt * nts;
  const int k0 = kt * 64, n0 = ntile * 64;
#pragma unroll
  for (int j = 0; j < 16; ++j) {
    const int k = j * 4 + (tid >> 6), n = tid & 63;
    sm[k * 65 + n] = src[(long)(k0 + k) * N + n0 + n];
  }
  __syncthreads();
#pragma unroll
  for (int j = 0; j < 2; ++j) {
    const int n = (tid >> 3) + 32 * j, kc = tid & 7;
    float v[8];
#pragma unroll
    for (int e = 0; e < 8; ++e) v[e] = sm[(kc * 8 + e) * 65 + n];
    int nn = n0 + n;
    if (perm) { const int s = nn >= FFN ? 1 : 0; const int jj = nn - s * FFN; nn = 64 * (jj >> 5) + 32 * s + (jj & 31); }
    u32x4 o; o.x = pk2(v[0], v[1]); o.y = pk2(v[2], v[3]); o.z = pk2(v[4], v[5]); o.w = pk2(v[6], v[7]);
    *GP(u32x4, dst + (long)nn * K + k0 + kc * 8) = o;
  }
  __syncthreads();
}

constexpr int CONV_TILES = 7616;
DI void conv_phase(int layer, const Params& P, char* lds, int extra_first) {
  char* ws = ows(P);
  for (int t = blockIdx.x + extra_first; t < CONV_TILES + extra_first; t += gridDim.x) {
    int x = t - extra_first;
    const float* src; int K, N, perm = 0; u16* dst;
    if (x < 2816) { const int s = x / 1408; x -= s * 1408; src = P.in[7] + ((long)(layer * 2 + s)) * DM * 2 * FFN; K = DM; N = 2 * FFN; perm = 1; dst = reinterpret_cast<u16*>(ws + O_WIN + s * SZ_WIN); }
    else if (x < 4224) { x -= 2816; const int s = x / 704; x -= s * 704; src = P.in[8] + ((long)(layer * 2 + s)) * FFN * DM; K = FFN; N = DM; dst = reinterpret_cast<u16*>(ws + O_WOUT + s * SZ_WOUT); }
    else if (x < 6320) { x -= 4224; src = P.in[9] + (long)layer * DM * MIXIN; K = DM; N = MIXIN; dst = reinterpret_cast<u16*>(ws + O_WMIX); }
    else if (x < 6464) { x -= 6320; src = P.in[15] + (long)layer * 384 * 1536; K = 384; N = 1536; dst = reinterpret_cast<u16*>(ws + O_WUQ); }
    else if (x < 6592) { x -= 6464; src = P.in[16] + (long)layer * 256 * 2048; K = 256; N = 2048; dst = reinterpret_cast<u16*>(ws + O_WUKV); }
    else if (x < 7360) { x -= 6592; const int br = x / 256; x -= br * 256; src = P.in[17] + ((long)(layer * 3 + br)) * DM * DM; K = DM; N = DM; dst = reinterpret_cast<u16*>(ws + O_WBR) + (long)br * DM * DM; }
    else { x -= 7360; src = P.in[18] + (long)layer * DM * DM; K = DM; N = DM; dst = reinterpret_cast<u16*>(ws + O_WMO); }
    conv_tile(src, K, N, dst, x, perm, lds);
  }
}

DI void mods_item(int item, const Params& P, char* lds) {
  float* sv = reinterpret_cast<float*>(lds);
  float* red = sv + 3 * 1024;
  const int tid = otid();
  const int l = item / 144, nb = item - l * 144;
  for (int e = tid; e < 3 * 1024; e += 256) {
    const int v = e >> 10, k = e & 1023;
    const float x = v < 2 ? P.in[1][v * DM + k] : P.in[3][k];
    sv[e] = x / (1.f + __expf(-x));
  }
  __syncthreads();
  const int c = tid & 63, kg = tid >> 6;
  const float* w = P.in[4] + (long)l * DM * 9216 + nb * 64 + c;
  float a0 = 0.f, a1 = 0.f, a2 = 0.f;
  for (int k = kg * 256; k < kg * 256 + 256; ++k) {
    const float wv = w[(long)k * 9216];
    a0 += sv[k] * wv; a1 += sv[1024 + k] * wv; a2 += sv[2048 + k] * wv;
  }
  red[(kg * 3 + 0) * 64 + c] = a0; red[(kg * 3 + 1) * 64 + c] = a1; red[(kg * 3 + 2) * 64 + c] = a2;
  __syncthreads();
  if (tid < 192) {
    const int v = tid >> 6, cc = tid & 63;
    float s = red[(0 * 3 + v) * 64 + cc] + red[(1 * 3 + v) * 64 + cc] + red[(2 * 3 + v) * 64 + cc] + red[(3 * 3 + v) * 64 + cc];
    const int n = nb * 64 + cc;
    reinterpret_cast<float*>(ows(P) + O_MODS)[(l * 3 + v) * 9216 + n] = s + P.in[5][l * 9216 + n];
  }
  __syncthreads();
}

DI void misc_item(const Params& P) {
  const int tid = otid();
  float* rope = reinterpret_cast<float*>(ows(P) + O_ROPE);
  for (int e = tid; e < 256 * 16; e += 256) {
    const int p = e >> 4, j = e & 15;
    const float ang = (float)p * P.inv_freq[j];
    double a = (double)ang;
    const double TWO_PI = 6.283185307179586476925;
    a -= TWO_PI * rint(a / TWO_PI);
    const double q = a * 0.25, q2 = q * q;
    double sn = q * (1.0 + q2 * (-1.0 / 6 + q2 * (1.0 / 120 + q2 * (-1.0 / 5040 + q2 * (1.0 / 362880 + q2 * (-1.0 / 39916800 + q2 * (1.0 / 6227020800.0)))))));
    double cs = 1.0 + q2 * (-0.5 + q2 * (1.0 / 24 + q2 * (-1.0 / 720 + q2 * (1.0 / 40320 + q2 * (-1.0 / 3628800 + q2 * (1.0 / 479001600.0 + q2 * (-1.0 / 87178291200.0)))))));
    double s2 = 2 * sn * cs, c2 = cs * cs - sn * sn;
    double s4 = 2 * s2 * c2, c4 = c2 * c2 - s2 * s2;
    rope[e] = (float)c4;
    rope[256 * 16 + e] = (float)s4;
  }
  if (tid < DEPTH) {
    const float* dl = P.in[10] + tid * 4 * 64;
    float d01 = 0.f, d23 = 0.f;
    for (int i = 0; i < 64; ++i) { d01 += dl[i] * dl[64 + i]; d23 += dl[128 + i] * dl[192 + i]; }
    reinterpret_cast<float*>(ows(P) + O_LAM)[tid] = expf(d01) - expf(d23) + P.linit[tid];
  }
}

#define XB_TMO      128
#define XB_XCNT(j)  (256  + 64 * (j))
#define XB_XSUB(j)  (1280 + 64 * (j))
#define XB_XGEN(j)  (2304 + 64 * (j))
#define XB_TOP      3328
#define XB_TOPGEN   3392
#define XCD_BAR_WORDS 3456
#define XB_SPIN_CAP (1u << 18)
#define LAS __attribute__((address_space(3)))
DI unsigned xb_ld(unsigned* p) { return __hip_atomic_load(p, __ATOMIC_RELAXED, __HIP_MEMORY_SCOPE_AGENT); }
DI unsigned xb_add(unsigned* p, unsigned v) { return __hip_atomic_fetch_add(p, v, __ATOMIC_RELAXED, __HIP_MEMORY_SCOPE_AGENT); }
DI unsigned xb_xcc_id() { return (unsigned)__builtin_amdgcn_s_getreg((3 << 11) | 20) & 0xFu; }
#define XB_SPIN(cond, bar) do { unsigned _sp = 0; while (cond) { __builtin_amdgcn_s_sleep(1); \
    if ((++_sp & 255u) == 0u) { if (xb_ld(&(bar)[XB_TMO])) break; if (_sp > XB_SPIN_CAP) { atomicAdd(&(bar)[XB_TMO], 1u); break; } } } } while (0)
struct XcdBarrier { unsigned* bar; unsigned x; volatile LAS unsigned* st; };
DI XcdBarrier xcd_barrier_post(unsigned* bar, volatile LAS unsigned* st) {
  XcdBarrier b; b.bar = bar; b.x = xb_xcc_id(); b.st = st;
  if (threadIdx.x == 0) (void)xb_add(&bar[XB_XCNT(b.x)], 1u);
  return b;
}
DI void xcd_barrier_complete(unsigned* bar, unsigned x, unsigned& nloc, unsigned& nx) {
  const unsigned G = gridDim.x * gridDim.y * gridDim.z;
  unsigned sum, cnt, mine, sp = 0u;
  for (;;) {
    sum = 0u; cnt = 0u; mine = 0u;
#pragma unroll
    for (unsigned j = 0; j < 16; ++j) { const unsigned c = xb_ld(&bar[XB_XCNT(j)]); sum += c; cnt += (c > 0u) ? 1u : 0u; mine = (j == x) ? c : mine; }
    if (sum == G) break;
    __builtin_amdgcn_s_sleep(1);
    if ((++sp & 255u) == 0u) { if (xb_ld(&bar[XB_TMO])) break; if (sp > XB_SPIN_CAP) { atomicAdd(&bar[XB_TMO], 1u); break; } }
  }
  nloc = mine > 0u ? mine : 1u; nx = cnt > 0u ? cnt : 1u;
}
DI void xcd_barrier(const XcdBarrier& b) {
  asm volatile("s_waitcnt vmcnt(0)" ::: "memory");
  __syncthreads();
  if (threadIdx.x == 0) {
    unsigned* bar = b.bar;
    __builtin_amdgcn_s_waitcnt(0);
    unsigned nloc = b.st[0], nx = b.st[1];
    if (nloc == 0u) { xcd_barrier_complete(bar, b.x, nloc, nx); b.st[0] = nloc; b.st[1] = nx; }
    const unsigned old = xb_add(&bar[XB_XSUB(b.x)], 1u);
    const unsigned gen = old / nloc;
    if (old + 1u == (gen + 1u) * nloc) {
      __builtin_amdgcn_fence(__ATOMIC_RELEASE, "agent");
      asm volatile("s_waitcnt vmcnt(0)" ::: "memory");
      const unsigned og = xb_add(&bar[XB_TOP], 1u);
      const unsigned tg = og / nx;
      if (og + 1u == (tg + 1u) * nx) xb_add(&bar[XB_TOPGEN], 1u);
      else XB_SPIN(xb_ld(&bar[XB_TOPGEN]) == tg, bar);
      __builtin_amdgcn_fence(__ATOMIC_ACQUIRE, "agent");
      xb_add(&bar[XB_XGEN(b.x)], 1u);
      asm volatile("s_waitcnt vmcnt(0)" ::: "memory");
    } else {
      XB_SPIN(xb_ld(&bar[XB_XGEN(b.x)]) == gen, bar);
      __builtin_amdgcn_fence(__ATOMIC_ACQUIRE, "agent");
      asm volatile("s_waitcnt vmcnt(0)" ::: "memory");
    }
  }
  __syncthreads();
}

constexpr size_t LDS_BYTES = 65536 + 64;
constexpr int NPL = 23;
constexpr int NPH = 1 + DEPTH * NPL;

__global__ void __launch_bounds__(256, 2) fwd_megakernel(Params P) {
  extern __shared__ __attribute__((aligned(16))) char lds[];
  cg::grid_group grid = cg::this_grid();
  volatile LAS unsigned* xst = (volatile LAS unsigned*)(lds + 65536);
  if (threadIdx.x == 0) { xst[0] = 0u; xst[1] = 0u; }
  __syncthreads();
  const XcdBarrier xb = xcd_barrier_post(reinterpret_cast<unsigned*>(P.ws + O_BAR), xst);
  char* ws = P.ws;
  u16* U = reinterpret_cast<u16*>(ws + O_U);
  float* tctx = reinterpret_cast<float*>(ws + O_TCTX);
  for (int ph = 0; ph < NPH; ++ph) {
    int kind = 0;
    GemmDesc gd; RowDesc rd;
    gd.skipctx = 0; gd.epi = 0; gd.mtiles = 0; gd.ntiles = 0; gd.K = 0; gd.lda = 0; gd.A = nullptr; gd.W = nullptr; gd.dst = nullptr;
    rd.skipctx = 0; rd.g0 = 0; rd.g1 = 0; rd.told_lat = P.out; rd.told_ctx = tctx; rd.ybuf = nullptr; rd.yrow0 = 0; rd.gscale = 1.f;
    rd.gate_idx = 0; rd.gpost_idx = 0; rd.layer = 0; rd.has_u = 0; rd.ulayer = 0; rd.gpre_idx = 0; rd.shift_idx = 0; rd.scale_idx = 0;
    int layer = 0, conv_layer = -1;
    if (ph == 0) {
      for (int t = blockIdx.x; t < 289; t += gridDim.x) { if (t < 288) mods_item(t, P, lds); else misc_item(P); }
      conv_phase(0, P, lds, 0);
    } else {
      layer = (ph - 1) / NPL;
      const int q = (ph - 1) - layer * NPL;
      const bool first = layer == 0;
      if (q == 0) {
        if (first) { kind = 2; rd.g0 = 0; rd.g1 = MT; rd.told_lat = P.in[0]; rd.told_ctx = P.in[2]; rd.has_u = 1; rd.ulayer = 0; rd.gpre_idx = 0; rd.shift_idx = 0; rd.scale_idx = 1; }
        else kind = -1;
      } else if (q == 1 || q == 20) {
        const int s = q == 1 ? 0 : 1;
        kind = 1; gd.epi = EPI_SWIGLU; gd.mtiles = MT / 128;
        if (s == 1 && layer + 1 == DEPTH) { gd.mtiles = 256; gd.skipctx = 1; } gd.ntiles = 44; gd.K = DM; gd.lda = DM; gd.A = U;
        gd.W = reinterpret_cast<const u16*>(ws + O_WIN + s * SZ_WIN); gd.dst = ws + O_ACT;
      } else if (q == 2 || q == 21) {
        const int s = q == 2 ? 0 : 1;
        kind = 1; gd.epi = EPI_YF32; gd.mtiles = MT / 128;
        if (s == 1 && layer + 1 == DEPTH) { gd.mtiles = 256; gd.skipctx = 1; } gd.ntiles = 8; gd.K = FFN; gd.lda = FFN; gd.A = reinterpret_cast<const u16*>(ws + O_ACT);
        gd.W = reinterpret_cast<const u16*>(ws + O_WOUT + s * SZ_WOUT); gd.dst = ws + O_Y;
      } else if (q == 3) {
        kind = 2; rd.g0 = 0; rd.g1 = MT;
        if (first) { rd.told_lat = P.in[0]; rd.told_ctx = P.in[2]; }
        rd.ybuf = reinterpret_cast<const float*>(ws + O_Y); rd.yrow0 = 0; rd.gscale = 0.5f; rd.gate_idx = 2; rd.gpost_idx = 1; rd.layer = layer;
        rd.has_u = 1; rd.ulayer = layer; rd.gpre_idx = 2; rd.shift_idx = 3; rd.scale_idx = 4;
      } else if (q < 20) {
        const int b = (q - 4) >> 3, qq = (q - 4) & 7;
        const u16* Ub = U + (long)b * MB * DM;
        const int mtq = layer + 1 == DEPTH ? 128 : 130;
        if (qq == 0) { kind = 1; gd.epi = EPI_PROJ; gd.mtiles = 130; gd.ntiles = 42; gd.K = DM; gd.lda = DM; gd.A = Ub; gd.W = reinterpret_cast<const u16*>(ws + O_WMIX); }
        else if (qq == 1) { kind = 3; }
        else if (qq == 2) { kind = 1; gd.epi = EPI_UQKV; gd.mtiles = 130; gd.ntiles = 28; }
        else if (qq == 3) { kind = 4; }
        else if (qq == 4) { kind = 1; gd.epi = EPI_SG; gd.mtiles = mtq; gd.ntiles = 24; gd.K = DM; gd.lda = DM; gd.A = Ub; gd.W = reinterpret_cast<const u16*>(ws + O_WMIX) + (long)NPROJ * DM; gd.dst = ws + O_SG; }
        else if (qq == 5) { kind = 5; gd.epi = EPI_MERGE; gd.mtiles = mtq; gd.ntiles = 8; gd.K = DM; gd.lda = DM; gd.A = reinterpret_cast<const u16*>(ws + O_YA); gd.W = reinterpret_cast<const u16*>(ws + O_WBR); gd.dst = ws + O_MERGED; }
        else if (qq == 6) { kind = 1; gd.epi = EPI_YF32; gd.mtiles = mtq; gd.ntiles = 8; gd.K = DM; gd.lda = DM; gd.A = reinterpret_cast<const u16*>(ws + O_MERGED); gd.W = reinterpret_cast<const u16*>(ws + O_WMO); gd.dst = ws + O_YO; }
        else {
          kind = 2; rd.g0 = b * MB; rd.g1 = (b + 1) * MB; rd.skipctx = layer + 1 == DEPTH; rd.ybuf = reinterpret_cast<const float*>(ws + O_YO); rd.yrow0 = b * MB; rd.gscale = 1.f;
          rd.gate_idx = 5; rd.gpost_idx = 3; rd.layer = layer; rd.has_u = 1; rd.ulayer = layer; rd.gpre_idx = 4; rd.shift_idx = 6; rd.scale_idx = 7;
        }
      } else {
        kind = 2; rd.g0 = 0; rd.g1 = MT; rd.skipctx = layer + 1 == DEPTH; rd.ybuf = reinterpret_cast<const float*>(ws + O_Y); rd.yrow0 = 0; rd.gscale = 0.5f; rd.gate_idx = 8; rd.gpost_idx = 5; rd.layer = layer;
        if (layer + 1 < DEPTH) { rd.has_u = 1; rd.ulayer = layer + 1; rd.gpre_idx = 0; rd.shift_idx = 0; rd.scale_idx = 1; conv_layer = layer + 1; }
      }
    }
    if (kind == 1) gemm_phase<false>(gd, P, lds);
    else if (kind == 5) gemm_phase<true>(gd, P, lds);
    else if (kind == 2) rowop_phase(rd, P);
    else if (kind == 3) r3_phase(layer, P);
    else if (kind == 4) attn_phase(layer, P, lds);
    if (conv_layer >= 0) conv_phase(conv_layer, P, lds, 0);
    if (kind != -1 && ph + 1 < NPH) {
      if (P.pad[0] == 0x7fffffff) grid.sync();
      xcd_barrier(xb);
    }
  }
}

extern "C" void kernel_launch(void* const* d_in, const int* in_sizes, int n_in, void* d_out, int out_size, void* d_ws, size_t ws_size,
                              hipStream_t stream) {
  static int grid_blocks = 0;
  if (!grid_blocks) {
    int dev = 0, cus = 0, per_cu = 0;
    (void)hipGetDevice(&dev);
    (void)hipDeviceGetAttribute(&cus, hipDeviceAttributeMultiprocessorCount, dev);
    (void)hipFuncSetAttribute((const void*)fwd_megakernel, hipFuncAttributeMaxDynamicSharedMemorySize, (int)LDS_BYTES);
    (void)hipOccupancyMaxActiveBlocksPerMultiprocessor(&per_cu, fwd_megakernel, 256, LDS_BYTES);
    if (per_cu > 2) per_cu = 2;
    if (per_cu < 1) per_cu = 1;
    grid_blocks = cus * per_cu;
    fprintf(stderr, "megakernel: cus %d per_cu %d grid %d ws_need %zu ws_size %zu\n", cus, per_cu, grid_blocks, (size_t)WS_NEED, ws_size);
  }
  if (n_in != 19 || ws_size < WS_NEED) {
    fprintf(stderr, "kernel_launch: bad setup n_in %d ws_size %zu need %zu\n", n_in, ws_size, (size_t)WS_NEED);
    return;
  }
  Params p{};
  for (int i = 0; i < 19; ++i) p.in[i] = reinterpret_cast<const float*>(d_in[i]);
  p.out = reinterpret_cast<float*>(d_out);
  p.ws = reinterpret_cast<char*>(d_ws);
  for (int j = 0; j < 16; ++j) p.inv_freq[j] = 1.0f / powf(10000.0f, (float)j / 16.0f);
  for (int l = 0; l < DEPTH; ++l) p.linit[l] = (float)(0.8 - 0.6 * exp(-0.3 * (double)l));
  (void)hipMemsetAsync(reinterpret_cast<char*>(d_ws) + O_BAR, 0, XCD_BAR_WORDS * 4, stream);
  void* args[] = {&p};
  hipError_t e = hipLaunchCooperativeKernel((void*)fwd_megakernel, dim3(grid_blocks), dim3(256), args, LDS_BYTES, stream);
  if (e != hipSuccess) fprintf(stderr, "cooperative launch failed: %s (grid %d)\n", hipGetErrorString(e), grid_blocks);
}
```

```cpp
#include <hip/hip_runtime.h>
#include <hip/hip_cooperative_groups.h>
#include <cstdio>
#include <cstdint>
#include <cmath>
namespace cg = cooperative_groups;

typedef unsigned short u16;
using bf16x8 = __attribute__((ext_vector_type(8))) short;
using f32x16 = __attribute__((ext_vector_type(16))) float;
using u32x4 = __attribute__((ext_vector_type(4))) unsigned;
using u32x2 = __attribute__((ext_vector_type(2))) unsigned;
using f32x4 = __attribute__((ext_vector_type(4))) float;
#define GAS __attribute__((address_space(1)))
#define GP(T, p) (reinterpret_cast<GAS T*>(reinterpret_cast<uintptr_t>(p)))
#define GPC(T, p) (reinterpret_cast<const GAS T*>(reinterpret_cast<uintptr_t>(p)))
typedef __bf16 bf2_t __attribute__((ext_vector_type(2)));
typedef float f2_t __attribute__((ext_vector_type(2)));
#define DI __device__ __forceinline__
#define MFMA(a, b, c) __builtin_amdgcn_mfma_f32_32x32x16_bf16((a), (b), (c), 0, 0, 0)

constexpr int DM = 1024, NB = 2, SEQ = 16384, CTX = 256, DEPTH = 2;
constexpr int MB = SEQ + CTX;
constexpr int MT = NB * MB;
constexpr int FFN = 2816;
constexpr int MIXIN = 8384, NPROJ = 5312;
constexpr float EPS = 1e-6f;
constexpr float LOG2E = 1.4426950408889634f;

constexpr size_t SZ_WIN = (size_t)2 * FFN * DM * 2;
constexpr size_t SZ_WOUT = (size_t)DM * FFN * 2;
constexpr size_t O_WIN = 0;
constexpr size_t O_WOUT = O_WIN + 2 * SZ_WIN;
constexpr size_t O_WMIX = O_WOUT + 2 * SZ_WOUT;
constexpr size_t O_WUQ = O_WMIX + (size_t)MIXIN * DM * 2;
constexpr size_t O_WUKV = O_WUQ + (size_t)1536 * 384 * 2;
constexpr size_t O_WBR = O_WUKV + (size_t)2048 * 256 * 2;
constexpr size_t O_WMO = O_WBR + (size_t)3 * DM * DM * 2;
constexpr size_t O_MODS = O_WMO + (size_t)DM * DM * 2;
constexpr size_t O_ROPE = O_MODS + (size_t)DEPTH * 3 * 9216 * 4;
constexpr size_t O_LAM = O_ROPE + 2 * 256 * 16 * 4;
constexpr size_t O_BAR = O_LAM + 256;
constexpr size_t O_TCTX = O_BAR + 16384;
constexpr size_t O_U = O_TCTX + (size_t)NB * CTX * DM * 4;
constexpr size_t O_RX = O_U + (size_t)MT * DM * 2;
constexpr size_t O_ACT = O_RX;
constexpr size_t O_Y = O_ACT + (size_t)MT * FFN * 2;
constexpr size_t END_FFN = O_Y + (size_t)MT * DM * 4;
constexpr size_t SZ1 = (size_t)MB * DM * 2;
constexpr size_t SZQ = (size_t)MB * 256 * 2;
constexpr size_t O_QA = O_RX;
constexpr size_t O_KA = O_QA + SZ1;
constexpr size_t O_VAT = O_KA + SZ1;
constexpr size_t O_QB = O_VAT + SZ1;
constexpr size_t O_KB = O_QB + SZ1;
constexpr size_t O_VBT = O_KB + SZQ;
constexpr size_t O_CQ = O_VBT + SZQ;
constexpr size_t O_CKV = O_CQ + (size_t)MB * 384 * 2;
constexpr size_t O_KR = O_CKV + SZQ;
constexpr size_t O_QC = O_KR + (size_t)MB * 64 * 2;
constexpr size_t O_KCN = O_QC + (size_t)MB * 1536 * 2;
constexpr size_t O_VCT = O_KCN + SZ1;
constexpr size_t O_YA = O_VCT + SZ1;
constexpr size_t END_MIX = O_YA + 3 * SZ1;
constexpr size_t O_SG = O_QA;
constexpr size_t O_MERGED = O_QB;
constexpr size_t O_YO = O_KCN;
constexpr size_t WS_NEED = END_MIX > END_FFN ? END_MIX : END_FFN;

struct Params {
  const float* in[19];
  float* out;
  char* ws;
  float inv_freq[16];
  float linit[2];
  int pad[2];
};

DI int otid() { int t = threadIdx.x; asm volatile("" : "+v"(t)); return t; }
DI char* ows(const Params& P) {
  const unsigned long long w = reinterpret_cast<unsigned long long>(P.ws);
  unsigned lo = __builtin_amdgcn_readfirstlane((unsigned)w), hi = __builtin_amdgcn_readfirstlane((unsigned)(w >> 32));
  asm volatile("" : "+s"(lo), "+s"(hi));
  return reinterpret_cast<char*>(((unsigned long long)hi << 32) | lo);
}
DI const char* uptr(const void* p) {
  const unsigned long long w = reinterpret_cast<unsigned long long>(p);
  const unsigned lo = __builtin_amdgcn_readfirstlane((unsigned)w), hi = __builtin_amdgcn_readfirstlane((unsigned)(w >> 32));
  return reinterpret_cast<const char*>(((unsigned long long)hi << 32) | lo);
}
DI int crow(int i, int h) { return (i & 3) + 8 * (i >> 2) + 4 * h; }
DI unsigned pk2(float a, float b) { f2_t v = {a, b}; bf2_t r = __builtin_convertvector(v, bf2_t); return __builtin_bit_cast(unsigned, r); }
DI float bflo(unsigned x) { return __uint_as_float(x << 16); }
DI float bfhi(unsigned x) { return __uint_as_float(x & 0xffff0000u); }
DI float wave_sum(float v) {
#pragma unroll
  for (int o = 32; o > 0; o >>= 1) v += __shfl_xor(v, o);
  return v;
}
DI float xhalf_max(float v) {
  auto rr = __builtin_amdgcn_permlane32_swap(__float_as_uint(v), __float_as_uint(v), false, false);
  return fmaxf(__uint_as_float(rr[0]), __uint_as_float(rr[1]));
}
DI float xhalf_sum(float v) {
  auto rr = __builtin_amdgcn_permlane32_swap(__float_as_uint(v), __float_as_uint(v), false, false);
  return __uint_as_float(rr[0]) + __uint_as_float(rr[1]);
}
DI float vmax3(float a, float b, float c) { float r; asm("v_max3_f32 %0, %1, %2, %3" : "=v"(r) : "v"(a), "v"(b), "v"(c)); return r; }
DI float vmax3w(float a, float b, float c, float dep) { float r; asm volatile("s_nop 15\n\tv_max3_f32 %0, %1, %2, %3" : "=v"(r) : "v"(a), "v"(b), "v"(c), "v"(dep)); return r; }
DI float vmax3d4(float a, float b, float c, float d1, float d2, float d3, float d4) { float r; asm("v_max3_f32 %0, %1, %2, %3" : "=v"(r) : "v"(a), "v"(b), "v"(c), "v"(d1), "v"(d2), "v"(d3), "v"(d4)); return r; }
DI float vmax3d(float a, float b, float c, float dep) { float r; asm("v_max3_f32 %0, %1, %2, %3" : "=v"(r) : "v"(a), "v"(b), "v"(c), "v"(dep)); return r; }
DI float sigmoidf_(float x) { return __builtin_amdgcn_rcpf(1.f + __builtin_amdgcn_exp2f(-LOG2E * x)); }
DI void st_bf16_tile(const f32x16& c, u16* dst, int h) {
#pragma unroll
  for (int q = 0; q < 4; ++q) {
    u32x2 v; v.x = pk2(c[4 * q], c[4 * q + 1]); v.y = pk2(c[4 * q + 2], c[4 * q + 3]);
    *GP(u32x2, dst + 8 * q + 4 * h) = v;
  }
}
DI void st_bf16_tile_vt(const f32x16& c, u16* dst, int h) {
#pragma unroll
  for (int q = 0; q < 4; ++q) {
    u32x2 v; v.x = pk2(c[4 * q], c[4 * q + 1]); v.y = pk2(c[4 * q + 2], c[4 * q + 3]);
    *GP(u32x2, dst + 16 * (q >> 1) + 8 * h + 4 * (q & 1)) = v;
  }
}
DI void st_f32_tile(const f32x16& c, float* dst, int h) {
#pragma unroll
  for (int q = 0; q < 4; ++q) {
    f32x4 v = {c[4 * q], c[4 * q + 1], c[4 * q + 2], c[4 * q + 3]};
    *GP(f32x4, dst + 8 * q + 4 * h) = v;
  }
}
DI void rope_tile(f32x16& c, const float* __restrict__ rope, int idx, int h) {
  const float* cp = rope + idx * 16 + 4 * h;
  const float* sp = cp + 256 * 16;
  const f32x4 c0 = *GPC(f32x4, cp), c1 = *GPC(f32x4, cp + 8);
  const f32x4 s0 = *GPC(f32x4, sp), s1 = *GPC(f32x4, sp + 8);
#define ROPE1(i, CS, SN) { const float x1 = c[i], x2 = c[(i) + 8]; c[i] = x1 * (CS) - x2 * (SN); c[(i) + 8] = x2 * (CS) + x1 * (SN); }
  ROPE1(0, c0.x, s0.x) ROPE1(1, c0.y, s0.y) ROPE1(2, c0.z, s0.z) ROPE1(3, c0.w, s0.w)
  ROPE1(4, c1.x, s1.x) ROPE1(5, c1.y, s1.y) ROPE1(6, c1.z, s1.z) ROPE1(7, c1.w, s1.w)
#undef ROPE1
}

template <bool TRANS>
DI void gemm_kloop(const u16* __restrict__ A, int lda, const u16* __restrict__ W, int ldw, int K, f32x16 (&acc)[2][2], char* lds) {
  const int tid = otid(), lane = tid & 63, wid = tid >> 6, r = lane & 31, h = lane >> 5;
  const int wm = wid >> 1, wn = wid & 1;
  const int lrow = tid >> 3, lkc = tid & 7;
  const unsigned voa = (unsigned)(lrow * lda + lkc * 8) * 2u, vob = (unsigned)(lrow * ldw + lkc * 8) * 2u;
  const char* Ab = reinterpret_cast<const char*>(A);
  const char* Wb = reinterpret_cast<const char*>(W);
  const int soff0 = lrow * 128 + ((lkc ^ ((lrow >> 1) & 7)) << 4);
  u32x4 ra0, ra1, ra2, ra3, rb0, rb1, rb2, rb3, rc0, rc1, rc2, rc3, rd0, rd1, rd2, rd3;
#define GLOAD(A0, A1, A2, A3, B0, B1, B2, B3, k0)                                \
  {                                                                              \
    const char* pa_ = Ab + (long)(k0) * 2;                                       \
    const char* pw_ = Wb + (long)(k0) * 2;                                       \
    A0 = *GPC(u32x4, pa_ + voa);                                                 \
    A1 = *GPC(u32x4, pa_ + (long)64 * lda + voa);                                \
    A2 = *GPC(u32x4, pa_ + (long)128 * lda + voa);                               \
    A3 = *GPC(u32x4, pa_ + (long)192 * lda + voa);                               \
    B0 = *GPC(u32x4, pw_ + vob);                                                 \
    B1 = *GPC(u32x4, pw_ + (long)64 * ldw + vob);                                \
    B2 = *GPC(u32x4, pw_ + (long)128 * ldw + vob);                               \
    B3 = *GPC(u32x4, pw_ + (long)192 * ldw + vob);                               \
  }
#define SSTORE(A0, A1, A2, A3, B0, B1, B2, B3, bufi)                             \
  {                                                                              \
    char* sb = lds + (bufi) * 32768 + soff0;                                     \
    *reinterpret_cast<u32x4*>(sb) = A0;                                          \
    *reinterpret_cast<u32x4*>(sb + 4096) = A1;                                   \
    *reinterpret_cast<u32x4*>(sb + 8192) = A2;                                   \
    *reinterpret_cast<u32x4*>(sb + 12288) = A3;                                  \
    *reinterpret_cast<u32x4*>(sb + 16384) = B0;                                  \
    *reinterpret_cast<u32x4*>(sb + 16384 + 4096) = B1;                           \
    *reinterpret_cast<u32x4*>(sb + 16384 + 8192) = B2;                           \
    *reinterpret_cast<u32x4*>(sb + 16384 + 12288) = B3;                          \
  }
#define SET0 ra0, ra1, ra2, ra3, rb0, rb1, rb2, rb3
#define SET1 rc0, rc1, rc2, rc3, rd0, rd1, rd2, rd3
#define GL(...) GLOAD(__VA_ARGS__)
#define SS(...) SSTORE(__VA_ARGS__)
  const int KT = K >> 6;
  const int xr = (r >> 1) & 7;
  const int aoff = (wm * 64 + r) * 128, boff = 16384 + (wn * 64 + r) * 128;
#define COMPUTE(bufi)                                                                                                              \
  {                                                                                                                                \
    const char* buf = lds + (bufi) * 32768;                                                                                        \
    bf16x8 a0n, a1n, b0n, b1n;                                                                                                     \
    {                                                                                                                              \
      const int co = (h ^ xr) << 4;                                                                                                \
      a0n = *reinterpret_cast<const bf16x8*>(buf + aoff + co); a1n = *reinterpret_cast<const bf16x8*>(buf + aoff + 4096 + co);     \
      b0n = *reinterpret_cast<const bf16x8*>(buf + boff + co); b1n = *reinterpret_cast<const bf16x8*>(buf + boff + 4096 + co);     \
    }                                                                                                                              \
    _Pragma("unroll") for (int s = 0; s < 4; ++s) {                                                                                \
      const bf16x8 a0 = a0n, a1 = a1n, b0 = b0n, b1 = b1n;                                                                         \
      if (s < 3) {                                                                                                                 \
        const int co = ((2 * (s + 1) + h) ^ xr) << 4;                                                                              \
        a0n = *reinterpret_cast<const bf16x8*>(buf + aoff + co); a1n = *reinterpret_cast<const bf16x8*>(buf + aoff + 4096 + co);   \
        b0n = *reinterpret_cast<const bf16x8*>(buf + boff + co); b1n = *reinterpret_cast<const bf16x8*>(buf + boff + 4096 + co);   \
      }                                                                                                                            \
      if (TRANS) {                                                                                                                 \
        acc[0][0] = MFMA(a0, b0, acc[0][0]); acc[0][1] = MFMA(a0, b1, acc[0][1]);                                                  \
        acc[1][0] = MFMA(a1, b0, acc[1][0]); acc[1][1] = MFMA(a1, b1, acc[1][1]);                                                  \
      } else {                                                                                                                     \
        acc[0][0] = MFMA(b0, a0, acc[0][0]); acc[0][1] = MFMA(b1, a0, acc[0][1]);                                                  \
        acc[1][0] = MFMA(b0, a1, acc[1][0]); acc[1][1] = MFMA(b1, a1, acc[1][1]);                                                  \
      }                                                                                                                            \
      __builtin_amdgcn_sched_barrier(0);                                                                                           \
    }                                                                                                                              \
  }
  GL(SET0, 0);
  SS(SET0, 0);
  GL(SET1, 64);
  __syncthreads();
  for (int kt = 0; kt < KT; kt += 2) {
    const bool m2 = kt + 2 < KT;
    if (m2) { GL(SET0, (kt + 2) * 64); }
    COMPUTE(0);
    SS(SET1, 1);
    __syncthreads();
    if (m2) { GL(SET1, (kt + 3) * 64); }
    COMPUTE(1);
    if (m2) { SS(SET0, 0); }
    __syncthreads();
  }
#undef GLOAD
#undef SSTORE
#undef SET0
#undef SET1
#undef GL
#undef SS
#undef COMPUTE
}

enum { EPI_SWIGLU = 0, EPI_YF32 = 1, EPI_PROJ = 2, EPI_UQKV = 3, EPI_SG = 4, EPI_MERGE = 5 };
struct GemmDesc {
  int epi, mtiles, ntiles, K, lda, skipctx;
  const u16* A; const u16* W;
  void* dst;
};

template <bool MERGE>
DI void gemm_phase(const GemmDesc& d, const Params& P, char* lds) {
  const int tid = otid(), lane = tid & 63, wid = tid >> 6, r = lane & 31, h = lane >> 5;
  const int wm = wid >> 1, wn = wid & 1;
  char* ws = ows(P);
  const float* rope = reinterpret_cast<const float*>(ws + O_ROPE);
  const int ntl = d.mtiles * d.ntiles;
  for (int t = blockIdx.x; t < ntl; t += gridDim.x) {
    int mt = t / d.ntiles;
    int nt = t - mt * d.ntiles;
    if (d.ntiles == 8) {
      const int m4 = d.mtiles & ~3;
      if (t < 8 * m4) {
        const int x = t & 7, k = t >> 3;
        nt = 4 * (x & 1) + (k & 3);
        mt = 4 * (k >> 2) + (x >> 1);
      }
    }
    if (d.skipctx && mt >= 128) mt += 2;
    const u16* A = d.A; const u16* W = d.W; int lda = d.lda, K = d.K;
    bool trans = false;
    int uq = 0;
    if (d.epi == EPI_PROJ) {
      const int n0 = nt * 128;
      trans = (n0 >= 2048 && n0 < 3072) || (n0 >= 4352 && n0 < 4608);
    } else if (d.epi == EPI_UQKV) {
      if (nt < 12) { uq = 1; A = reinterpret_cast<const u16*>(ws + O_CQ); lda = 384; K = 384; W = reinterpret_cast<const u16*>(ws + O_WUQ); }
      else { nt -= 12; A = reinterpret_cast<const u16*>(ws + O_CKV); lda = 256; K = 256; W = reinterpret_cast<const u16*>(ws + O_WUKV); trans = (nt & 1); }
    }
    const int n0 = nt * 128;
    constexpr int nrep = MERGE ? 3 : 1;
    f32x16 acc[2][2];
#pragma unroll 1
    for (int rep = 0; rep < nrep; ++rep) {
#pragma unroll
      for (int a = 0; a < 2; ++a)
#pragma unroll
        for (int b = 0; b < 2; ++b)
#pragma unroll
          for (int i = 0; i < 16; ++i) acc[a][b][i] = 0.f;
      const u16* Ar = A + (long)rep * ((long)MB * DM) + (long)(mt * 128) * lda;
      const u16* Wr = W + (long)rep * ((long)DM * DM) + (long)n0 * K;
      if (trans) gemm_kloop<true>(Ar, lda, Wr, K, K, acc, lds);
      else gemm_kloop<false>(Ar, lda, Wr, K, K, acc, lds);
      if constexpr (MERGE) {
        const u16* sg = reinterpret_cast<const u16*>(ws + O_SG);
        float* macc = reinterpret_cast<float*>(ws + O_YO);
        u16* mo = reinterpret_cast<u16*>(d.dst);
#pragma unroll
        for (int mi = 0; mi < 2; ++mi)
#pragma unroll
          for (int ni = 0; ni < 2; ++ni) {
            const long row = mt * 128 + wm * 64 + mi * 32 + r;
            const int col = n0 + wn * 64 + ni * 32 + 4 * h;
            const u16* gp = sg + row * 3072 + rep * 1024 + col;
            float* mp = macc + row * DM + col;
#pragma unroll
            for (int q = 0; q < 4; ++q) {
              const u32x2 g = *GPC(u32x2, gp + 8 * q);
              f32x4 v = {0.f, 0.f, 0.f, 0.f};
              if (rep > 0) v = *GPC(f32x4, mp + 8 * q);
              v.x += bflo(g.x) * acc[mi][ni][4 * q + 0]; v.y += bfhi(g.x) * acc[mi][ni][4 * q + 1];
              v.z += bflo(g.y) * acc[mi][ni][4 * q + 2]; v.w += bfhi(g.y) * acc[mi][ni][4 * q + 3];
              if (rep < 2) *GP(f32x4, mp + 8 * q) = v;
              else { u32x2 o = {pk2(v.x, v.y), pk2(v.z, v.w)}; *GP(u32x2, mo + row * DM + col + 8 * q) = o; }
            }
          }
      }
    }
    const int cb = n0 + wn * 64;
    const int rowb = mt * 128 + wm * 64;
    if constexpr (MERGE) {
    } else if (d.epi == EPI_SWIGLU) {
      u16* act = reinterpret_cast<u16*>(d.dst);
      const int acol = (n0 >> 1) + wn * 32;
#pragma unroll
      for (int mi = 0; mi < 2; ++mi) {
        f32x16 o;
#pragma unroll
        for (int i = 0; i < 16; ++i) { float a = acc[mi][0][i], b = acc[mi][1][i]; o[i] = a * sigmoidf_(a) * b; }
        st_bf16_tile(o, act + (long)(rowb + mi * 32 + r) * FFN + acol, h);
      }
    } else if (d.epi == EPI_YF32) {
      float* y = reinterpret_cast<float*>(d.dst);
#pragma unroll
      for (int mi = 0; mi < 2; ++mi)
#pragma unroll
        for (int ni = 0; ni < 2; ++ni) st_f32_tile(acc[mi][ni], y + (long)(rowb + mi * 32 + r) * DM + cb + ni * 32, h);
    } else if (d.epi == EPI_SG) {
      u16* sg = reinterpret_cast<u16*>(d.dst);
#pragma unroll
      for (int mi = 0; mi < 2; ++mi)
#pragma unroll
        for (int ni = 0; ni < 2; ++ni) {
          f32x16 o;
#pragma unroll
          for (int i = 0; i < 16; ++i) o[i] = sigmoidf_(acc[mi][ni][i]);
          st_bf16_tile(o, sg + (long)(rowb + mi * 32 + r) * 3072 + cb + ni * 32, h);
        }
    } else if (trans) {
      u16* vt; int f0;
      if (d.epi == EPI_PROJ) {
        if (cb < 3072) { vt = reinterpret_cast<u16*>(ws + O_VAT); f0 = cb - 2048; }
        else { vt = reinterpret_cast<u16*>(ws + O_VBT); f0 = cb - 4352; }
      } else { vt = reinterpret_cast<u16*>(ws + O_VCT); f0 = (nt >> 1) * 128 + wn * 64; }
#pragma unroll
      for (int mi = 0; mi < 2; ++mi)
#pragma unroll
        for (int ni = 0; ni < 2; ++ni) st_bf16_tile_vt(acc[mi][ni], vt + (long)(f0 + ni * 32 + r) * MB + rowb + mi * 32, h);
    } else {
      u16* dst = nullptr; int ld = 0, cofs = 0; bool rp = false;
      if (d.epi == EPI_PROJ) {
        if (cb < 1024) { dst = reinterpret_cast<u16*>(ws + O_QA); ld = 1024; cofs = cb; rp = true; }
        else if (cb < 2048) { dst = reinterpret_cast<u16*>(ws + O_KA); ld = 1024; cofs = cb - 1024; rp = true; }
        else if (cb < 4096) { dst = reinterpret_cast<u16*>(ws + O_QB); ld = 1024; cofs = cb - 3072; rp = true; }
        else if (cb < 4352) { dst = reinterpret_cast<u16*>(ws + O_KB); ld = 256; cofs = cb - 4096; rp = true; }
        else if (cb < 4992) { dst = reinterpret_cast<u16*>(ws + O_CQ); ld = 384; cofs = cb - 4608; }
        else if (cb < 5248) { dst = reinterpret_cast<u16*>(ws + O_CKV); ld = 256; cofs = cb - 4992; }
        else if (cb < 5312) { dst = reinterpret_cast<u16*>(ws + O_KR); ld = 64; cofs = 0; rp = true; }
      } else {
        if (uq) { dst = reinterpret_cast<u16*>(ws + O_QC); ld = 1536; cofs = cb; rp = (cb % 192) == 128; }
        else { dst = reinterpret_cast<u16*>(ws + O_KCN); ld = 1024; cofs = (nt >> 1) * 128 + wn * 64; }
      }
      if (dst != nullptr) {
        const bool latent = mt < 128;
#pragma unroll
        for (int mi = 0; mi < 2; ++mi) {
          const int lr = rowb + mi * 32 + r;
#pragma unroll
          for (int ni = 0; ni < 2; ++ni) {
            f32x16 o = acc[mi][ni];
            if (rp && latent) rope_tile(o, rope, ni == 0 ? (lr >> 6) : (lr & 63), h);
            st_bf16_tile(o, dst + (long)lr * ld + cofs + ni * 32, h);
          }
        }
      }
    }
  }
}

struct RowDesc {
  int g0, g1, skipctx;
  const float* told_lat; const float* told_ctx;
  const float* ybuf; int yrow0;
  float gscale; int gate_idx, gpost_idx, layer;
  int has_u, ulayer, gpre_idx, shift_idx, scale_idx;
};

DI void rowop_phase(const RowDesc& d, const Params& P) {
  const int tid_ = otid(); const int lane = tid_ & 63, wid = tid_ >> 6;
  char* ws = ows(P);
  const float* mods = reinterpret_cast<const float*>(ws + O_MODS);
  const float* normg = P.in[6];
  float* tctx = reinterpret_cast<float*>(ws + O_TCTX);
  u16* U = reinterpret_cast<u16*>(ws + O_U);
  const int stride = gridDim.x * 4;
  const bool has_y = d.ybuf != nullptr;
  f32x4 tn[4], yn[4];
  bool vn = false;
#define LOADROW(g_)                                                                                              \
  {                                                                                                              \
    const int b_ = (g_) / MB, i_ = (g_) - b_ * MB;                                                               \
    const bool lat_ = i_ < SEQ;                                                                                  \
    vn = !(d.skipctx && !lat_);                                                                                  \
    if (vn) {                                                                                                    \
      const long toff_ = lat_ ? ((long)(b_ * SEQ + i_)) * DM : ((long)(b_ * CTX + i_ - SEQ)) * DM;               \
      const float* told_ = (lat_ ? d.told_lat : d.told_ctx) + toff_;                                             \
      _Pragma("unroll") for (int j = 0; j < 4; ++j) tn[j] = *GPC(f32x4, told_ + lane * 4 + 256 * j);             \
      if (has_y) {                                                                                               \
        const float* y_ = d.ybuf + (long)((g_) - d.yrow0) * DM;                                                  \
        _Pragma("unroll") for (int j = 0; j < 4; ++j) yn[j] = *GPC(f32x4, y_ + lane * 4 + 256 * j);              \
      }                                                                                                          \
    }                                                                                                            \
  }
  int gnext = d.g0 + blockIdx.x * 4 + wid;
  if (gnext < d.g1) { LOADROW(gnext) }
  while (gnext < d.g1) {
    const int g = gnext;
    const bool v = vn;
    f32x4 t[4], yv[4];
#pragma unroll
    for (int j = 0; j < 4; ++j) { t[j] = tn[j]; yv[j] = yn[j]; }
    gnext += stride;
    if (gnext < d.g1) { LOADROW(gnext) }
    if (!v) continue;
    const int b = g / MB, i = g - b * MB;
    const bool lat = i < SEQ;
    const int midx = lat ? b : 2;
    const long toff = lat ? ((long)(b * SEQ + i)) * DM : ((long)(b * CTX + i - SEQ)) * DM;
    if (has_y) {
      float ss = 0.f;
#pragma unroll
      for (int j = 0; j < 4; ++j) ss += yv[j].x * yv[j].x + yv[j].y * yv[j].y + yv[j].z * yv[j].z + yv[j].w * yv[j].w;
      ss = wave_sum(ss);
      const float rr = rsqrtf(ss * (1.f / DM) + EPS) * d.gscale;
      const float* gate = mods + (d.layer * 3 + midx) * 9216 + d.gate_idx * DM;
      const float* gp = normg + (d.layer * 6 + d.gpost_idx) * DM;
      float* tnew = (lat ? P.out : tctx) + toff;
#pragma unroll
      for (int j = 0; j < 4; ++j) {
        f32x4 ga = *GPC(f32x4, gate + lane * 4 + 256 * j);
        f32x4 gg = *GPC(f32x4, gp + lane * 4 + 256 * j);
        t[j].x += ga.x * (yv[j].x * rr * gg.x); t[j].y += ga.y * (yv[j].y * rr * gg.y);
        t[j].z += ga.z * (yv[j].z * rr * gg.z); t[j].w += ga.w * (yv[j].w * rr * gg.w);
        *GP(f32x4, tnew + lane * 4 + 256 * j) = t[j];
      }
    }
    if (d.has_u) {
      float ss = 0.f;
#pragma unroll
      for (int j = 0; j < 4; ++j) ss += t[j].x * t[j].x + t[j].y * t[j].y + t[j].z * t[j].z + t[j].w * t[j].w;
      ss = wave_sum(ss);
      const float rr = rsqrtf(ss * (1.f / DM) + EPS);
      const float* mu = mods + (d.ulayer * 3 + midx) * 9216;
      const float* sh = mu + d.shift_idx * DM; const float* sc = mu + d.scale_idx * DM;
      const float* gp = normg + (d.ulayer * 6 + d.gpre_idx) * DM;
      u16* u = U + (long)g * DM;
#pragma unroll
      for (int j = 0; j < 4; ++j) {
        f32x4 gg = *GPC(f32x4, gp + lane * 4 + 256 * j);
        f32x4 s1 = *GPC(f32x4, sc + lane * 4 + 256 * j);
        f32x4 s0 = *GPC(f32x4, sh + lane * 4 + 256 * j);
        float a = (t[j].x * rr * gg.x) * (1.f + s1.x) + s0.x, bb = (t[j].y * rr * gg.y) * (1.f + s1.y) + s0.y;
        float c = (t[j].z * rr * gg.z) * (1.f + s1.z) + s0.z, dd = (t[j].w * rr * gg.w) * (1.f + s1.w) + s0.w;
        u32x2 v2; v2.x = pk2(a, bb); v2.y = pk2(c, dd);
        *GP(u32x2, u + lane * 4 + 256 * j) = v2;
      }
    }
  }
#undef LOADROW
}

DI void r3_phase(int layer, const Params& P) {
  const int tid_ = otid(); const int lane = tid_ & 63, wid = tid_ >> 6;
  char* ws = ows(P);
  u16* cq = reinterpret_cast<u16*>(ws + O_CQ);
  u16* ckv = reinterpret_cast<u16*>(ws + O_CKV);
  const float* gq = P.in[13] + layer * 384;
  const float* gkv = P.in[14] + layer * 256;
  for (int row = blockIdx.x * 4 + wid; row < MB; row += gridDim.x * 4) {
    {
      u16* p = cq + (long)row * 384;
      float v[6]; float ss = 0.f;
#pragma unroll
      for (int j = 0; j < 3; ++j) {
        unsigned x = *GPC(unsigned, p + lane * 2 + 128 * j);
        v[2 * j] = bflo(x); v[2 * j + 1] = bfhi(x); ss += v[2 * j] * v[2 * j] + v[2 * j + 1] * v[2 * j + 1];
      }
      ss = wave_sum(ss);
      const float rr = rsqrtf(ss * (1.f / 384.f) + EPS);
#pragma unroll
      for (int j = 0; j < 3; ++j) {
        const int c = lane * 2 + 128 * j;
        *GP(unsigned, p + c) = pk2(v[2 * j] * rr * gq[c], v[2 * j + 1] * rr * gq[c + 1]);
      }
    }
    {
      u16* p = ckv + (long)row * 256;
      u32x2 x = *GPC(u32x2, p + lane * 4);
      float v0 = bflo(x.x), v1 = bfhi(x.x), v2 = bflo(x.y), v3 = bfhi(x.y);
      float ss = wave_sum(v0 * v0 + v1 * v1 + v2 * v2 + v3 * v3);
      const float rr = rsqrtf(ss * (1.f / 256.f) + EPS);
      const int c = lane * 4;
      u32x2 o; o.x = pk2(v0 * rr * gkv[c], v1 * rr * gkv[c + 1]); o.y = pk2(v2 * rr * gkv[c + 2], v3 * rr * gkv[c + 3]);
      *GP(u32x2, p + c) = o;
    }
  }
}

template <int DQK, int DV, int TYPE>
DI void attn_item(int layer, int qt, int head, char* lds, const Params& P) {
  const int tid = otid(), lane = tid & 63, wid = tid >> 6, r = lane & 31, h = lane >> 5;
  char* ws = ows(P);
  constexpr int NS = DQK / 16, NDV = DV / 32;
  constexpr bool DB = DQK == 64;
  constexpr int KBYTES = 64 * DQK * 2;
  constexpr int STAGE = DB ? 24576 : 0;
  constexpr int VOFF = DB ? 8192 : 24576;
  constexpr float SCALE = TYPE == 1 ? 0.07216878364870322f : 0.125f;
  constexpr float C = SCALE * LOG2E;
  const bool latent = qt < 128;
  int ta0, na, NT;
  if (!latent) { ta0 = 256; na = 4; NT = 4; }
  else if (TYPE == 2) { int lo = qt * 2 - 2; if (lo < 0) lo = 0; int hi = qt * 2 + 4; if (hi > 256) hi = 256; ta0 = lo; na = hi - lo; NT = na + 4; }
  else { ta0 = 0; na = 260; NT = 260; }
  const int qrow = qt * 128 + wid * 32 + r;
  const u16* Kp; int ldk; const u16* Vp;
  if (TYPE == 0) { Kp = reinterpret_cast<const u16*>(ws + O_KA) + head * 128; ldk = 1024; Vp = reinterpret_cast<const u16*>(ws + O_VAT) + (long)(head * 128) * MB; }
  else if (TYPE == 1) { Kp = reinterpret_cast<const u16*>(ws + O_KCN) + head * 128; ldk = 1024; Vp = reinterpret_cast<const u16*>(ws + O_VCT) + (long)(head * 128) * MB; }
  else { Kp = reinterpret_cast<const u16*>(ws + O_KB) + (head >> 2) * 64; ldk = 256; Vp = reinterpret_cast<const u16*>(ws + O_VBT) + (long)((head >> 2) * 64) * MB; }
  const u16* K2 = reinterpret_cast<const u16*>(ws + O_KR);
  const int kr_a = (DQK == 64) ? (tid >> 3) : (tid >> 4), kc_a = (DQK == 64) ? (tid & 7) : (tid & 15);
  const int kgo_a = kr_a * ldk + kc_a * 8;
  const int kso_a = kr_a * (DQK * 2) + ((kc_a ^ ((kr_a >> 1) & 7)) << 4);
  const int kr_b = tid >> 3, kc_b = 16 + (tid & 7);
  const int kgo_b = kr_b * 64 + (tid & 7) * 8;
  const int kso_b = kr_b * (DQK * 2) + ((kc_b ^ ((kr_b >> 1) & 7)) << 4);
  const int vdv = tid >> 3, vkc = tid & 7, vxs = (vdv >> 1) & 7;
  const unsigned vvo = (unsigned)(vdv * MB + vkc * 8) * 2u;
  const unsigned kvo_a = (unsigned)kgo_a * 2u, kvo_b = (unsigned)kgo_b * 2u;
  const int vso = VOFF + vdv * 128 + ((vkc ^ vxs) << 4);
  u32x4 kreg0, kreg1, kreg2, kreg3, kreg4, kreg5, vreg0, vreg1, vreg2, vreg3;
  const int xr = (r >> 1) & 7;
  constexpr int NMAPS = TYPE == 0 ? 2 : 1;
  u16* ya_dst = reinterpret_cast<u16*>(ws + O_YA) + (long)qrow * 1024 + head * 128;
  for (int map = 0; map < NMAPS; ++map) {
    const u16* Kb = Kp + map * 64;
    const u16* Qp;
    if (TYPE == 0) Qp = reinterpret_cast<const u16*>(ws + O_QA) + (long)qrow * 1024 + head * 128 + map * 64;
    else if (TYPE == 1) Qp = reinterpret_cast<const u16*>(ws + O_QC) + (long)qrow * 1536 + head * 192;
    else Qp = reinterpret_cast<const u16*>(ws + O_QB) + (long)qrow * 1024 + head * 64;
    constexpr int NQR = NS > 6 ? 6 : NS;
    bf16x8 qf[NQR];
#pragma unroll
    for (int s = 0; s < NQR; ++s) qf[s] = *GPC(bf16x8, Qp + 16 * s + 8 * h);
    char* qpark = lds + 40960 + tid * 16;
#pragma unroll
    for (int s = NQR; s < NS; ++s) *reinterpret_cast<bf16x8*>(qpark + (s - NQR) * 4096) = *GPC(bf16x8, Qp + 16 * s + 8 * h);
    float m_run, l_run;
    if (TYPE == 2) { m_run = P.in[12][layer * 16 + head] * (1.f / SCALE); l_run = 1.f; }
    else { m_run = -1e30f; l_run = 0.f; }
    f32x16 oacc[NDV];
#pragma unroll
    for (int d = 0; d < NDV; ++d)
#pragma unroll
      for (int i = 0; i < 16; ++i) oacc[d][i] = 0.f;
#define TILE_OF(j) ((j) < na ? ta0 + (j) : 256 + ((j) - na))
#define LDG(p) (*GPC(u32x4, p))
#define ATT_GLOAD(tile)                                                                                          \
  {                                                                                                              \
      \
    const long key0 = (long)(tile) * 64;                                                                         \
    const char* kp_ = reinterpret_cast<const char*>(Kb + key0 * ldk);                                            \
    if constexpr (DQK == 64) {                                                                                   \
      kreg0 = LDG(uptr(kp_) + kvo_a); kreg1 = LDG(uptr(kp_ + (long)64 * ldk) + kvo_a);                           \
    } else {                                                                                                     \
      kreg0 = LDG(uptr(kp_) + kvo_a); kreg1 = LDG(uptr(kp_ + (long)32 * ldk) + kvo_a);                           \
      kreg2 = LDG(uptr(kp_ + (long)64 * ldk) + kvo_a); kreg3 = LDG(uptr(kp_ + (long)96 * ldk) + kvo_a);          \
      const char* k2_ = reinterpret_cast<const char*>(K2 + key0 * 64);                                           \
      kreg4 = LDG(uptr(k2_) + kvo_b); kreg5 = LDG(uptr(k2_ + 32 * 64 * 2) + kvo_b);                              \
    }                                                                                                            \
    const char* vp_ = reinterpret_cast<const char*>(Vp + key0);                                                  \
    vreg0 = LDG(uptr(vp_) + vvo); vreg1 = LDG(uptr(vp_ + (long)64 * MB) + vvo);                                  \
    if constexpr (DV == 128) { vreg2 = LDG(uptr(vp_ + (long)128 * MB) + vvo); vreg3 = LDG(uptr(vp_ + (long)192 * MB) + vvo); } \
  }
#define STV(sb, j, v) { *reinterpret_cast<u32x4*>((sb) + vso + (j) * 4096) = v; }
#define ATT_SSTORE(sb)                                                                                           \
  {                                                                                                              \
    if constexpr (DQK == 64) {                                                                                   \
      *reinterpret_cast<u32x4*>((sb) + kso_a) = kreg0; *reinterpret_cast<u32x4*>((sb) + kso_a + 4096) = kreg1;   \
    } else {                                                                                                     \
      *reinterpret_cast<u32x4*>((sb) + kso_a) = kreg0; *reinterpret_cast<u32x4*>((sb) + kso_a + 16 * 384) = kreg1; \
      *reinterpret_cast<u32x4*>((sb) + kso_a + 32 * 384) = kreg2; *reinterpret_cast<u32x4*>((sb) + kso_a + 48 * 384) = kreg3; \
      *reinterpret_cast<u32x4*>((sb) + kso_b) = kreg4; *reinterpret_cast<u32x4*>((sb) + kso_b + 32 * 384) = kreg5; \
    }                                                                                                            \
    STV(sb, 0, vreg0) STV(sb, 1, vreg1)                                                                          \
    if constexpr (DV == 128) { STV(sb, 2, vreg2) STV(sb, 3, vreg3) }                                             \
  }
    ATT_GLOAD(TILE_OF(0));
    ATT_SSTORE(lds);
    if constexpr (DB) { if (1 < NT) { ATT_GLOAD(TILE_OF(1)); } }
    __syncthreads();
    for (int j = 0; j < NT; ++j) {
      const int tile = TILE_OF(j);
      const char* sb = lds + (DB ? (j & 1) * STAGE : 0);
      constexpr int KD = 2, KRING = 3;
      bf16x8 kr0[KRING], kr1[KRING];
#define KFR(s_, slot_)                                                                          \
  {                                                                                             \
    const int co = ((2 * (s_) + h) ^ xr) << 4;                                                  \
    kr0[slot_] = *reinterpret_cast<const bf16x8*>(sb + r * (DQK * 2) + co);                     \
    kr1[slot_] = *reinterpret_cast<const bf16x8*>(sb + (32 + r) * (DQK * 2) + co);              \
  }
#pragma unroll
      for (int s = 0; s < KD; ++s) KFR(s, s)
      __builtin_amdgcn_sched_barrier(0);
      if constexpr (DB) {
        char* sn = lds + ((j + 1) & 1) * STAGE;
        if (j + 1 < NT) { ATT_SSTORE(sn); }
        if (j + 2 < NT) { ATT_GLOAD(TILE_OF(j + 2)); }
      } else {
        if (j + 1 < NT) { ATT_GLOAD(TILE_OF(j + 1)); }
      }
      f32x16 s0, s1;
#pragma unroll
      for (int i = 0; i < 16; ++i) { s0[i] = 0.f; s1[i] = 0.f; }
      {
#pragma unroll
        for (int s = 0; s < NS; ++s) {
          if (s + KD < NS) KFR(s + KD, (s + KD) % KRING)
          bf16x8 qs;
          if constexpr (NS > NQR) { if (s < NQR) qs = qf[s < NQR ? s : 0]; else qs = *reinterpret_cast<const bf16x8*>(qpark + (s - NQR) * 4096); }
          else qs = qf[s];
          s0 = MFMA(kr0[s % KRING], qs, s0);
          s1 = MFMA(kr1[s % KRING], qs, s1);
          __builtin_amdgcn_sched_barrier(0);
        }
#undef KFR
      }
      const char* vb0 = sb + VOFF + r * 128;
#define VFRAG(d, B) (*reinterpret_cast<const bf16x8*>(vb0 + (d) * 4096 + (((2 * (B) + h) ^ xr) << 4)))
      constexpr int VD = 3;
      bf16x8 vr[8];
#pragma unroll
      for (int g = 0; g < VD; ++g) vr[g] = VFRAG(g >> 2, g & 3);
      if (TYPE == 2 && latent && j < na) {
        const int kb0 = tile * 64 - qrow;
#pragma unroll
        for (int i = 0; i < 16; ++i) {
          const int d0 = kb0 + crow(i, h), d1 = d0 + 32;
          if (d0 > 128 || d0 < -128) s0[i] = -1e30f;
          if (d1 > 128 || d1 < -128) s1[i] = -1e30f;
        }
      }
      const float tm0 = vmax3w(s0[0], s0[1], s0[2], s1[0]);
      const float tm1 = vmax3d(s0[3], s0[4], s0[5], tm0), tm2 = vmax3d(s0[6], s0[7], s0[8], tm0), tm3 = vmax3d(s0[9], s0[10], s0[11], tm0);
      const float tm4 = vmax3d(s0[12], s0[13], s0[14], tm0);
      const float tm5 = vmax3d4(s1[0], s1[1], s1[2], tm1, tm2, tm3, tm4), tm6 = vmax3d(s1[3], s1[4], s1[5], tm5), tm7 = vmax3d(s1[6], s1[7], s1[8], tm5);
      const float tm8 = vmax3d(s1[9], s1[10], s1[11], tm5), tm9 = vmax3d(s1[12], s1[13], s1[14], tm5), tma = vmax3d(s0[15], s1[15], tm0, tm5), tmb = vmax3(tm1, tm2, tm3);
      const float tmc = vmax3(tm4, tm5, tm6), tmd = vmax3(tm7, tm8, tm9);
      float tmax = xhalf_max(vmax3(vmax3(tma, tmb, tmc), tmd, tmd));
      const float mnew = fmaxf(m_run, tmax);
      const float alpha = __builtin_amdgcn_exp2f((m_run - mnew) * C);
      m_run = mnew;
      const float mc = -mnew * C;
      float pa = 0.f, pb = 0.f, pc = 0.f, pd = 0.f;
#pragma unroll
      for (int i = 0; i < 16; i += 2) {
        s0[i] = __builtin_amdgcn_exp2f(fmaf(s0[i], C, mc)); pa += s0[i];
        s0[i + 1] = __builtin_amdgcn_exp2f(fmaf(s0[i + 1], C, mc)); pb += s0[i + 1];
      }
#pragma unroll
      for (int i = 0; i < 16; i += 2) {
        s1[i] = __builtin_amdgcn_exp2f(fmaf(s1[i], C, mc)); pc += s1[i];
        s1[i + 1] = __builtin_amdgcn_exp2f(fmaf(s1[i + 1], C, mc)); pd += s1[i + 1];
      }
      const float ps = xhalf_sum((pa + pb) + (pc + pd));
      l_run = l_run * alpha + ps;
      if (__any(alpha != 1.f)) {
#pragma unroll
        for (int d = 0; d < NDV; ++d)
#pragma unroll
          for (int i = 0; i < 16; ++i) oacc[d][i] *= alpha;
      }
      bf16x8 pf[4];
#pragma unroll
      for (int sp = 0; sp < 2; ++sp) {
        u32x4 w0, w1;
        w0.x = pk2(s0[8 * sp + 0], s0[8 * sp + 1]); w0.y = pk2(s0[8 * sp + 2], s0[8 * sp + 3]);
        w0.z = pk2(s0[8 * sp + 4], s0[8 * sp + 5]); w0.w = pk2(s0[8 * sp + 6], s0[8 * sp + 7]);
        w1.x = pk2(s1[8 * sp + 0], s1[8 * sp + 1]); w1.y = pk2(s1[8 * sp + 2], s1[8 * sp + 3]);
        w1.z = pk2(s1[8 * sp + 4], s1[8 * sp + 5]); w1.w = pk2(s1[8 * sp + 6], s1[8 * sp + 7]);
        pf[sp] = __builtin_bit_cast(bf16x8, w0);
        pf[2 + sp] = __builtin_bit_cast(bf16x8, w1);
      }
      {
#pragma unroll
        for (int f = 0; f < NDV * 4; ++f) {
          if (f + VD < NDV * 4) vr[(f + VD) & 7] = VFRAG((f + VD) >> 2, (f + VD) & 3);
          oacc[f >> 2] = MFMA(vr[f & 7], pf[f & 3], oacc[f >> 2]);
          __builtin_amdgcn_sched_barrier(0);
        }
#undef VFRAG
      }
      __syncthreads();
      if constexpr (!DB) {
        if (j + 1 < NT) { ATT_SSTORE(lds); }
        __syncthreads();
      }
    }
#undef ATT_GLOAD
#undef ATT_SSTORE
#undef STV
#undef LDG
#undef TILE_OF
    const float il = 1.f / l_run;
    if (TYPE == 0 && map == 0) {
#pragma unroll
      for (int d = 0; d < NDV; ++d) {
        f32x16 o;
#pragma unroll
        for (int i = 0; i < 16; ++i) o[i] = oacc[d][i] * il;
        st_bf16_tile(o, ya_dst + d * 32, h);
      }
    } else if (TYPE == 0) {
      const float lam = reinterpret_cast<const float*>(ws + O_LAM)[layer];
      float ss = 0.f;
#pragma unroll
      for (int d = 0; d < NDV; ++d) {
#pragma unroll
        for (int q = 0; q < 4; ++q) {
          const u32x2 w = *GPC(u32x2, ya_dst + d * 32 + 8 * q + 4 * h);
          const float v0 = bflo(w.x) - lam * (oacc[d][4 * q + 0] * il), v1 = bfhi(w.x) - lam * (oacc[d][4 * q + 1] * il);
          const float v2 = bflo(w.y) - lam * (oacc[d][4 * q + 2] * il), v3 = bfhi(w.y) - lam * (oacc[d][4 * q + 3] * il);
          oacc[d][4 * q + 0] = v0; oacc[d][4 * q + 1] = v1; oacc[d][4 * q + 2] = v2; oacc[d][4 * q + 3] = v3;
          ss += v0 * v0 + v1 * v1 + v2 * v2 + v3 * v3;
        }
      }
      ss = xhalf_sum(ss);
      const float rr = rsqrtf(ss * (1.f / 128.f) + EPS) * (1.f - P.linit[layer]);
      const float* sg = P.in[11] + layer * 128;
#pragma unroll
      for (int d = 0; d < NDV; ++d) {
        f32x16 o;
#pragma unroll
        for (int q = 0; q < 4; ++q) {
          const f32x4 g4 = *GPC(f32x4, sg + d * 32 + 8 * q + 4 * h);
          o[4 * q] = oacc[d][4 * q] * rr * g4.x; o[4 * q + 1] = oacc[d][4 * q + 1] * rr * g4.y;
          o[4 * q + 2] = oacc[d][4 * q + 2] * rr * g4.z; o[4 * q + 3] = oacc[d][4 * q + 3] * rr * g4.w;
        }
        st_bf16_tile(o, ya_dst + d * 32, h);
      }
    } else {
      u16* dst = TYPE == 1 ? reinterpret_cast<u16*>(ws + O_YA + 2 * SZ1) + (long)qrow * 1024 + head * 128
                           : reinterpret_cast<u16*>(ws + O_YA + SZ1) + (long)qrow * 1024 + head * 64;
#pragma unroll
      for (int d = 0; d < NDV; ++d) {
        f32x16 o;
#pragma unroll
        for (int i = 0; i < 16; ++i) o[i] = oacc[d][i] * il;
        st_bf16_tile(o, dst + d * 32, h);
      }
    }
  }
  __syncthreads();
}

DI void attn_phase(int layer, const Params& P, char* lds) {
  const int NITEMS = layer + 1 < DEPTH ? 4096 + 64 : 4096;
  for (int w = blockIdx.x; w < NITEMS; w += gridDim.x) {
    if (w < 1024) attn_item<64, 128, 0>(layer, w >> 3, w & 7, lds, P);
    else if (w < 2048) attn_item<192, 128, 1>(layer, (w - 1024) >> 3, w & 7, lds, P);
    else if (w < 4096) attn_item<64, 64, 2>(layer, (w - 2048) >> 4, w & 15, lds, P);
    else if (w < 4112) attn_item<64, 128, 0>(layer, 128 + ((w - 4096) >> 3), w & 7, lds, P);
    else if (w < 4128) attn_item<192, 128, 1>(layer, 128 + ((w - 4112) >> 3), w & 7, lds, P);
    else attn_item<64, 64, 2>(layer, 128 + ((w - 4128) >> 4), w & 15, lds, P);
  }
}

DI void conv_tile(const float* __restrict__ src, int K, int N, u16* __restrict__ dst, int tile, int perm, char* lds) {
  float* sm = reinterpret_cast<float*>(lds);
  const int tid = otid();
  const int nts = N >> 6;
  const int kt = tile / nts, ntile = tile - kt * nts;
  const int k0 = kt * 64, n0 = ntile * 64;
#pragma unroll
  for (int j = 0; j < 16; ++j) {
    const int k = j * 4 + (tid >> 6), n = tid & 63;
    sm[k * 65 + n] = src[(long)(k0 + k) * N + n0 + n];
  }
  __syncthreads();
#pragma unroll
  for (int j = 0; j < 2; ++j) {
    const int n = (tid >> 3) + 32 * j, kc = tid & 7;
    float v[8];
#pragma unroll
    for (int e = 0; e < 8; ++e) v[e] = sm[(kc * 8 + e) * 65 + n];
    int nn = n0 + n;
    if (perm) { const int s = nn >= FFN ? 1 : 0; const int jj = nn - s * FFN; nn = 64 * (jj >> 5) + 32 * s + (jj & 31); }
    u32x4 o; o.x = pk2(v[0], v[1]); o.y = pk2(v[2], v[3]); o.z = pk2(v[4], v[5]); o.w = pk2(v[6], v[7]);
    *GP(u32x4, dst + (long)nn * K + k0 + kc * 8) = o;
  }
  __syncthreads();
}

constexpr int CONV_TILES = 7616;
DI void conv_phase(int layer, const Params& P, char* lds, int extra_first) {
  char* ws = ows(P);
  for (int t = blockIdx.x + extra_first; t < CONV_TILES + extra_first; t += gridDim.x) {
    int x = t - extra_first;
    const float* src; int K, N, perm = 0; u16* dst;
    if (x < 2816) { const int s = x / 1408; x -= s * 1408; src = P.in[7] + ((long)(layer * 2 + s)) * DM * 2 * FFN; K = DM; N = 2 * FFN; perm = 1; dst = reinterpret_cast<u16*>(ws + O_WIN + s * SZ_WIN); }
    else if (x < 4224) { x -= 2816; const int s = x / 704; x -= s * 704; src = P.in[8] + ((long)(layer * 2 + s)) * FFN * DM; K = FFN; N = DM; dst = reinterpret_cast<u16*>(ws + O_WOUT + s * SZ_WOUT); }
    else if (x < 6320) { x -= 4224; src = P.in[9] + (long)layer * DM * MIXIN; K = DM; N = MIXIN; dst = reinterpret_cast<u16*>(ws + O_WMIX); }
    else if (x < 6464) { x -= 6320; src = P.in[15] + (long)layer * 384 * 1536; K = 384; N = 1536; dst = reinterpret_cast<u16*>(ws + O_WUQ); }
    else if (x < 6592) { x -= 6464; src = P.in[16] + (long)layer * 256 * 2048; K = 256; N = 2048; dst = reinterpret_cast<u16*>(ws + O_WUKV); }
    else if (x < 7360) { x -= 6592; const int br = x / 256; x -= br * 256; src = P.in[17] + ((long)(layer * 3 + br)) * DM * DM; K = DM; N = DM; dst = reinterpret_cast<u16*>(ws + O_WBR) + (long)br * DM * DM; }
    else { x -= 7360; src = P.in[18] + (long)layer * DM * DM; K = DM; N = DM; dst = reinterpret_cast<u16*>(ws + O_WMO); }
    conv_tile(src, K, N, dst, x, perm, lds);
  }
}

DI void mods_item(int item, const Params& P, char* lds) {
  float* sv = reinterpret_cast<float*>(lds);
  float* red = sv + 3 * 1024;
  const int tid = otid();
  const int l = item / 144, nb = item - l * 144;
  for (int e = tid; e < 3 * 1024; e += 256) {
    const int v = e >> 10, k = e & 1023;
    const float x = v < 2 ? P.in[1][v * DM + k] : P.in[3][k];
    sv[e] = x / (1.f + __expf(-x));
  }
  __syncthreads();
  const int c = tid & 63, kg = tid >> 6;
  const float* w = P.in[4] + (long)l * DM * 9216 + nb * 64 + c;
  float a0 = 0.f, a1 = 0.f, a2 = 0.f;
  for (int k = kg * 256; k < kg * 256 + 256; ++k) {
    const float wv = w[(long)k * 9216];
    a0 += sv[k] * wv; a1 += sv[1024 + k] * wv; a2 += sv[2048 + k] * wv;
  }
  red[(kg * 3 + 0) * 64 + c] = a0; red[(kg * 3 + 1) * 64 + c] = a1; red[(kg * 3 + 2) * 64 + c] = a2;
  __syncthreads();
  if (tid < 192) {
    const int v = tid >> 6, cc = tid & 63;
    float s = red[(0 * 3 + v) * 64 + cc] + red[(1 * 3 + v) * 64 + cc] + red[(2 * 3 + v) * 64 + cc] + red[(3 * 3 + v) * 64 + cc];
    const int n = nb * 64 + cc;
    reinterpret_cast<float*>(ows(P) + O_MODS)[(l * 3 + v) * 9216 + n] = s + P.in[5][l * 9216 + n];
  }
  __syncthreads();
}

DI void misc_item(const Params& P) {
  const int tid = otid();
  float* rope = reinterpret_cast<float*>(ows(P) + O_ROPE);
  for (int e = tid; e < 256 * 16; e += 256) {
    const int p = e >> 4, j = e & 15;
    const float ang = (float)p * P.inv_freq[j];
    double a = (double)ang;
    const double TWO_PI = 6.283185307179586476925;
    a -= TWO_PI * rint(a / TWO_PI);
    const double q = a * 0.25, q2 = q * q;
    double sn = q * (1.0 + q2 * (-1.0 / 6 + q2 * (1.0 / 120 + q2 * (-1.0 / 5040 + q2 * (1.0 / 362880 + q2 * (-1.0 / 39916800 + q2 * (1.0 / 6227020800.0)))))));
    double cs = 1.0 + q2 * (-0.5 + q2 * (1.0 / 24 + q2 * (-1.0 / 720 + q2 * (1.0 / 40320 + q2 * (-1.0 / 3628800 + q2 * (1.0 / 479001600.0 + q2 * (-1.0 / 87178291200.0)))))));
    double s2 = 2 * sn * cs, c2 = cs * cs - sn * sn;
    double s4 = 2 * s2 * c2, c4 = c2 * c2 - s2 * s2;
    rope[e] = (float)c4;
    rope[256 * 16 + e] = (float)s4;
  }
  if (tid < DEPTH) {
    const float* dl = P.in[10] + tid * 4 * 64;
    float d01 = 0.f, d23 = 0.f;
    for (int i = 0; i < 64; ++i) { d01 += dl[i] * dl[64 + i]; d23 += dl[128 + i] * dl[192 + i]; }
    reinterpret_cast<float*>(ows(P) + O_LAM)[tid] = expf(d01) - expf(d23) + P.linit[tid];
  }
}

#define XB_TMO      128
#define XB_XCNT(j)  (256  + 64 * (j))
#define XB_XSUB(j)  (1280 + 64 * (j))
#define XB_XGEN(j)  (2304 + 64 * (j))
#define XB_TOP      3328
#define XB_TOPGEN   3392
#define XCD_BAR_WORDS 3456
#define XB_SPIN_CAP (1u << 18)
#define LAS __attribute__((address_space(3)))
DI unsigned xb_ld(unsigned* p) { return __hip_atomic_load(p, __ATOMIC_RELAXED, __HIP_MEMORY_SCOPE_AGENT); }
DI unsigned xb_add(unsigned* p, unsigned v) { return __hip_atomic_fetch_add(p, v, __ATOMIC_RELAXED, __HIP_MEMORY_SCOPE_AGENT); }
DI unsigned xb_xcc_id() { return (unsigned)__builtin_amdgcn_s_getreg((3 << 11) | 20) & 0xFu; }
#define XB_SPIN(cond, bar) do { unsigned _sp = 0; while (cond) { __builtin_amdgcn_s_sleep(1); \
    if ((++_sp & 255u) == 0u) { if (xb_ld(&(bar)[XB_TMO])) break; if (_sp > XB_SPIN_CAP) { atomicAdd(&(bar)[XB_TMO], 1u); break; } } } } while (0)
struct XcdBarrier { unsigned* bar; unsigned x; volatile LAS unsigned* st; };
DI XcdBarrier xcd_barrier_post(unsigned* bar, volatile LAS unsigned* st) {
  XcdBarrier b; b.bar = bar; b.x = xb_xcc_id(); b.st = st;
  if (threadIdx.x == 0) (void)xb_add(&bar[XB_XCNT(b.x)], 1u);
  return b;
}
DI void xcd_barrier_complete(unsigned* bar, unsigned x, unsigned& nloc, unsigned& nx) {
  const unsigned G = gridDim.x * gridDim.y * gridDim.z;
  unsigned sum, cnt, mine, sp = 0u;
  for (;;) {
    sum = 0u; cnt = 0u; mine = 0u;
#pragma unroll
    for (unsigned j = 0; j < 16; ++j) { const unsigned c = xb_ld(&bar[XB_XCNT(j)]); sum += c; cnt += (c > 0u) ? 1u : 0u; mine = (j == x) ? c : mine; }
    if (sum == G) break;
    __builtin_amdgcn_s_sleep(1);
    if ((++sp & 255u) == 0u) { if (xb_ld(&bar[XB_TMO])) break; if (sp > XB_SPIN_CAP) { atomicAdd(&bar[XB_TMO], 1u); break; } }
  }
  nloc = mine > 0u ? mine : 1u; nx = cnt > 0u ? cnt : 1u;
}
DI void xcd_barrier(const XcdBarrier& b) {
  asm volatile("s_waitcnt vmcnt(0)" ::: "memory");
  __syncthreads();
  if (threadIdx.x == 0) {
    unsigned* bar = b.bar;
    __builtin_amdgcn_s_waitcnt(0);
    unsigned nloc = b.st[0], nx = b.st[1];
    if (nloc == 0u) { xcd_barrier_complete(bar, b.x, nloc, nx); b.st[0] = nloc; b.st[1] = nx; }
    const unsigned old = xb_add(&bar[XB_XSUB(b.x)], 1u);
    const unsigned gen = old / nloc;
    if (old + 1u == (gen + 1u) * nloc) {
      __builtin_amdgcn_fence(__ATOMIC_RELEASE, "agent");
      asm volatile("s_waitcnt vmcnt(0)" ::: "memory");
      const unsigned og = xb_add(&bar[XB_TOP], 1u);
      const unsigned tg = og / nx;
      if (og + 1u == (tg + 1u) * nx) xb_add(&bar[XB_TOPGEN], 1u);
      else XB_SPIN(xb_ld(&bar[XB_TOPGEN]) == tg, bar);
      __builtin_amdgcn_fence(__ATOMIC_ACQUIRE, "agent");
      xb_add(&bar[XB_XGEN(b.x)], 1u);
      asm volatile("s_waitcnt vmcnt(0)" ::: "memory");
    } else {
      XB_SPIN(xb_ld(&bar[XB_XGEN(b.x)]) == gen, bar);
      __builtin_amdgcn_fence(__ATOMIC_ACQUIRE, "agent");
      asm volatile("s_waitcnt vmcnt(0)" ::: "memory");
    }
  }
  __syncthreads();
}

constexpr size_t LDS_BYTES = 65536 + 64;
constexpr int NPL = 23;
constexpr int NPH = 1 + DEPTH * NPL;

__global__ void __launch_bounds__(256, 2) fwd_megakernel(Params P) {
  extern __shared__ __attribute__((aligned(16))) char lds[];
  cg::grid_group grid = cg::this_grid();
  volatile LAS unsigned* xst = (volatile LAS unsigned*)(lds + 65536);
  if (threadIdx.x == 0) { xst[0] = 0u; xst[1] = 0u; }
  __syncthreads();
  const XcdBarrier xb = xcd_barrier_post(reinterpret_cast<unsigned*>(P.ws + O_BAR), xst);
  char* ws = P.ws;
  u16* U = reinterpret_cast<u16*>(ws + O_U);
  float* tctx = reinterpret_cast<float*>(ws + O_TCTX);
  for (int ph = 0; ph < NPH; ++ph) {
    int kind = 0;
    GemmDesc gd; RowDesc rd;
    gd.skipctx = 0; gd.epi = 0; gd.mtiles = 0; gd.ntiles = 0; gd.K = 0; gd.lda = 0; gd.A = nullptr; gd.W = nullptr; gd.dst = nullptr;
    rd.skipctx = 0; rd.g0 = 0; rd.g1 = 0; rd.told_lat = P.out; rd.told_ctx = tctx; rd.ybuf = nullptr; rd.yrow0 = 0; rd.gscale = 1.f;
    rd.gate_idx = 0; rd.gpost_idx = 0; rd.layer = 0; rd.has_u = 0; rd.ulayer = 0; rd.gpre_idx = 0; rd.shift_idx = 0; rd.scale_idx = 0;
    int layer = 0, conv_layer = -1;
    if (ph == 0) {
      for (int t = blockIdx.x; t < 289; t += gridDim.x) { if (t < 288) mods_item(t, P, lds); else misc_item(P); }
      conv_phase(0, P, lds, 0);
    } else {
      layer = (ph - 1) / NPL;
      const int q = (ph - 1) - layer * NPL;
      const bool first = layer == 0;
      if (q == 0) {
        if (first) { kind = 2; rd.g0 = 0; rd.g1 = MT; rd.told_lat = P.in[0]; rd.told_ctx = P.in[2]; rd.has_u = 1; rd.ulayer = 0; rd.gpre_idx = 0; rd.shift_idx = 0; rd.scale_idx = 1; }
        else kind = -1;
      } else if (q == 1 || q == 20) {
        const int s = q == 1 ? 0 : 1;
        kind = 1; gd.epi = EPI_SWIGLU; gd.mtiles = MT / 128;
        if (s == 1 && layer + 1 == DEPTH) { gd.mtiles = 256; gd.skipctx = 1; } gd.ntiles = 44; gd.K = DM; gd.lda = DM; gd.A = U;
        gd.W = reinterpret_cast<const u16*>(ws + O_WIN + s * SZ_WIN); gd.dst = ws + O_ACT;
      } else if (q == 2 || q == 21) {
        const int s = q == 2 ? 0 : 1;
        kind = 1; gd.epi = EPI_YF32; gd.mtiles = MT / 128;
        if (s == 1 && layer + 1 == DEPTH) { gd.mtiles = 256; gd.skipctx = 1; } gd.ntiles = 8; gd.K = FFN; gd.lda = FFN; gd.A = reinterpret_cast<const u16*>(ws + O_ACT);
        gd.W = reinterpret_cast<const u16*>(ws + O_WOUT + s * SZ_WOUT); gd.dst = ws + O_Y;
      } else if (q == 3) {
        kind = 2; rd.g0 = 0; rd.g1 = MT;
        if (first) { rd.told_lat = P.in[0]; rd.told_ctx = P.in[2]; }
        rd.ybuf = reinterpret_cast<const float*>(ws + O_Y); rd.yrow0 = 0; rd.gscale = 0.5f; rd.gate_idx = 2; rd.gpost_idx = 1; rd.layer = layer;
        rd.has_u = 1; rd.ulayer = layer; rd.gpre_idx = 2; rd.shift_idx = 3; rd.scale_idx = 4;
      } else if (q < 20) {
        const int b = (q - 4) >> 3, qq = (q - 4) & 7;
        const u16* Ub = U + (long)b * MB * DM;
        const int mtq = layer + 1 == DEPTH ? 128 : 130;
        if (qq == 0) { kind = 1; gd.epi = EPI_PROJ; gd.mtiles = 130; gd.ntiles = 42; gd.K = DM; gd.lda = DM; gd.A = Ub; gd.W = reinterpret_cast<const u16*>(ws + O_WMIX); }
        else if (qq == 1) { kind = 3; }
        else if (qq == 2) { kind = 1; gd.epi = EPI_UQKV; gd.mtiles = 130; gd.ntiles = 28; }
        else if (qq == 3) { kind = 4; }
        else if (qq == 4) { kind = 1; gd.epi = EPI_SG; gd.mtiles = mtq; gd.ntiles = 24; gd.K = DM; gd.lda = DM; gd.A = Ub; gd.W = reinterpret_cast<const u16*>(ws + O_WMIX) + (long)NPROJ * DM; gd.dst = ws + O_SG; }
        else if (qq == 5) { kind = 5; gd.epi = EPI_MERGE; gd.mtiles = mtq; gd.ntiles = 8; gd.K = DM; gd.lda = DM; gd.A = reinterpret_cast<const u16*>(ws + O_YA); gd.W = reinterpret_cast<const u16*>(ws + O_WBR); gd.dst = ws + O_MERGED; }
        else if (qq == 6) { kind = 1; gd.epi = EPI_YF32; gd.mtiles = mtq; gd.ntiles = 8; gd.K = DM; gd.lda = DM; gd.A = reinterpret_cast<const u16*>(ws + O_MERGED); gd.W = reinterpret_cast<const u16*>(ws + O_WMO); gd.dst = ws + O_YO; }
        else {
          kind = 2; rd.g0 = b * MB; rd.g1 = (b + 1) * MB; rd.skipctx = layer + 1 == DEPTH; rd.ybuf = reinterpret_cast<const float*>(ws + O_YO); rd.yrow0 = b * MB; rd.gscale = 1.f;
          rd.gate_idx = 5; rd.gpost_idx = 3; rd.layer = layer; rd.has_u = 1; rd.ulayer = layer; rd.gpre_idx = 4; rd.shift_idx = 6; rd.scale_idx = 7;
        }
      } else {
        kind = 2; rd.g0 = 0; rd.g1 = MT; rd.skipctx = layer + 1 == DEPTH; rd.ybuf = reinterpret_cast<const float*>(ws + O_Y); rd.yrow0 = 0; rd.gscale = 0.5f; rd.gate_idx = 8; rd.gpost_idx = 5; rd.layer = layer;
        if (layer + 1 < DEPTH) { rd.has_u = 1; rd.ulayer = layer + 1; rd.gpre_idx = 0; rd.shift_idx = 0; rd.scale_idx = 1; conv_layer = layer + 1; }
      }
    }
    if (kind == 1) gemm_phase<false>(gd, P, lds);
    else if (kind == 5) gemm_phase<true>(gd, P, lds);
    else if (kind == 2) rowop_phase(rd, P);
    else if (kind == 3) r3_phase(layer, P);
    else if (kind == 4) attn_phase(layer, P, lds);
    if (conv_layer >= 0) conv_phase(conv_layer, P, lds, 0);
    if (kind != -1 && ph + 1 < NPH) {
      if (P.pad[0] == 0x7fffffff) grid.sync();
      xcd_barrier(xb);
    }
  }
}

extern "C" void kernel_launch(void* const* d_in, const int* in_sizes, int n_in, void* d_out, int out_size, void* d_ws, size_t ws_size,
                              hipStream_t stream) {
  static int grid_blocks = 0;
  if (!grid_blocks) {
    int dev = 0, cus = 0, per_cu = 0;
    (void)hipGetDevice(&dev);
    (void)hipDeviceGetAttribute(&cus, hipDeviceAttributeMultiprocessorCount, dev);
    (void)hipFuncSetAttribute((const void*)fwd_megakernel, hipFuncAttributeMaxDynamicSharedMemorySize, (int)LDS_BYTES);
    (void)hipOccupancyMaxActiveBlocksPerMultiprocessor(&per_cu, fwd_megakernel, 256, LDS_BYTES);
    if (per_cu > 2) per_cu = 2;
    if (per_cu < 1) per_cu = 1;
    grid_blocks = cus * per_cu;
    fprintf(stderr, "megakernel: cus %d per_cu %d grid %d ws_need %zu ws_size %zu\n", cus, per_cu, grid_blocks, (size_t)WS_NEED, ws_size);
  }
  if (n_in != 19 || ws_size < WS_NEED) {
    fprintf(stderr, "kernel_launch: bad setup n_in %d ws_size %zu need %zu\n", n_in, ws_size, (size_t)WS_NEED);
    return;
  }
  Params p{};
  for (int i = 0; i < 19; ++i) p.in[i] = reinterpret_cast<const float*>(d_in[i]);
  p.out = reinterpret_cast<float*>(d_out);
  p.ws = reinterpret_cast<char*>(d_ws);
  for (int j = 0; j < 16; ++j) p.inv_freq[j] = 1.0f / powf(10000.0f, (float)j / 16.0f);
  for (int l = 0; l < DEPTH; ++l) p.linit[l] = (float)(0.8 - 0.6 * exp(-0.3 * (double)l));
  (void)hipMemsetAsync(reinterpret_cast<char*>(d_ws) + O_BAR, 0, XCD_BAR_WORDS * 4, stream);
  void* args[] = {&p};
  hipError_t e = hipLaunchCooperativeKernel((void*)fwd_megakernel, dim3(grid_blocks), dim3(256), args, LDS_BYTES, stream);
  if (e != hipSuccess) fprintf(stderr, "cooperative launch failed: %s (grid %d)\n", hipGetErrorString(e), grid_blocks);
}
```

```cpp
#include <hip/hip_runtime.h>
#include <hip/hip_cooperative_groups.h>
#include <cstdio>
#include <cstdint>
#include <cmath>
namespace cg = cooperative_groups;

typedef unsigned short u16;
using bf16x8 = __attribute__((ext_vector_type(8))) short;
using f32x16 = __attribute__((ext_vector_type(16))) float;
using u32x4 = __attribute__((ext_vector_type(4))) unsigned;
using u32x2 = __attribute__((ext_vector_type(2))) unsigned;
using f32x4 = __attribute__((ext_vector_type(4))) float;
#define GAS __attribute__((address_space(1)))
#define GP(T, p) (reinterpret_cast<GAS T*>(reinterpret_cast<uintptr_t>(p)))
#define GPC(T, p) (reinterpret_cast<const GAS T*>(reinterpret_cast<uintptr_t>(p)))
typedef __bf16 bf2_t __attribute__((ext_vector_type(2)));
typedef float f2_t __attribute__((ext_vector_type(2)));
#define DI __device__ __forceinline__
#define MFMA(a, b, c) __builtin_amdgcn_mfma_f32_32x32x16_bf16((a), (b), (c), 0, 0, 0)

constexpr int DM = 1024, NB = 2, SEQ = 16384, CTX = 256, DEPTH = 2;
constexpr int MB = SEQ + CTX;
constexpr int MT = NB * MB;
constexpr int FFN = 2816;
constexpr int MIXIN = 8384, NPROJ = 5312;
constexpr float EPS = 1e-6f;
constexpr float LOG2E = 1.4426950408889634f;

constexpr size_t SZ_WIN = (size_t)2 * FFN * DM * 2;
constexpr size_t SZ_WOUT = (size_t)DM * FFN * 2;
constexpr size_t O_WIN = 0;
constexpr size_t O_WOUT = O_WIN + 2 * SZ_WIN;
constexpr size_t O_WMIX = O_WOUT + 2 * SZ_WOUT;
constexpr size_t O_WUQ = O_WMIX + (size_t)MIXIN * DM * 2;
constexpr size_t O_WUKV = O_WUQ + (size_t)1536 * 384 * 2;
constexpr size_t O_WBR = O_WUKV + (size_t)2048 * 256 * 2;
constexpr size_t O_WMO = O_WBR + (size_t)3 * DM * DM * 2;
constexpr size_t O_MODS = O_WMO + (size_t)DM * DM * 2;
constexpr size_t O_ROPE = O_MODS + (size_t)DEPTH * 3 * 9216 * 4;
constexpr size_t O_LAM = O_ROPE + 2 * 256 * 16 * 4;
constexpr size_t O_BAR = O_LAM + 256;
constexpr size_t O_TCTX = O_BAR + 16384;
constexpr size_t O_U = O_TCTX + (size_t)NB * CTX * DM * 4;
constexpr size_t O_RX = O_U + (size_t)MT * DM * 2;
constexpr size_t O_ACT = O_RX;
constexpr size_t O_Y = O_ACT + (size_t)MT * FFN * 2;
constexpr size_t END_FFN = O_Y + (size_t)MT * DM * 4;
constexpr size_t SZ1 = (size_t)MB * DM * 2;
constexpr size_t SZQ = (size_t)MB * 256 * 2;
constexpr size_t O_QA = O_RX;
constexpr size_t O_KA = O_QA + SZ1;
constexpr size_t O_VAT = O_KA + SZ1;
constexpr size_t O_QB = O_VAT + SZ1;
constexpr size_t O_KB = O_QB + SZ1;
constexpr size_t O_VBT = O_KB + SZQ;
constexpr size_t O_CQ = O_VBT + SZQ;
constexpr size_t O_CKV = O_CQ + (size_t)MB * 384 * 2;
constexpr size_t O_KR = O_CKV + SZQ;
constexpr size_t O_QC = O_KR + (size_t)MB * 64 * 2;
constexpr size_t O_KCN = O_QC + (size_t)MB * 1536 * 2;
constexpr size_t O_VCT = O_KCN + SZ1;
constexpr size_t O_YA = O_VCT + SZ1;
constexpr size_t END_MIX = O_YA + 3 * SZ1;
constexpr size_t O_SG = O_QA;
constexpr size_t O_MERGED = O_QB;
constexpr size_t O_YO = O_KCN;
constexpr size_t WS_NEED = END_MIX > END_FFN ? END_MIX : END_FFN;

struct Params {
  const float* in[19];
  float* out;
  char* ws;
  float inv_freq[16];
  float linit[2];
  int pad[2];
};

DI int otid() { int t = threadIdx.x; asm volatile("" : "+v"(t)); return t; }
DI char* ows(const Params& P) {
  const unsigned long long w = reinterpret_cast<unsigned long long>(P.ws);
  unsigned lo = __builtin_amdgcn_readfirstlane((unsigned)w), hi = __builtin_amdgcn_readfirstlane((unsigned)(w >> 32));
  asm volatile("" : "+s"(lo), "+s"(hi));
  return reinterpret_cast<char*>(((unsigned long long)hi << 32) | lo);
}
DI const char* uptr(const void* p) {
  const unsigned long long w = reinterpret_cast<unsigned long long>(p);
  const unsigned lo = __builtin_amdgcn_readfirstlane((unsigned)w), hi = __builtin_amdgcn_readfirstlane((unsigned)(w >> 32));
  return reinterpret_cast<const char*>(((unsigned long long)hi << 32) | lo);
}
DI int crow(int i, int h) { return (i & 3) + 8 * (i >> 2) + 4 * h; }
DI unsigned pk2(float a, float b) { f2_t v = {a, b}; bf2_t r = __builtin_convertvector(v, bf2_t); return __builtin_bit_cast(unsigned, r); }
DI float bflo(unsigned x) { return __uint_as_float(x << 16); }
DI float bfhi(unsigned x) { return __uint_as_float(x & 0xffff0000u); }
DI float wave_sum(float v) {
#pragma unroll
  for (int o = 32; o > 0; o >>= 1) v += __shfl_xor(v, o);
  return v;
}
DI float xhalf_max(float v) {
  auto rr = __builtin_amdgcn_permlane32_swap(__float_as_uint(v), __float_as_uint(v), false, false);
  return fmaxf(__uint_as_float(rr[0]), __uint_as_float(rr[1]));
}
DI float xhalf_sum(float v) {
  auto rr = __builtin_amdgcn_permlane32_swap(__float_as_uint(v), __float_as_uint(v), false, false);
  return __uint_as_float(rr[0]) + __uint_as_float(rr[1]);
}
DI float vmax3(float a, float b, float c) { float r; asm("v_max3_f32 %0, %1, %2, %3" : "=v"(r) : "v"(a), "v"(b), "v"(c)); return r; }
DI float vmax3w(float a, float b, float c, float dep) { float r; asm volatile("s_nop 15\n\tv_max3_f32 %0, %1, %2, %3" : "=v"(r) : "v"(a), "v"(b), "v"(c), "v"(dep)); return r; }
DI float vmax3d4(float a, float b, float c, float d1, float d2, float d3, float d4) { float r; asm("v_max3_f32 %0, %1, %2, %3" : "=v"(r) : "v"(a), "v"(b), "v"(c), "v"(d1), "v"(d2), "v"(d3), "v"(d4)); return r; }
DI float vmax3d(float a, float b, float c, float dep) { float r; asm("v_max3_f32 %0, %1, %2, %3" : "=v"(r) : "v"(a), "v"(b), "v"(c), "v"(dep)); return r; }
DI float sigmoidf_(float x) { return __builtin_amdgcn_rcpf(1.f + __builtin_amdgcn_exp2f(-LOG2E * x)); }
DI void st_bf16_tile(const f32x16& c, u16* dst, int h) {
#pragma unroll
  for (int q = 0; q < 4; ++q) {
    u32x2 v; v.x = pk2(c[4 * q], c[4 * q + 1]); v.y = pk2(c[4 * q + 2], c[4 * q + 3]);
    *GP(u32x2, dst + 8 * q + 4 * h) = v;
  }
}
DI void st_bf16_tile_vt(const f32x16& c, u16* dst, int h) {
#pragma unroll
  for (int q = 0; q < 4; ++q) {
    u32x2 v; v.x = pk2(c[4 * q], c[4 * q + 1]); v.y = pk2(c[4 * q + 2], c[4 * q + 3]);
    *GP(u32x2, dst + 16 * (q >> 1) + 8 * h + 4 * (q & 1)) = v;
  }
}
DI void st_f32_tile(const f32x16& c, float* dst, int h) {
#pragma unroll
  for (int q = 0; q < 4; ++q) {
    f32x4 v = {c[4 * q], c[4 * q + 1], c[4 * q + 2], c[4 * q + 3]};
    *GP(f32x4, dst + 8 * q + 4 * h) = v;
  }
}
DI void rope_tile(f32x16& c, const float* __restrict__ rope, int idx, int h) {
  const float* cp = rope + idx * 16 + 4 * h;
  const float* sp = cp + 256 * 16;
  const f32x4 c0 = *GPC(f32x4, cp), c1 = *GPC(f32x4, cp + 8);
  const f32x4 s0 = *GPC(f32x4, sp), s1 = *GPC(f32x4, sp + 8);
#define ROPE1(i, CS, SN) { const float x1 = c[i], x2 = c[(i) + 8]; c[i] = x1 * (CS) - x2 * (SN); c[(i) + 8] = x2 * (CS) + x1 * (SN); }
  ROPE1(0, c0.x, s0.x) ROPE1(1, c0.y, s0.y) ROPE1(2, c0.z, s0.z) ROPE1(3, c0.w, s0.w)
  ROPE1(4, c1.x, s1.x) ROPE1(5, c1.y, s1.y) ROPE1(6, c1.z, s1.z) ROPE1(7, c1.w, s1.w)
#undef ROPE1
}

template <bool TRANS>
DI void gemm_kloop(const u16* __restrict__ A, int lda, const u16* __restrict__ W, int ldw, int K, f32x16 (&acc)[2][2], char* lds) {
  const int tid = otid(), lane = tid & 63, wid = tid >> 6, r = lane & 31, h = lane >> 5;
  const int wm = wid >> 1, wn = wid & 1;
  const int lrow = tid >> 3, lkc = tid & 7;
  const unsigned voa = (unsigned)(lrow * lda + lkc * 8) * 2u, vob = (unsigned)(lrow * ldw + lkc * 8) * 2u;
  const char* Ab = reinterpret_cast<const char*>(A);
  const char* Wb = reinterpret_cast<const char*>(W);
  const int soff0 = lrow * 128 + ((lkc ^ ((lrow >> 1) & 7)) << 4);
  u32x4 ra0, ra1, ra2, ra3, rb0, rb1, rb2, rb3, rc0, rc1, rc2, rc3, rd0, rd1, rd2, rd3;
#define GLOAD(A0, A1, A2, A3, B0, B1, B2, B3, k0)                                \
  {                                                                              \
    const char* pa_ = Ab + (long)(k0) * 2;                                       \
    const char* pw_ = Wb + (long)(k0) * 2;                                       \
    A0 = *GPC(u32x4, pa_ + voa);                                                 \
    A1 = *GPC(u32x4, pa_ + (long)64 * lda + voa);                                \
    A2 = *GPC(u32x4, pa_ + (long)128 * lda + voa);                               \
    A3 = *GPC(u32x4, pa_ + (long)192 * lda + voa);                               \
    B0 = *GPC(u32x4, pw_ + vob);                                                 \
    B1 = *GPC(u32x4, pw_ + (long)64 * ldw + vob);                                \
    B2 = *GPC(u32x4, pw_ + (long)128 * ldw + vob);                               \
    B3 = *GPC(u32x4, pw_ + (long)192 * ldw + vob);                               \
  }
#define SSTORE(A0, A1, A2, A3, B0, B1, B2, B3, bufi)                             \
  {                                                                              \
    char* sb = lds + (bufi) * 32768 + soff0;                                     \
    *reinterpret_cast<u32x4*>(sb) = A0;                                          \
    *reinterpret_cast<u32x4*>(sb + 4096) = A1;                                   \
    *reinterpret_cast<u32x4*>(sb + 8192) = A2;                                   \
    *reinterpret_cast<u32x4*>(sb + 12288) = A3;                                  \
    *reinterpret_cast<u32x4*>(sb + 16384) = B0;                                  \
    *reinterpret_cast<u32x4*>(sb + 16384 + 4096) = B1;                           \
    *reinterpret_cast<u32x4*>(sb + 16384 + 8192) = B2;                           \
    *reinterpret_cast<u32x4*>(sb + 16384 + 12288) = B3;                          \
  }
#define SET0 ra0, ra1, ra2, ra3, rb0, rb1, rb2, rb3
#define SET1 rc0, rc1, rc2, rc3, rd0, rd1, rd2, rd3
#define GL(...) GLOAD(__VA_ARGS__)
#define SS(...) SSTORE(__VA_ARGS__)
  const int KT = K >> 6;
  const int xr = (r >> 1) & 7;
  const int aoff = (wm * 64 + r) * 128, boff = 16384 + (wn * 64 + r) * 128;
#define COMPUTE(bufi)                                                                                                              \
  {                                                                                                                                \
    const char* buf = lds + (bufi) * 32768;                                                                                        \
    bf16x8 a0n, a1n, b0n, b1n;                                                                                                     \
    {                                                                                                                              \
      const int co = (h ^ xr) << 4;                                                                                                \
      a0n = *reinterpret_cast<const bf16x8*>(buf + aoff + co); a1n = *reinterpret_cast<const bf16x8*>(buf + aoff + 4096 + co);     \
      b0n = *reinterpret_cast<const bf16x8*>(buf + boff + co); b1n = *reinterpret_cast<const bf16x8*>(buf + boff + 4096 + co);     \
    }                                                                                                                              \
    _Pragma("unroll") for (int s = 0; s < 4; ++s) {                                                                                \
      const bf16x8 a0 = a0n, a1 = a1n, b0 = b0n, b1 = b1n;                                                                         \
      if (s < 3) {                                                                                                                 \
        const int co = ((2 * (s + 1) + h) ^ xr) << 4;                                                                              \
        a0n = *reinterpret_cast<const bf16x8*>(buf + aoff + co); a1n = *reinterpret_cast<const bf16x8*>(buf + aoff + 4096 + co);   \
        b0n = *reinterpret_cast<const bf16x8*>(buf + boff + co); b1n = *reinterpret_cast<const bf16x8*>(buf + boff + 4096 + co);   \
      }                                                                                                                            \
      if (TRANS) {                                                                                                                 \
        acc[0][0] = MFMA(a0, b0, acc[0][0]); acc[0][1] = MFMA(a0, b1, acc[0][1]);                                                  \
        acc[1][0] = MFMA(a1, b0, acc[1][0]); acc[1][1] = MFMA(a1, b1, acc[1][1]);                                                  \
      } else {                                                                                                                     \
        acc[0][0] = MFMA(b0, a0, acc[0][0]); acc[0][1] = MFMA(b1, a0, acc[0][1]);                                                  \
        acc[1][0] = MFMA(b0, a1, acc[1][0]); acc[1][1] = MFMA(b1, a1, acc[1][1]);                                                  \
      }                                                                                                                            \
      __builtin_amdgcn_sched_barrier(0);                                                                                           \
    }                                                                                                                              \
  }
  GL(SET0, 0);
  SS(SET0, 0);
  GL(SET1, 64);
  __syncthreads();
  for (int kt = 0; kt < KT; kt += 2) {
    const bool m2 = kt + 2 < KT;
    if (m2) { GL(SET0, (kt + 2) * 64); }
    COMPUTE(0);
    SS(SET1, 1);
    __syncthreads();
    if (m2) { GL(SET1, (kt + 3) * 64); }
    COMPUTE(1);
    if (m2) { SS(SET0, 0); }
    __syncthreads();
  }
#undef GLOAD
#undef SSTORE
#undef SET0
#undef SET1
#undef GL
#undef SS
#undef COMPUTE
}

enum { EPI_SWIGLU = 0, EPI_YF32 = 1, EPI_PROJ = 2, EPI_UQKV = 3, EPI_SG = 4, EPI_MERGE = 5 };
struct GemmDesc {
  int epi, mtiles, ntiles, K, lda, skipctx;
  const u16* A; const u16* W;
  void* dst;
};

template <bool MERGE>
DI void gemm_phase(const GemmDesc& d, const Params& P, char* lds) {
  const int tid = otid(), lane = tid & 63, wid = tid >> 6, r = lane & 31, h = lane >> 5;
  const int wm = wid >> 1, wn = wid & 1;
  char* ws = ows(P);
  const float* rope = reinterpret_cast<const float*>(ws + O_ROPE);
  const int ntl = d.mtiles * d.ntiles;
  for (int t = blockIdx.x; t < ntl; t += gridDim.x) {
    int mt = t / d.ntiles;
    int nt = t - mt * d.ntiles;
    if (d.ntiles == 8) {
      const int m4 = d.mtiles & ~3;
      if (t < 8 * m4) {
        const int x = t & 7, k = t >> 3;
        nt = 4 * (x & 1) + (k & 3);
        mt = 4 * (k >> 2) + (x >> 1);
      }
    }
    if (d.skipctx && mt >= 128) mt += 2;
    const u16* A = d.A; const u16* W = d.W; int lda = d.lda, K = d.K;
    bool trans = false;
    int uq = 0;
    if (d.epi == EPI_PROJ) {
      const int n0 = nt * 128;
      trans = (n0 >= 2048 && n0 < 3072) || (n0 >= 4352 && n0 < 4608);
    } else if (d.epi == EPI_UQKV) {
      if (nt < 12) { uq = 1; A = reinterpret_cast<const u16*>(ws + O_CQ); lda = 384; K = 384; W = reinterpret_cast<const u16*>(ws + O_WUQ); }
      else { nt -= 12; A = reinterpret_cast<const u16*>(ws + O_CKV); lda = 256; K = 256; W = reinterpret_cast<const u16*>(ws + O_WUKV); trans = (nt & 1); }
    }
    const int n0 = nt * 128;
    constexpr int nrep = MERGE ? 3 : 1;
    f32x16 acc[2][2];
#pragma unroll 1
    for (int rep = 0; rep < nrep; ++rep) {
#pragma unroll
      for (int a = 0; a < 2; ++a)
#pragma unroll
        for (int b = 0; b < 2; ++b)
#pragma unroll
          for (int i = 0; i < 16; ++i) acc[a][b][i] = 0.f;
      const u16* Ar = A + (long)rep * ((long)MB * DM) + (long)(mt * 128) * lda;
      const u16* Wr = W + (long)rep * ((long)DM * DM) + (long)n0 * K;
      if (trans) gemm_kloop<true>(Ar, lda, Wr, K, K, acc, lds);
      else gemm_kloop<false>(Ar, lda, Wr, K, K, acc, lds);
      if constexpr (MERGE) {
        const u16* sg = reinterpret_cast<const u16*>(ws + O_SG);
        float* macc = reinterpret_cast<float*>(ws + O_YO);
        u16* mo = reinterpret_cast<u16*>(d.dst);
#pragma unroll
        for (int mi = 0; mi < 2; ++mi)
#pragma unroll
          for (int ni = 0; ni < 2; ++ni) {
            const long row = mt * 128 + wm * 64 + mi * 32 + r;
            const int col = n0 + wn * 64 + ni * 32 + 4 * h;
            const u16* gp = sg + row * 3072 + rep * 1024 + col;
            float* mp = macc + row * DM + col;
#pragma unroll
            for (int q = 0; q < 4; ++q) {
              const u32x2 g = *GPC(u32x2, gp + 8 * q);
              f32x4 v = {0.f, 0.f, 0.f, 0.f};
              if (rep > 0) v = *GPC(f32x4, mp + 8 * q);
              v.x += bflo(g.x) * acc[mi][ni][4 * q + 0]; v.y += bfhi(g.x) * acc[mi][ni][4 * q + 1];
              v.z += bflo(g.y) * acc[mi][ni][4 * q + 2]; v.w += bfhi(g.y) * acc[mi][ni][4 * q + 3];
              if (rep < 2) *GP(f32x4, mp + 8 * q) = v;
              else { u32x2 o = {pk2(v.x, v.y), pk2(v.z, v.w)}; *GP(u32x2, mo + row * DM + col + 8 * q) = o; }
            }
          }
      }
    }
    const int cb = n0 + wn * 64;
    const int rowb = mt * 128 + wm * 64;
    if constexpr (MERGE) {
    } else if (d.epi == EPI_SWIGLU) {
      u16* act = reinterpret_cast<u16*>(d.dst);
      const int acol = (n0 >> 1) + wn * 32;
#pragma unroll
      for (int mi = 0; mi < 2; ++mi) {
        f32x16 o;
#pragma unroll
        for (int i = 0; i < 16; ++i) { float a = acc[mi][0][i], b = acc[mi][1][i]; o[i] = a * sigmoidf_(a) * b; }
        st_bf16_tile(o, act + (long)(rowb + mi * 32 + r) * FFN + acol, h);
      }
    } else if (d.epi == EPI_YF32) {
      u16* y = reinterpret_cast<u16*>(d.dst);
#pragma unroll
      for (int mi = 0; mi < 2; ++mi)
#pragma unroll
        for (int ni = 0; ni < 2; ++ni) st_bf16_tile(acc[mi][ni], y + (long)(rowb + mi * 32 + r) * DM + cb + ni * 32, h);
    } else if (d.epi == EPI_SG) {
      u16* sg = reinterpret_cast<u16*>(d.dst);
#pragma unroll
      for (int mi = 0; mi < 2; ++mi)
#pragma unroll
        for (int ni = 0; ni < 2; ++ni) {
          f32x16 o;
#pragma unroll
          for (int i = 0; i < 16; ++i) o[i] = sigmoidf_(acc[mi][ni][i]);
          st_bf16_tile(o, sg + (long)(rowb + mi * 32 + r) * 3072 + cb + ni * 32, h);
        }
    } else if (trans) {
      u16* vt; int f0;
      if (d.epi == EPI_PROJ) {
        if (cb < 3072) { vt = reinterpret_cast<u16*>(ws + O_VAT); f0 = cb - 2048; }
        else { vt = reinterpret_cast<u16*>(ws + O_VBT); f0 = cb - 4352; }
      } else { vt = reinterpret_cast<u16*>(ws + O_VCT); f0 = (nt >> 1) * 128 + wn * 64; }
#pragma unroll
      for (int mi = 0; mi < 2; ++mi)
#pragma unroll
        for (int ni = 0; ni < 2; ++ni) st_bf16_tile_vt(acc[mi][ni], vt + (long)(f0 + ni * 32 + r) * MB + rowb + mi * 32, h);
    } else {
      u16* dst = nullptr; int ld = 0, cofs = 0; bool rp = false;
      if (d.epi == EPI_PROJ) {
        if (cb < 1024) { dst = reinterpret_cast<u16*>(ws + O_QA); ld = 1024; cofs = cb; rp = true; }
        else if (cb < 2048) { dst = reinterpret_cast<u16*>(ws + O_KA); ld = 1024; cofs = cb - 1024; rp = true; }
        else if (cb < 4096) { dst = reinterpret_cast<u16*>(ws + O_QB); ld = 1024; cofs = cb - 3072; rp = true; }
        else if (cb < 4352) { dst = reinterpret_cast<u16*>(ws + O_KB); ld = 256; cofs = cb - 4096; rp = true; }
        else if (cb < 4992) { dst = reinterpret_cast<u16*>(ws + O_CQ); ld = 384; cofs = cb - 4608; }
        else if (cb < 5248) { dst = reinterpret_cast<u16*>(ws + O_CKV); ld = 256; cofs = cb - 4992; }
        else if (cb < 5312) { dst = reinterpret_cast<u16*>(ws + O_KR); ld = 64; cofs = 0; rp = true; }
      } else {
        if (uq) { dst = reinterpret_cast<u16*>(ws + O_QC); ld = 1536; cofs = cb; rp = (cb % 192) == 128; }
        else { dst = reinterpret_cast<u16*>(ws + O_KCN); ld = 1024; cofs = (nt >> 1) * 128 + wn * 64; }
      }
      if (dst != nullptr) {
        const bool latent = mt < 128;
#pragma unroll
        for (int mi = 0; mi < 2; ++mi) {
          const int lr = rowb + mi * 32 + r;
#pragma unroll
          for (int ni = 0; ni < 2; ++ni) {
            f32x16 o = acc[mi][ni];
            if (rp && latent) rope_tile(o, rope, ni == 0 ? (lr >> 6) : (lr & 63), h);
            st_bf16_tile(o, dst + (long)lr * ld + cofs + ni * 32, h);
          }
        }
      }
    }
  }
}

struct RowDesc {
  int g0, g1, skipctx;
  const float* told_lat; const float* told_ctx;
  const float* ybuf; int yrow0;
  float gscale; int gate_idx, gpost_idx, layer;
  int has_u, ulayer, gpre_idx, shift_idx, scale_idx;
};

DI void rowop_phase(const RowDesc& d, const Params& P) {
  const int tid_ = otid(); const int lane = tid_ & 63, wid = tid_ >> 6;
  char* ws = ows(P);
  const float* mods = reinterpret_cast<const float*>(ws + O_MODS);
  const float* normg = P.in[6];
  float* tctx = reinterpret_cast<float*>(ws + O_TCTX);
  u16* U = reinterpret_cast<u16*>(ws + O_U);
  const int stride = gridDim.x * 4;
  const bool has_y = d.ybuf != nullptr;
  f32x4 tn[4], yn[4];
  bool vn = false;
#define LOADROW(g_)                                                                                              \
  {                                                                                                              \
    const int b_ = (g_) / MB, i_ = (g_) - b_ * MB;                                                               \
    const bool lat_ = i_ < SEQ;                                                                                  \
    vn = !(d.skipctx && !lat_);                                                                                  \
    if (vn) {                                                                                                    \
      const long toff_ = lat_ ? ((long)(b_ * SEQ + i_)) * DM : ((long)(b_ * CTX + i_ - SEQ)) * DM;               \
      const float* told_ = (lat_ ? d.told_lat : d.told_ctx) + toff_;                                             \
      _Pragma("unroll") for (int j = 0; j < 4; ++j) tn[j] = *GPC(f32x4, told_ + lane * 4 + 256 * j);             \
      if (has_y) {                                                                                               \
        const u16* y_ = reinterpret_cast<const u16*>(d.ybuf) + (long)((g_) - d.yrow0) * DM;                      \
        _Pragma("unroll") for (int j = 0; j < 4; ++j) {                                                          \
          const u32x2 w_ = *GPC(u32x2, y_ + lane * 4 + 256 * j);                                                 \
          yn[j].x = bflo(w_.x); yn[j].y = bfhi(w_.x); yn[j].z = bflo(w_.y); yn[j].w = bfhi(w_.y);                \
        }                                                                                                        \
      }                                                                                                          \
    }                                                                                                            \
  }
  int gnext = d.g0 + blockIdx.x * 4 + wid;
  if (gnext < d.g1) { LOADROW(gnext) }
  while (gnext < d.g1) {
    const int g = gnext;
    const bool v = vn;
    f32x4 t[4], yv[4];
#pragma unroll
    for (int j = 0; j < 4; ++j) { t[j] = tn[j]; yv[j] = yn[j]; }
    gnext += stride;
    if (gnext < d.g1) { LOADROW(gnext) }
    if (!v) continue;
    const int b = g / MB, i = g - b * MB;
    const bool lat = i < SEQ;
    const int midx = lat ? b : 2;
    const long toff = lat ? ((long)(b * SEQ + i)) * DM : ((long)(b * CTX + i - SEQ)) * DM;
    if (has_y) {
      float ss = 0.f;
#pragma unroll
      for (int j = 0; j < 4; ++j) ss += yv[j].x * yv[j].x + yv[j].y * yv[j].y + yv[j].z * yv[j].z + yv[j].w * yv[j].w;
      ss = wave_sum(ss);
      const float rr = rsqrtf(ss * (1.f / DM) + EPS) * d.gscale;
      const float* gate = mods + (d.layer * 3 + midx) * 9216 + d.gate_idx * DM;
      const float* gp = normg + (d.layer * 6 + d.gpost_idx) * DM;
      float* tnew = (lat ? P.out : tctx) + toff;
#pragma unroll
      for (int j = 0; j < 4; ++j) {
        f32x4 ga = *GPC(f32x4, gate + lane * 4 + 256 * j);
        f32x4 gg = *GPC(f32x4, gp + lane * 4 + 256 * j);
        t[j].x += ga.x * (yv[j].x * rr * gg.x); t[j].y += ga.y * (yv[j].y * rr * gg.y);
        t[j].z += ga.z * (yv[j].z * rr * gg.z); t[j].w += ga.w * (yv[j].w * rr * gg.w);
        *GP(f32x4, tnew + lane * 4 + 256 * j) = t[j];
      }
    }
    if (d.has_u) {
      float ss = 0.f;
#pragma unroll
      for (int j = 0; j < 4; ++j) ss += t[j].x * t[j].x + t[j].y * t[j].y + t[j].z * t[j].z + t[j].w * t[j].w;
      ss = wave_sum(ss);
      const float rr = rsqrtf(ss * (1.f / DM) + EPS);
      const float* mu = mods + (d.ulayer * 3 + midx) * 9216;
      const float* sh = mu + d.shift_idx * DM; const float* sc = mu + d.scale_idx * DM;
      const float* gp = normg + (d.ulayer * 6 + d.gpre_idx) * DM;
      u16* u = U + (long)g * DM;
#pragma unroll
      for (int j = 0; j < 4; ++j) {
        f32x4 gg = *GPC(f32x4, gp + lane * 4 + 256 * j);
        f32x4 s1 = *GPC(f32x4, sc + lane * 4 + 256 * j);
        f32x4 s0 = *GPC(f32x4, sh + lane * 4 + 256 * j);
        float a = (t[j].x * rr * gg.x) * (1.f + s1.x) + s0.x, bb = (t[j].y * rr * gg.y) * (1.f + s1.y) + s0.y;
        float c = (t[j].z * rr * gg.z) * (1.f + s1.z) + s0.z, dd = (t[j].w * rr * gg.w) * (1.f + s1.w) + s0.w;
        u32x2 v2; v2.x = pk2(a, bb); v2.y = pk2(c, dd);
        *GP(u32x2, u + lane * 4 + 256 * j) = v2;
      }
    }
  }
#undef LOADROW
}

DI void r3_phase(int layer, const Params& P) {
  const int tid_ = otid(); const int lane = tid_ & 63, wid = tid_ >> 6;
  char* ws = ows(P);
  u16* cq = reinterpret_cast<u16*>(ws + O_CQ);
  u16* ckv = reinterpret_cast<u16*>(ws + O_CKV);
  const float* gq = P.in[13] + layer * 384;
  const float* gkv = P.in[14] + layer * 256;
  for (int row = blockIdx.x * 4 + wid; row < MB; row += gridDim.x * 4) {
    {
      u16* p = cq + (long)row * 384;
      float v[6]; float ss = 0.f;
#pragma unroll
      for (int j = 0; j < 3; ++j) {
        unsigned x = *GPC(unsigned, p + lane * 2 + 128 * j);
        v[2 * j] = bflo(x); v[2 * j + 1] = bfhi(x); ss += v[2 * j] * v[2 * j] + v[2 * j + 1] * v[2 * j + 1];
      }
      ss = wave_sum(ss);
      const float rr = rsqrtf(ss * (1.f / 384.f) + EPS);
#pragma unroll
      for (int j = 0; j < 3; ++j) {
        const int c = lane * 2 + 128 * j;
        *GP(unsigned, p + c) = pk2(v[2 * j] * rr * gq[c], v[2 * j + 1] * rr * gq[c + 1]);
      }
    }
    {
      u16* p = ckv + (long)row * 256;
      u32x2 x = *GPC(u32x2, p + lane * 4);
      float v0 = bflo(x.x), v1 = bfhi(x.x), v2 = bflo(x.y), v3 = bfhi(x.y);
      float ss = wave_sum(v0 * v0 + v1 * v1 + v2 * v2 + v3 * v3);
      const float rr = rsqrtf(ss * (1.f / 256.f) + EPS);
      const int c = lane * 4;
      u32x2 o; o.x = pk2(v0 * rr * gkv[c], v1 * rr * gkv[c + 1]); o.y = pk2(v2 * rr * gkv[c + 2], v3 * rr * gkv[c + 3]);
      *GP(u32x2, p + c) = o;
    }
  }
}

template <int DQK, int DV, int TYPE>
DI void attn_item(int layer, int qt, int head, char* lds, const Params& P) {
  const int tid = otid(), lane = tid & 63, wid = tid >> 6, r = lane & 31, h = lane >> 5;
  char* ws = ows(P);
  constexpr int NS = DQK / 16, NDV = DV / 32;
  constexpr bool DB = DQK == 64;
  constexpr int KBYTES = 64 * DQK * 2;
  constexpr int STAGE = DB ? 24576 : 0;
  constexpr int VOFF = DB ? 8192 : 24576;
  constexpr float SCALE = TYPE == 1 ? 0.07216878364870322f : 0.125f;
  constexpr float C = SCALE * LOG2E;
  const bool latent = qt < 128;
  int ta0, na, NT;
  if (!latent) { ta0 = 256; na = 4; NT = 4; }
  else if (TYPE == 2) { int lo = qt * 2 - 2; if (lo < 0) lo = 0; int hi = qt * 2 + 4; if (hi > 256) hi = 256; ta0 = lo; na = hi - lo; NT = na + 4; }
  else { ta0 = 0; na = 260; NT = 260; }
  const int qrow = qt * 128 + wid * 32 + r;
  const u16* Kp; int ldk; const u16* Vp;
  if (TYPE == 0) { Kp = reinterpret_cast<const u16*>(ws + O_KA) + head * 128; ldk = 1024; Vp = reinterpret_cast<const u16*>(ws + O_VAT) + (long)(head * 128) * MB; }
  else if (TYPE == 1) { Kp = reinterpret_cast<const u16*>(ws + O_KCN) + head * 128; ldk = 1024; Vp = reinterpret_cast<const u16*>(ws + O_VCT) + (long)(head * 128) * MB; }
  else { Kp = reinterpret_cast<const u16*>(ws + O_KB) + (head >> 2) * 64; ldk = 256; Vp = reinterpret_cast<const u16*>(ws + O_VBT) + (long)((head >> 2) * 64) * MB; }
  const u16* K2 = reinterpret_cast<const u16*>(ws + O_KR);
  const int kr_a = (DQK == 64) ? (tid >> 3) : (tid >> 4), kc_a = (DQK == 64) ? (tid & 7) : (tid & 15);
  const int kgo_a = kr_a * ldk + kc_a * 8;
  const int kso_a = kr_a * (DQK * 2) + ((kc_a ^ ((kr_a >> 1) & 7)) << 4);
  const int kr_b = tid >> 3, kc_b = 16 + (tid & 7);
  const int kgo_b = kr_b * 64 + (tid & 7) * 8;
  const int kso_b = kr_b * (DQK * 2) + ((kc_b ^ ((kr_b >> 1) & 7)) << 4);
  const int vdv = tid >> 3, vkc = tid & 7, vxs = (vdv >> 1) & 7;
  const unsigned vvo = (unsigned)(vdv * MB + vkc * 8) * 2u;
  const unsigned kvo_a = (unsigned)kgo_a * 2u, kvo_b = (unsigned)kgo_b * 2u;
  const int vso = VOFF + vdv * 128 + ((vkc ^ vxs) << 4);
  u32x4 kreg0, kreg1, kreg2, kreg3, kreg4, kreg5, vreg0, vreg1, vreg2, vreg3;
  const int xr = (r >> 1) & 7;
  constexpr int NMAPS = TYPE == 0 ? 2 : 1;
  u16* ya_dst = reinterpret_cast<u16*>(ws + O_YA) + (long)qrow * 1024 + head * 128;
  for (int map = 0; map < NMAPS; ++map) {
    const u16* Kb = Kp + map * 64;
    const u16* Qp;
    if (TYPE == 0) Qp = reinterpret_cast<const u16*>(ws + O_QA) + (long)qrow * 1024 + head * 128 + map * 64;
    else if (TYPE == 1) Qp = reinterpret_cast<const u16*>(ws + O_QC) + (long)qrow * 1536 + head * 192;
    else Qp = reinterpret_cast<const u16*>(ws + O_QB) + (long)qrow * 1024 + head * 64;
    constexpr int NQR = NS > 6 ? 6 : NS;
    bf16x8 qf[NQR];
#pragma unroll
    for (int s = 0; s < NQR; ++s) qf[s] = *GPC(bf16x8, Qp + 16 * s + 8 * h);
    char* qpark = lds + 40960 + tid * 16;
#pragma unroll
    for (int s = NQR; s < NS; ++s) *reinterpret_cast<bf16x8*>(qpark + (s - NQR) * 4096) = *GPC(bf16x8, Qp + 16 * s + 8 * h);
    float m_run, l_run;
    if (TYPE == 2) { m_run = P.in[12][layer * 16 + head] * (1.f / SCALE); l_run = 1.f; }
    else { m_run = -1e30f; l_run = 0.f; }
    f32x16 oacc[NDV];
#pragma unroll
    for (int d = 0; d < NDV; ++d)
#pragma unroll
      for (int i = 0; i < 16; ++i) oacc[d][i] = 0.f;
#define TILE_OF(j) ((j) < na ? ta0 + (j) : 256 + ((j) - na))
#define LDG(p) (*GPC(u32x4, p))
#define ATT_GLOAD(tile)                                                                                          \
  {                                                                                                              \
      \
    const long key0 = (long)(tile) * 64;                                                                         \
    const char* kp_ = reinterpret_cast<const char*>(Kb + key0 * ldk);                                            \
    if constexpr (DQK == 64) {                                                                                   \
      kreg0 = LDG(uptr(kp_) + kvo_a); kreg1 = LDG(uptr(kp_ + (long)64 * ldk) + kvo_a);                           \
    } else {                                                                                                     \
      kreg0 = LDG(uptr(kp_) + kvo_a); kreg1 = LDG(uptr(kp_ + (long)32 * ldk) + kvo_a);                           \
      kreg2 = LDG(uptr(kp_ + (long)64 * ldk) + kvo_a); kreg3 = LDG(uptr(kp_ + (long)96 * ldk) + kvo_a);          \
      const char* k2_ = reinterpret_cast<const char*>(K2 + key0 * 64);                                           \
      kreg4 = LDG(uptr(k2_) + kvo_b); kreg5 = LDG(uptr(k2_ + 32 * 64 * 2) + kvo_b);                              \
    }                                                                                                            \
    const char* vp_ = reinterpret_cast<const char*>(Vp + key0);                                                  \
    vreg0 = LDG(uptr(vp_) + vvo); vreg1 = LDG(uptr(vp_ + (long)64 * MB) + vvo);                                  \
    if constexpr (DV == 128) { vreg2 = LDG(uptr(vp_ + (long)128 * MB) + vvo); vreg3 = LDG(uptr(vp_ + (long)192 * MB) + vvo); } \
  }
#define STV(sb, j, v) { *reinterpret_cast<u32x4*>((sb) + vso + (j) * 4096) = v; }
#define ATT_SSTORE(sb)                                                                                           \
  {                                                                                                              \
    if constexpr (DQK == 64) {                                                                                   \
      *reinterpret_cast<u32x4*>((sb) + kso_a) = kreg0; *reinterpret_cast<u32x4*>((sb) + kso_a + 4096) = kreg1;   \
    } else {                                                                                                     \
      *reinterpret_cast<u32x4*>((sb) + kso_a) = kreg0; *reinterpret_cast<u32x4*>((sb) + kso_a + 16 * 384) = kreg1; \
      *reinterpret_cast<u32x4*>((sb) + kso_a + 32 * 384) = kreg2; *reinterpret_cast<u32x4*>((sb) + kso_a + 48 * 384) = kreg3; \
      *reinterpret_cast<u32x4*>((sb) + kso_b) = kreg4; *reinterpret_cast<u32x4*>((sb) + kso_b + 32 * 384) = kreg5; \
    }                                                                                                            \
    STV(sb, 0, vreg0) STV(sb, 1, vreg1)                                                                          \
    if constexpr (DV == 128) { STV(sb, 2, vreg2) STV(sb, 3, vreg3) }                                             \
  }
    ATT_GLOAD(TILE_OF(0));
    ATT_SSTORE(lds);
    if constexpr (DB) { if (1 < NT) { ATT_GLOAD(TILE_OF(1)); } }
    __syncthreads();
    for (int j = 0; j < NT; ++j) {
      const int tile = TILE_OF(j);
      const char* sb = lds + (DB ? (j & 1) * STAGE : 0);
      constexpr int KD = 2, KRING = 3;
      bf16x8 kr0[KRING], kr1[KRING];
#define KFR(s_, slot_)                                                                          \
  {                                                                                             \
    const int co = ((2 * (s_) + h) ^ xr) << 4;                                                  \
    kr0[slot_] = *reinterpret_cast<const bf16x8*>(sb + r * (DQK * 2) + co);                     \
    kr1[slot_] = *reinterpret_cast<const bf16x8*>(sb + (32 + r) * (DQK * 2) + co);              \
  }
#pragma unroll
      for (int s = 0; s < KD; ++s) KFR(s, s)
      __builtin_amdgcn_sched_barrier(0);
      if constexpr (DB) {
        char* sn = lds + ((j + 1) & 1) * STAGE;
        if (j + 1 < NT) { ATT_SSTORE(sn); }
        if (j + 2 < NT) { ATT_GLOAD(TILE_OF(j + 2)); }
      } else {
        if (j + 1 < NT) { ATT_GLOAD(TILE_OF(j + 1)); }
      }
      f32x16 s0, s1;
#pragma unroll
      for (int i = 0; i < 16; ++i) { s0[i] = 0.f; s1[i] = 0.f; }
      {
#pragma unroll
        for (int s = 0; s < NS; ++s) {
          if (s + KD < NS) KFR(s + KD, (s + KD) % KRING)
          bf16x8 qs;
          if constexpr (NS > NQR) { if (s < NQR) qs = qf[s < NQR ? s : 0]; else qs = *reinterpret_cast<const bf16x8*>(qpark + (s - NQR) * 4096); }
          else qs = qf[s];
          s0 = MFMA(kr0[s % KRING], qs, s0);
          s1 = MFMA(kr1[s % KRING], qs, s1);
          __builtin_amdgcn_sched_barrier(0);
        }
#undef KFR
      }
      const char* vb0 = sb + VOFF + r * 128;
#define VFRAG(d, B) (*reinterpret_cast<const bf16x8*>(vb0 + (d) * 4096 + (((2 * (B) + h) ^ xr) << 4)))
      constexpr int VD = 3;
      bf16x8 vr[8];
#pragma unroll
      for (int g = 0; g < VD; ++g) vr[g] = VFRAG(g >> 2, g & 3);
      if (TYPE == 2 && latent && j < na) {
        const int kb0 = tile * 64 - qrow;
#pragma unroll
        for (int i = 0; i < 16; ++i) {
          const int d0 = kb0 + crow(i, h), d1 = d0 + 32;
          if (d0 > 128 || d0 < -128) s0[i] = -1e30f;
          if (d1 > 128 || d1 < -128) s1[i] = -1e30f;
        }
      }
      const float tm0 = vmax3w(s0[0], s0[1], s0[2], s1[0]);
      const float tm1 = vmax3d(s0[3], s0[4], s0[5], tm0), tm2 = vmax3d(s0[6], s0[7], s0[8], tm0), tm3 = vmax3d(s0[9], s0[10], s0[11], tm0);
      const float tm4 = vmax3d(s0[12], s0[13], s0[14], tm0);
      const float tm5 = vmax3d4(s1[0], s1[1], s1[2], tm1, tm2, tm3, tm4), tm6 = vmax3d(s1[3], s1[4], s1[5], tm5), tm7 = vmax3d(s1[6], s1[7], s1[8], tm5);
      const float tm8 = vmax3d(s1[9], s1[10], s1[11], tm5), tm9 = vmax3d(s1[12], s1[13], s1[14], tm5), tma = vmax3d(s0[15], s1[15], tm0, tm5), tmb = vmax3(tm1, tm2, tm3);
      const float tmc = vmax3(tm4, tm5, tm6), tmd = vmax3(tm7, tm8, tm9);
      float tmax = xhalf_max(vmax3(vmax3(tma, tmb, tmc), tmd, tmd));
      const float mnew = fmaxf(m_run, tmax);
      const float alpha = __builtin_amdgcn_exp2f((m_run - mnew) * C);
      m_run = mnew;
      const float mc = -mnew * C;
      float pa = 0.f, pb = 0.f, pc = 0.f, pd = 0.f;
#pragma unroll
      for (int i = 0; i < 16; i += 2) {
        s0[i] = __builtin_amdgcn_exp2f(fmaf(s0[i], C, mc)); pa += s0[i];
        s0[i + 1] = __builtin_amdgcn_exp2f(fmaf(s0[i + 1], C, mc)); pb += s0[i + 1];
      }
#pragma unroll
      for (int i = 0; i < 16; i += 2) {
        s1[i] = __builtin_amdgcn_exp2f(fmaf(s1[i], C, mc)); pc += s1[i];
        s1[i + 1] = __builtin_amdgcn_exp2f(fmaf(s1[i + 1], C, mc)); pd += s1[i + 1];
      }
      const float ps = xhalf_sum((pa + pb) + (pc + pd));
      l_run = l_run * alpha + ps;
      if (__any(alpha != 1.f)) {
#pragma unroll
        for (int d = 0; d < NDV; ++d)
#pragma unroll
          for (int i = 0; i < 16; ++i) oacc[d][i] *= alpha;
      }
      bf16x8 pf[4];
#pragma unroll
      for (int sp = 0; sp < 2; ++sp) {
        u32x4 w0, w1;
        w0.x = pk2(s0[8 * sp + 0], s0[8 * sp + 1]); w0.y = pk2(s0[8 * sp + 2], s0[8 * sp + 3]);
        w0.z = pk2(s0[8 * sp + 4], s0[8 * sp + 5]); w0.w = pk2(s0[8 * sp + 6], s0[8 * sp + 7]);
        w1.x = pk2(s1[8 * sp + 0], s1[8 * sp + 1]); w1.y = pk2(s1[8 * sp + 2], s1[8 * sp + 3]);
        w1.z = pk2(s1[8 * sp + 4], s1[8 * sp + 5]); w1.w = pk2(s1[8 * sp + 6], s1[8 * sp + 7]);
        pf[sp] = __builtin_bit_cast(bf16x8, w0);
        pf[2 + sp] = __builtin_bit_cast(bf16x8, w1);
      }
      {
#pragma unroll
        for (int f = 0; f < NDV * 4; ++f) {
          if (f + VD < NDV * 4) vr[(f + VD) & 7] = VFRAG((f + VD) >> 2, (f + VD) & 3);
          oacc[f >> 2] = MFMA(vr[f & 7], pf[f & 3], oacc[f >> 2]);
          __builtin_amdgcn_sched_barrier(0);
        }
#undef VFRAG
      }
      __syncthreads();
      if constexpr (!DB) {
        if (j + 1 < NT) { ATT_SSTORE(lds); }
        __syncthreads();
      }
    }
#undef ATT_GLOAD
#undef ATT_SSTORE
#undef STV
#undef LDG
#undef TILE_OF
    const float il = 1.f / l_run;
    if (TYPE == 0 && map == 0) {
#pragma unroll
      for (int d = 0; d < NDV; ++d) {
        f32x16 o;
#pragma unroll
        for (int i = 0; i < 16; ++i) o[i] = oacc[d][i] * il;
        st_bf16_tile(o, ya_dst + d * 32, h);
      }
    } else if (TYPE == 0) {
      const float lam = reinterpret_cast<const float*>(ws + O_LAM)[layer];
      float ss = 0.f;
#pragma unroll
      for (int d = 0; d < NDV; ++d) {
#pragma unroll
        for (int q = 0; q < 4; ++q) {
          const u32x2 w = *GPC(u32x2, ya_dst + d * 32 + 8 * q + 4 * h);
          const float v0 = bflo(w.x) - lam * (oacc[d][4 * q + 0] * il), v1 = bfhi(w.x) - lam * (oacc[d][4 * q + 1] * il);
          const float v2 = bflo(w.y) - lam * (oacc[d][4 * q + 2] * il), v3 = bfhi(w.y) - lam * (oacc[d][4 * q + 3] * il);
          oacc[d][4 * q + 0] = v0; oacc[d][4 * q + 1] = v1; oacc[d][4 * q + 2] = v2; oacc[d][4 * q + 3] = v3;
          ss += v0 * v0 + v1 * v1 + v2 * v2 + v3 * v3;
        }
      }
      ss = xhalf_sum(ss);
      const float rr = rsqrtf(ss * (1.f / 128.f) + EPS) * (1.f - P.linit[layer]);
      const float* sg = P.in[11] + layer * 128;
#pragma unroll
      for (int d = 0; d < NDV; ++d) {
        f32x16 o;
#pragma unroll
        for (int q = 0; q < 4; ++q) {
          const f32x4 g4 = *GPC(f32x4, sg + d * 32 + 8 * q + 4 * h);
          o[4 * q] = oacc[d][4 * q] * rr * g4.x; o[4 * q + 1] = oacc[d][4 * q + 1] * rr * g4.y;
          o[4 * q + 2] = oacc[d][4 * q + 2] * rr * g4.z; o[4 * q + 3] = oacc[d][4 * q + 3] * rr * g4.w;
        }
        st_bf16_tile(o, ya_dst + d * 32, h);
      }
    } else {
      u16* dst = TYPE == 1 ? reinterpret_cast<u16*>(ws + O_YA + 2 * SZ1) + (long)qrow * 1024 + head * 128
                           : reinterpret_cast<u16*>(ws + O_YA + SZ1) + (long)qrow * 1024 + head * 64;
#pragma unroll
      for (int d = 0; d < NDV; ++d) {
        f32x16 o;
#pragma unroll
        for (int i = 0; i < 16; ++i) o[i] = oacc[d][i] * il;
        st_bf16_tile(o, dst + d * 32, h);
      }
    }
  }
  __syncthreads();
}

DI void attn_phase(int layer, const Params& P, char* lds) {
  const int NITEMS = layer + 1 < DEPTH ? 4096 + 64 : 4096;
  for (int w = blockIdx.x; w < NITEMS; w += gridDim.x) {
    if (w < 1024) attn_item<64, 128, 0>(layer, w >> 3, w & 7, lds, P);
    else if (w < 2048) attn_item<192, 128, 1>(layer, (w - 1024) >> 3, w & 7, lds, P);
    else if (w < 4096) attn_item<64, 64, 2>(layer, (w - 2048) >> 4, w & 15, lds, P);
    else if (w < 4112) attn_item<64, 128, 0>(layer, 128 + ((w - 4096) >> 3), w & 7, lds, P);
    else if (w < 4128) attn_item<192, 128, 1>(layer, 128 + ((w - 4112) >> 3), w & 7, lds, P);
    else attn_item<64, 64, 2>(layer, 128 + ((w - 4128) >> 4), w & 15, lds, P);
  }
}

DI void conv_tile(const float* __restrict__ src, int K, int N, u16* __restrict__ dst, int tile, int perm, char* lds) {
  float* sm = reinterpret_cast<float*>(lds);
  const int tid = otid();
  const int nts = N >> 6;
  const int kt = tile / nts, ntile = tile - kt * nts;
  const int k0 = kt * 64, n0 = ntile * 64;
#pragma unroll
  for (int j = 0; j < 16; ++j) {
    const int k = j * 4 + (tid >> 6), n = tid & 63;
    sm[k * 65 + n] = src[(long)(k0 + k) * N + n0 + n];
  }
  __syncthreads();
#pragma unroll
  for (int j = 0; j < 2; ++j) {
    const int n = (tid >> 3) + 32 * j, kc = tid & 7;
    float v[8];
#pragma unroll
    for (int e = 0; e < 8; ++e) v[e] = sm[(kc * 8 + e) * 65 + n];
    int nn = n0 + n;
    if (perm) { const int s = nn >= FFN ? 1 : 0; const int jj = nn - s * FFN; nn = 64 * (jj >> 5) + 32 * s + (jj & 31); }
    u32x4 o; o.x = pk2(v[0], v[1]); o.y = pk2(v[2], v[3]); o.z = pk2(v[4], v[5]); o.w = pk2(v[6], v[7]);
    *GP(u32x4, dst + (long)nn * K + k0 + kc * 8) = o;
  }
  __syncthreads();
}

constexpr int CONV_TILES = 7616;
DI void conv_phase(int layer, const Params& P, char* lds, int extra_first) {
  char* ws = ows(P);
  for (int t = blockIdx.x + extra_first; t < CONV_TILES + extra_first; t += gridDim.x) {
    int x = t - extra_first;
    const float* src; int K, N, perm = 0; u16* dst;
    if (x < 2816) { const int s = x / 1408; x -= s * 1408; src = P.in[7] + ((long)(layer * 2 + s)) * DM * 2 * FFN; K = DM; N = 2 * FFN; perm = 1; dst = reinterpret_cast<u16*>(ws + O_WIN + s * SZ_WIN); }
    else if (x < 4224) { x -= 2816; const int s = x / 704; x -= s * 704; src = P.in[8] + ((long)(layer * 2 + s)) * FFN * DM; K = FFN; N = DM; dst = reinterpret_cast<u16*>(ws + O_WOUT + s * SZ_WOUT); }
    else if (x < 6320) { x -= 4224; src = P.in[9] + (long)layer * DM * MIXIN; K = DM; N = MIXIN; dst = reinterpret_cast<u16*>(ws + O_WMIX); }
    else if (x < 6464) { x -= 6320; src = P.in[15] + (long)layer * 384 * 1536; K = 384; N = 1536; dst = reinterpret_cast<u16*>(ws + O_WUQ); }
    else if (x < 6592) { x -= 6464; src = P.in[16] + (long)layer * 256 * 2048; K = 256; N = 2048; dst = reinterpret_cast<u16*>(ws + O_WUKV); }
    else if (x < 7360) { x -= 6592; const int br = x / 256; x -= br * 256; src = P.in[17] + ((long)(layer * 3 + br)) * DM * DM; K = DM; N = DM; dst = reinterpret_cast<u16*>(ws + O_WBR) + (long)br * DM * DM; }
    else { x -= 7360; src = P.in[18] + (long)layer * DM * DM; K = DM; N = DM; dst = reinterpret_cast<u16*>(ws + O_WMO); }
    conv_tile(src, K, N, dst, x, perm, lds);
  }
}

DI void mods_item(int item, const Params& P, char* lds) {
  float* sv = reinterpret_cast<float*>(lds);
  float* red = sv + 3 * 1024;
  const int tid = otid();
  const int l = item / 144, nb = item - l * 144;
  for (int e = tid; e < 3 * 1024; e += 256) {
    const int v = e >> 10, k = e & 1023;
    const float x = v < 2 ? P.in[1][v * DM + k] : P.in[3][k];
    sv[e] = x / (1.f + __expf(-x));
  }
  __syncthreads();
  const int c = tid & 63, kg = tid >> 6;
  const float* w = P.in[4] + (long)l * DM * 9216 + nb * 64 + c;
  float a0 = 0.f, a1 = 0.f, a2 = 0.f;
  for (int k = kg * 256; k < kg * 256 + 256; ++k) {
    const float wv = w[(long)k * 9216];
    a0 += sv[k] * wv; a1 += sv[1024 + k] * wv; a2 += sv[2048 + k] * wv;
  }
  red[(kg * 3 + 0) * 64 + c] = a0; red[(kg * 3 + 1) * 64 + c] = a1; red[(kg * 3 + 2) * 64 + c] = a2;
  __syncthreads();
  if (tid < 192) {
    const int v = tid >> 6, cc = tid & 63;
    float s = red[(0 * 3 + v) * 64 + cc] + red[(1 * 3 + v) * 64 + cc] + red[(2 * 3 + v) * 64 + cc] + red[(3 * 3 + v) * 64 + cc];
    const int n = nb * 64 + cc;
    reinterpret_cast<float*>(ows(P) + O_MODS)[(l * 3 + v) * 9216 + n] = s + P.in[5][l * 9216 + n];
  }
  __syncthreads();
}

DI void misc_item(const Params& P) {
  const int tid = otid();
  float* rope = reinterpret_cast<float*>(ows(P) + O_ROPE);
  for (int e = tid; e < 256 * 16; e += 256) {
    const int p = e >> 4, j = e & 15;
    const float ang = (float)p * P.inv_freq[j];
    double a = (double)ang;
    const double TWO_PI = 6.283185307179586476925;
    a -= TWO_PI * rint(a / TWO_PI);
    const double q = a * 0.25, q2 = q * q;
    double sn = q * (1.0 + q2 * (-1.0 / 6 + q2 * (1.0 / 120 + q2 * (-1.0 / 5040 + q2 * (1.0 / 362880 + q2 * (-1.0 / 39916800 + q2 * (1.0 / 6227020800.0)))))));
    double cs = 1.0 + q2 * (-0.5 + q2 * (1.0 / 24 + q2 * (-1.0 / 720 + q2 * (1.0 / 40320 + q2 * (-1.0 / 3628800 + q2 * (1.0 / 479001600.0 + q2 * (-1.0 / 87178291200.0)))))));
    double s2 = 2 * sn * cs, c2 = cs * cs - sn * sn;
    double s4 = 2 * s2 * c2, c4 = c2 * c2 - s2 * s2;
    rope[e] = (float)c4;
    rope[256 * 16 + e] = (float)s4;
  }
  if (tid < DEPTH) {
    const float* dl = P.in[10] + tid * 4 * 64;
    float d01 = 0.f, d23 = 0.f;
    for (int i = 0; i < 64; ++i) { d01 += dl[i] * dl[64 + i]; d23 += dl[128 + i] * dl[192 + i]; }
    reinterpret_cast<float*>(ows(P) + O_LAM)[tid] = expf(d01) - expf(d23) + P.linit[tid];
  }
}

#define XB_TMO      128
#define XB_XCNT(j)  (256  + 64 * (j))
#define XB_XSUB(j)  (1280 + 64 * (j))
#define XB_XGEN(j)  (2304 + 64 * (j))
#define XB_TOP      3328
#define XB_TOPGEN   3392
#define XCD_BAR_WORDS 3456
#define XB_SPIN_CAP (1u << 18)
#define LAS __attribute__((address_space(3)))
DI unsigned xb_ld(unsigned* p) { return __hip_atomic_load(p, __ATOMIC_RELAXED, __HIP_MEMORY_SCOPE_AGENT); }
DI unsigned xb_add(unsigned* p, unsigned v) { return __hip_atomic_fetch_add(p, v, __ATOMIC_RELAXED, __HIP_MEMORY_SCOPE_AGENT); }
DI unsigned xb_xcc_id() { return (unsigned)__builtin_amdgcn_s_getreg((3 << 11) | 20) & 0xFu; }
#define XB_SPIN(cond, bar) do { unsigned _sp = 0; while (cond) { __builtin_amdgcn_s_sleep(1); \
    if ((++_sp & 255u) == 0u) { if (xb_ld(&(bar)[XB_TMO])) break; if (_sp > XB_SPIN_CAP) { atomicAdd(&(bar)[XB_TMO], 1u); break; } } } } while (0)
struct XcdBarrier { unsigned* bar; unsigned x; volatile LAS unsigned* st; };
DI XcdBarrier xcd_barrier_post(unsigned* bar, volatile LAS unsigned* st) {
  XcdBarrier b; b.bar = bar; b.x = xb_xcc_id(); b.st = st;
  if (threadIdx.x == 0) (void)xb_add(&bar[XB_XCNT(b.x)], 1u);
  return b;
}
DI void xcd_barrier_complete(unsigned* bar, unsigned x, unsigned& nloc, unsigned& nx) {
  const unsigned G = gridDim.x * gridDim.y * gridDim.z;
  unsigned sum, cnt, mine, sp = 0u;
  for (;;) {
    sum = 0u; cnt = 0u; mine = 0u;
#pragma unroll
    for (unsigned j = 0; j < 16; ++j) { const unsigned c = xb_ld(&bar[XB_XCNT(j)]); sum += c; cnt += (c > 0u) ? 1u : 0u; mine = (j == x) ? c : mine; }
    if (sum == G) break;
    __builtin_amdgcn_s_sleep(1);
    if ((++sp & 255u) == 0u) { if (xb_ld(&bar[XB_TMO])) break; if (sp > XB_SPIN_CAP) { atomicAdd(&bar[XB_TMO], 1u); break; } }
  }
  nloc = mine > 0u ? mine : 1u; nx = cnt > 0u ? cnt : 1u;
}
DI void xcd_barrier(const XcdBarrier& b) {
  asm volatile("s_waitcnt vmcnt(0)" ::: "memory");
  __syncthreads();
  if (threadIdx.x == 0) {
    unsigned* bar = b.bar;
    __builtin_amdgcn_s_waitcnt(0);
    unsigned nloc = b.st[0], nx = b.st[1];
    if (nloc == 0u) { xcd_barrier_complete(bar, b.x, nloc, nx); b.st[0] = nloc; b.st[1] = nx; }
    const unsigned old = xb_add(&bar[XB_XSUB(b.x)], 1u);
    const unsigned gen = old / nloc;
    if (old + 1u == (gen + 1u) * nloc) {
      __builtin_amdgcn_fence(__ATOMIC_RELEASE, "agent");
      asm volatile("s_waitcnt vmcnt(0)" ::: "memory");
      const unsigned og = xb_add(&bar[XB_TOP], 1u);
      const unsigned tg = og / nx;
      if (og + 1u == (tg + 1u) * nx) xb_add(&bar[XB_TOPGEN], 1u);
      else XB_SPIN(xb_ld(&bar[XB_TOPGEN]) == tg, bar);
      __builtin_amdgcn_fence(__ATOMIC_ACQUIRE, "agent");
      xb_add(&bar[XB_XGEN(b.x)], 1u);
      asm volatile("s_waitcnt vmcnt(0)" ::: "memory");
    } else {
      XB_SPIN(xb_ld(&bar[XB_XGEN(b.x)]) == gen, bar);
      __builtin_amdgcn_fence(__ATOMIC_ACQUIRE, "agent");
      asm volatile("s_waitcnt vmcnt(0)" ::: "memory");
    }
  }
  __syncthreads();
}

constexpr size_t LDS_BYTES = 65536 + 64;
constexpr int NPL = 23;
constexpr int NPH = 1 + DEPTH * NPL;

__global__ void __launch_bounds__(256, 2) fwd_megakernel(Params P) {
  extern __shared__ __attribute__((aligned(16))) char lds[];
  cg::grid_group grid = cg::this_grid();
  volatile LAS unsigned* xst = (volatile LAS unsigned*)(lds + 65536);
  if (threadIdx.x == 0) { xst[0] = 0u; xst[1] = 0u; }
  __syncthreads();
  const XcdBarrier xb = xcd_barrier_post(reinterpret_cast<unsigned*>(P.ws + O_BAR), xst);
  char* ws = P.ws;
  u16* U = reinterpret_cast<u16*>(ws + O_U);
  float* tctx = reinterpret_cast<float*>(ws + O_TCTX);
  for (int ph = 0; ph < NPH; ++ph) {
    int kind = 0;
    GemmDesc gd; RowDesc rd;
    gd.skipctx = 0; gd.epi = 0; gd.mtiles = 0; gd.ntiles = 0; gd.K = 0; gd.lda = 0; gd.A = nullptr; gd.W = nullptr; gd.dst = nullptr;
    rd.skipctx = 0; rd.g0 = 0; rd.g1 = 0; rd.told_lat = P.out; rd.told_ctx = tctx; rd.ybuf = nullptr; rd.yrow0 = 0; rd.gscale = 1.f;
    rd.gate_idx = 0; rd.gpost_idx = 0; rd.layer = 0; rd.has_u = 0; rd.ulayer = 0; rd.gpre_idx = 0; rd.shift_idx = 0; rd.scale_idx = 0;
    int layer = 0, conv_layer = -1;
    if (ph == 0) {
      for (int t = blockIdx.x; t < 289; t += gridDim.x) { if (t < 288) mods_item(t, P, lds); else misc_item(P); }
      conv_phase(0, P, lds, 0);
    } else {
      layer = (ph - 1) / NPL;
      const int q = (ph - 1) - layer * NPL;
      const bool first = layer == 0;
      if (q == 0) {
        if (first) { kind = 2; rd.g0 = 0; rd.g1 = MT; rd.told_lat = P.in[0]; rd.told_ctx = P.in[2]; rd.has_u = 1; rd.ulayer = 0; rd.gpre_idx = 0; rd.shift_idx = 0; rd.scale_idx = 1; }
        else kind = -1;
      } else if (q == 1 || q == 20) {
        const int s = q == 1 ? 0 : 1;
        kind = 1; gd.epi = EPI_SWIGLU; gd.mtiles = MT / 128;
        if (s == 1 && layer + 1 == DEPTH) { gd.mtiles = 256; gd.skipctx = 1; } gd.ntiles = 44; gd.K = DM; gd.lda = DM; gd.A = U;
        gd.W = reinterpret_cast<const u16*>(ws + O_WIN + s * SZ_WIN); gd.dst = ws + O_ACT;
      } else if (q == 2 || q == 21) {
        const int s = q == 2 ? 0 : 1;
        kind = 1; gd.epi = EPI_YF32; gd.mtiles = MT / 128;
        if (s == 1 && layer + 1 == DEPTH) { gd.mtiles = 256; gd.skipctx = 1; } gd.ntiles = 8; gd.K = FFN; gd.lda = FFN; gd.A = reinterpret_cast<const u16*>(ws + O_ACT);
        gd.W = reinterpret_cast<const u16*>(ws + O_WOUT + s * SZ_WOUT); gd.dst = ws + O_Y;
      } else if (q == 3) {
        kind = 2; rd.g0 = 0; rd.g1 = MT;
        if (first) { rd.told_lat = P.in[0]; rd.told_ctx = P.in[2]; }
        rd.ybuf = reinterpret_cast<const float*>(ws + O_Y); rd.yrow0 = 0; rd.gscale = 0.5f; rd.gate_idx = 2; rd.gpost_idx = 1; rd.layer = layer;
        rd.has_u = 1; rd.ulayer = layer; rd.gpre_idx = 2; rd.shift_idx = 3; rd.scale_idx = 4;
      } else if (q < 20) {
        const int b = (q - 4) >> 3, qq = (q - 4) & 7;
        const u16* Ub = U + (long)b * MB * DM;
        const int mtq = layer + 1 == DEPTH ? 128 : 130;
        if (qq == 0) { kind = 1; gd.epi = EPI_PROJ; gd.mtiles = 130; gd.ntiles = 42; gd.K = DM; gd.lda = DM; gd.A = Ub; gd.W = reinterpret_cast<const u16*>(ws + O_WMIX); }
        else if (qq == 1) { kind = 3; }
        else if (qq == 2) { kind = 1; gd.epi = EPI_UQKV; gd.mtiles = 130; gd.ntiles = 28; }
        else if (qq == 3) { kind = 4; }
        else if (qq == 4) { kind = 1; gd.epi = EPI_SG; gd.mtiles = mtq; gd.ntiles = 24; gd.K = DM; gd.lda = DM; gd.A = Ub; gd.W = reinterpret_cast<const u16*>(ws + O_WMIX) + (long)NPROJ * DM; gd.dst = ws + O_SG; }
        else if (qq == 5) { kind = 5; gd.epi = EPI_MERGE; gd.mtiles = mtq; gd.ntiles = 8; gd.K = DM; gd.lda = DM; gd.A = reinterpret_cast<const u16*>(ws + O_YA); gd.W = reinterpret_cast<const u16*>(ws + O_WBR); gd.dst = ws + O_MERGED; }
        else if (qq == 6) { kind = 1; gd.epi = EPI_YF32; gd.mtiles = mtq; gd.ntiles = 8; gd.K = DM; gd.lda = DM; gd.A = reinterpret_cast<const u16*>(ws + O_MERGED); gd.W = reinterpret_cast<const u16*>(ws + O_WMO); gd.dst = ws + O_YO; }
        else {
          kind = 2; rd.g0 = b * MB; rd.g1 = (b + 1) * MB; rd.skipctx = layer + 1 == DEPTH; rd.ybuf = reinterpret_cast<const float*>(ws + O_YO); rd.yrow0 = b * MB; rd.gscale = 1.f;
          rd.gate_idx = 5; rd.gpost_idx = 3; rd.layer = layer; rd.has_u = 1; rd.ulayer = layer; rd.gpre_idx = 4; rd.shift_idx = 6; rd.scale_idx = 7;
        }
      } else {
        kind = 2; rd.g0 = 0; rd.g1 = MT; rd.skipctx = layer + 1 == DEPTH; rd.ybuf = reinterpret_cast<const float*>(ws + O_Y); rd.yrow0 = 0; rd.gscale = 0.5f; rd.gate_idx = 8; rd.gpost_idx = 5; rd.layer = layer;
        if (layer + 1 < DEPTH) { rd.has_u = 1; rd.ulayer = layer + 1; rd.gpre_idx = 0; rd.shift_idx = 0; rd.scale_idx = 1; conv_layer = layer + 1; }
      }
    }
    if (kind == 1) gemm_phase<false>(gd, P, lds);
    else if (kind == 5) gemm_phase<true>(gd, P, lds);
    else if (kind == 2) rowop_phase(rd, P);
    else if (kind == 3) r3_phase(layer, P);
    else if (kind == 4) attn_phase(layer, P, lds);
    if (conv_layer >= 0) conv_phase(conv_layer, P, lds, 0);
    if (kind != -1 && ph + 1 < NPH) {
      if (P.pad[0] == 0x7fffffff) grid.sync();
      xcd_barrier(xb);
    }
  }
}

extern "C" void kernel_launch(void* const* d_in, const int* in_sizes, int n_in, void* d_out, int out_size, void* d_ws, size_t ws_size,
                              hipStream_t stream) {
  static int grid_blocks = 0;
  if (!grid_blocks) {
    int dev = 0, cus = 0, per_cu = 0;
    (void)hipGetDevice(&dev);
    (void)hipDeviceGetAttribute(&cus, hipDeviceAttributeMultiprocessorCount, dev);
    (void)hipFuncSetAttribute((const void*)fwd_megakernel, hipFuncAttributeMaxDynamicSharedMemorySize, (int)LDS_BYTES);
    (void)hipOccupancyMaxActiveBlocksPerMultiprocessor(&per_cu, fwd_megakernel, 256, LDS_BYTES);
    if (per_cu > 2) per_cu = 2;
    if (per_cu < 1) per_cu = 1;
    grid_blocks = cus * per_cu;
    fprintf(stderr, "megakernel: cus %d per_cu %d grid %d ws_need %zu ws_size %zu\n", cus, per_cu, grid_blocks, (size_t)WS_NEED, ws_size);
  }
  if (n_in != 19 || ws_size < WS_NEED) {
    fprintf(stderr, "kernel_launch: bad setup n_in %d ws_size %zu need %zu\n", n_in, ws_size, (size_t)WS_NEED);
    return;
  }
  Params p{};
  for (int i = 0; i < 19; ++i) p.in[i] = reinterpret_cast<const float*>(d_in[i]);
  p.out = reinterpret_cast<float*>(d_out);
  p.ws = reinterpret_cast<char*>(d_ws);
  for (int j = 0; j < 16; ++j) p.inv_freq[j] = 1.0f / powf(10000.0f, (float)j / 16.0f);
  for (int l = 0; l < DEPTH; ++l) p.linit[l] = (float)(0.8 - 0.6 * exp(-0.3 * (double)l));
  (void)hipMemsetAsync(reinterpret_cast<char*>(d_ws) + O_BAR, 0, XCD_BAR_WORDS * 4, stream);
  void* args[] = {&p};
  hipError_t e = hipLaunchCooperativeKernel((void*)fwd_megakernel, dim3(grid_blocks), dim3(256), args, LDS_BYTES, stream);
  if (e != hipSuccess) fprintf(stderr, "cooperative launch failed: %s (grid %d)\n", hipGetErrorString(e), grid_blocks);
}
```
